# Optimizing an MI355X kernel written in HIP

```python
import jax, jax.numpy as jnp
from jax import lax
import numpy as np


D_MODEL = 1024
BATCH = 4
SEQ = 4096
DEPTH = 2

NSA_HEADS = 8
NSA_KV_HEADS = 2
HEAD_DIM = 64
HPG = NSA_HEADS // NSA_KV_HEADS
CMP_LEN = 32
CMP_STRIDE = 16
CMP_HIDDEN = 256
SEL_LEN = 64
N_SEL = 16
WINDOW = 512
Q_BLOCK = 128
NSA_WIDTH = NSA_HEADS * HEAD_DIM
CONV_CH = D_MODEL // 2
CONV_WIDTH = 31
Q_COLS = NSA_WIDTH
KV_COLS = 3 * 2 * NSA_KV_HEADS * HEAD_DIM
GATE_COLS = 3 * NSA_HEADS
IN0_COLS = Q_COLS + KV_COLS + GATE_COLS + 2 * CONV_CH
MIX0_WIDTH = NSA_WIDTH + CONV_CH
GMLP_WIDTH = D_MODEL
GMLP_GROUPS = 8
GMLP_CHUNK = 128
DENSE_FF = 2816
N_EXPERTS = 8
TOP_K = 2
EXPERT_FF = 3584
MOE_BLOCK = 256
EPS = 1e-6
N_EVEN = (DEPTH + 1) // 2
N_ODD = DEPTH // 2

kernel_name = 'hybrid_nsa_conformer_gmlp_moe'


def rms_norm(x, g):
    xf = x.astype(jnp.float32)
    y = xf * lax.rsqrt(jnp.mean(xf * xf, axis=-1, keepdims=True) + EPS)
    return (y * g.astype(jnp.float32)).astype(x.dtype)


def layer_norm(x, g, b):
    xf = x.astype(jnp.float32)
    mu = jnp.mean(xf, axis=-1, keepdims=True)
    xc = xf - mu
    var = jnp.mean(xc * xc, axis=-1, keepdims=True)
    return (xc * lax.rsqrt(var + EPS) * g.astype(jnp.float32) + b.astype(jnp.float32)).astype(x.dtype)


def masked_softmax(s, mask, axis):
    s = jnp.where(mask, s.astype(jnp.float32), -1e30)
    return jax.nn.softmax(s, axis=axis)


def swiglu(x, w_gate, w_up, w_down):
    return (jax.nn.silu(x @ w_gate) * (x @ w_up)) @ w_down


def compress_blocks(k, pe, w1, b1, w2, b2):
    S = k.shape[2]
    nc = (S - CMP_LEN) // CMP_STRIDE + 1
    idx = np.arange(nc)[:, None] * CMP_STRIDE + np.arange(CMP_LEN)[None, :]
    blocks = k[:, :, idx] + pe
    flat = blocks.reshape(blocks.shape[:3] + (CMP_LEN * HEAD_DIM,))
    return jax.nn.gelu(flat @ w1 + b1) @ w2 + b2


def nsa_attention(q, k_cmp, v_cmp, k_slc, v_slc, k_win, v_win, gates,
                  cmp_pe, cmp_w1, cmp_b1, cmp_w2, cmp_b2):
    B, G, Hg, S, hd = q.shape
    scale = hd ** -0.5
    t = jnp.arange(S)

    kc = compress_blocks(k_cmp, cmp_pe[0], cmp_w1[0], cmp_b1[0], cmp_w2[0], cmp_b2[0])
    vc = compress_blocks(v_cmp, cmp_pe[1], cmp_w1[1], cmp_b1[1], cmp_w2[1], cmp_b2[1])
    nc = kc.shape[2]
    c_end = jnp.arange(nc) * CMP_STRIDE + CMP_LEN - 1
    c_mask = c_end[None, :] <= t[:, None]
    s_c = jnp.einsum('bghtd,bgnd->bghtn', q, kc) * scale
    p_c = jnp.where(c_mask, masked_softmax(s_c, c_mask, -1), 0.0)
    o_c = jnp.einsum('bghtn,bgnd->bghtd', p_c.astype(vc.dtype), vc)

    nsb = S // SEL_LEN
    cs = np.arange(nc) * CMP_STRIDE
    js = np.arange(nsb) * SEL_LEN
    overlap = jnp.asarray(((cs[:, None] < js[None, :] + SEL_LEN) &
                           (cs[:, None] + CMP_LEN > js[None, :])).astype(np.float32))
    imp = jnp.einsum('bghtn,nj->bgtj', p_c, overlap)
    blk = jnp.arange(nsb)[None, :]
    cur = (t // SEL_LEN)[:, None]
    valid = blk <= cur
    forced = (blk == 0) | (blk == cur) | (blk == cur - 1)
    score = jnp.where(valid, imp + jnp.where(forced, 1e6, 0.0), -1e9)
    n_sel = min(N_SEL, nsb)
    _, sel = lax.top_k(score, n_sel)

    nqb = S // Q_BLOCK
    kb = k_slc.reshape(B, G, nsb, SEL_LEN, hd)
    vb = v_slc.reshape(B, G, nsb, SEL_LEN, hd)
    gather = jax.vmap(jax.vmap(lambda blocks, ids: blocks[ids]))
    q_blocks = jnp.moveaxis(q.reshape(B, G, Hg, nqb, Q_BLOCK, hd), 3, 0)
    sel_blocks = jnp.moveaxis(sel.reshape(B, G, nqb, Q_BLOCK, n_sel), 2, 0)
    t_blocks = t.reshape(nqb, Q_BLOCK)

    def sel_block(args):
        qb, sb, tb = args
        kg = gather(kb, sb)
        vg = gather(vb, sb)
        s = jnp.einsum('bghqd,bgqnld->bghqnl', qb, kg) * scale
        kpos = sb[..., None] * SEL_LEN + jnp.arange(SEL_LEN)
        mask = (kpos <= tb[None, None, :, None, None])[:, :, None]
        p = masked_softmax(s, mask, (-2, -1))
        return jnp.einsum('bghqnl,bgqnld->bghqd', p.astype(vg.dtype), vg)

    o_s = lax.map(sel_block, (q_blocks, sel_blocks, t_blocks))
    o_s = jnp.moveaxis(o_s, 0, 3).reshape(B, G, Hg, S, hd)

    kp = jnp.pad(k_win, ((0, 0), (0, 0), (WINDOW, 0), (0, 0)))
    vp = jnp.pad(v_win, ((0, 0), (0, 0), (WINDOW, 0), (0, 0)))
    widx = np.arange(nqb)[:, None] * Q_BLOCK + np.arange(Q_BLOCK + WINDOW)[None, :]
    kw = kp[:, :, widx]
    vw = vp[:, :, widx]
    qw = q.reshape(B, G, Hg, nqb, Q_BLOCK, hd)
    s_w = jnp.einsum('bghnqd,bgnkd->bghnqk', qw, kw) * scale
    kpos = jnp.asarray(widx - WINDOW)[:, None, :]
    qpos = t_blocks[:, :, None]
    w_mask = (kpos <= qpos) & (kpos > qpos - WINDOW) & (kpos >= 0)
    p_w = masked_softmax(s_w, w_mask, -1)
    o_w = jnp.einsum('bghnqk,bgnkd->bghnqd', p_w.astype(vw.dtype), vw).reshape(B, G, Hg, S, hd)

    return gates[..., 0:1] * o_c + gates[..., 1:2] * o_s + gates[..., 2:3] * o_w


def mixer_nsa_conv(u, w_in, cmp_pe, cmp_w1, cmp_b1, cmp_w2, cmp_b2,
                   conv_w, conv_b, conv_ln_g, conv_ln_b, w_out):
    B, S, _ = u.shape
    proj = u @ w_in
    q, kv, g, glu = jnp.split(proj, [Q_COLS, Q_COLS + KV_COLS, Q_COLS + KV_COLS + GATE_COLS], axis=-1)
    q = q.reshape(B, S, NSA_KV_HEADS, HPG, HEAD_DIM).transpose(0, 2, 3, 1, 4)
    kv = kv.reshape(B, S, 6, NSA_KV_HEADS, HEAD_DIM).transpose(2, 0, 3, 1, 4)
    gates = jax.nn.sigmoid(g.reshape(B, S, NSA_KV_HEADS, HPG, 3).transpose(0, 2, 3, 1, 4))
    o = nsa_attention(q, kv[0], kv[1], kv[2], kv[3], kv[4], kv[5], gates,
                      cmp_pe, cmp_w1, cmp_b1, cmp_w2, cmp_b2)
    o_attn = o.transpose(0, 3, 1, 2, 4).reshape(B, S, NSA_WIDTH)
    a, b = jnp.split(glu, 2, axis=-1)
    c = a * jax.nn.sigmoid(b)
    c = lax.conv_general_dilated(c, conv_w, window_strides=(1,), padding=[(CONV_WIDTH - 1, 0)],
                                 dimension_numbers=('NWC', 'WIO', 'NWC'),
                                 feature_group_count=CONV_CH) + conv_b
    c = jax.nn.silu(layer_norm(c, conv_ln_g, conv_ln_b))
    return jnp.concatenate([o_attn, c], axis=-1) @ w_out


def mixer_gmlp(u, w_in, ln_g, ln_b, w_s, b_s, w_out):
    B, S, _ = u.shape
    z = jax.nn.gelu(u @ w_in)
    z1, z2 = jnp.split(z, 2, axis=-1)
    z2 = layer_norm(z2, ln_g, ln_b)
    nch = S // GMLP_CHUNK
    z2 = z2.reshape(B, nch, GMLP_CHUNK, GMLP_GROUPS, GMLP_WIDTH // GMLP_GROUPS)
    causal = jnp.tril(jnp.ones((GMLP_CHUNK, GMLP_CHUNK), dtype=bool))
    ws = jnp.where(causal, w_s, 0.0)
    mixed = jnp.einsum('gts,bcsgd->bctgd', ws, z2) + b_s.T[:, :, None]
    return (z1 * mixed.reshape(B, S, GMLP_WIDTH)) @ w_out


def moe_swiglu(x, w_router, w_gate, w_up, w_down):
    B, S, D = x.shape
    h = x.reshape(-1, D)
    n = h.shape[0]
    logits = (h @ w_router).astype(jnp.float32)
    top_logit, top_e = lax.top_k(logits, TOP_K)
    top_w = jax.nn.softmax(top_logit, axis=-1)
    nk = n * TOP_K
    e_flat = top_e.reshape(-1)
    w_flat = top_w.reshape(-1)
    tok_flat = jnp.arange(nk) // TOP_K
    order = jnp.argsort(e_flat)
    e_sorted = e_flat[order]
    counts = jnp.zeros((N_EXPERTS,), jnp.int32).at[e_flat].add(1)
    starts = jnp.cumsum(counts) - counts
    padded = (counts + MOE_BLOCK - 1) // MOE_BLOCK * MOE_BLOCK
    pad_ends = jnp.cumsum(padded)
    pad_starts = pad_ends - padded
    dest = pad_starts[e_sorted] + (jnp.arange(nk) - starts[e_sorted])
    n_rows = nk + N_EXPERTS * MOE_BLOCK
    n_blocks = n_rows // MOE_BLOCK
    row_tok = jnp.full((n_rows,), n, jnp.int32).at[dest].set(tok_flat[order])
    row_w = jnp.zeros((n_rows,), jnp.float32).at[dest].set(w_flat[order])
    block_e = jnp.minimum(jnp.searchsorted(pad_ends, jnp.arange(n_blocks) * MOE_BLOCK, side='right'),
                          N_EXPERTS - 1)
    h_pad = jnp.concatenate([h, jnp.zeros((1, D), h.dtype)], axis=0)
    xb = h_pad[row_tok].reshape(n_blocks, MOE_BLOCK, D)

    def expert_block(args):
        xe, e = args
        return swiglu(xe, w_gate[e], w_up[e], w_down[e])

    yb = lax.map(expert_block, (xb, block_e)).reshape(n_rows, D)
    out = jnp.zeros((n + 1, D), jnp.float32).at[row_tok].add(yb.astype(jnp.float32) * row_w[:, None])
    return out[:n].astype(x.dtype).reshape(B, S, D)


def setup_inputs(seed: int = 0) -> dict:
    key = jax.random.key(seed)
    keys = jax.random.split(key, 32)
    D = D_MODEL
    NE = N_EVEN
    NO = N_ODD

    def nrm(i, shape, scale):
        return jax.random.normal(keys[i], shape, jnp.float32) * scale

    return {
        'x': nrm(0, (BATCH, SEQ, D), 1.0),
        'norm_mix_pre': 1.0 + nrm(1, (DEPTH, D), 0.02),
        'norm_mix_post': 1.0 + nrm(2, (DEPTH, D), 0.02),
        'norm_ffn_pre': 1.0 + nrm(3, (DEPTH, D), 0.02),
        'norm_ffn_post': 1.0 + nrm(4, (DEPTH, D), 0.02),
        'nsa_conv_w_in': nrm(5, (NE, D, IN0_COLS), D ** -0.5),
        'cmp_pe': nrm(6, (NE, 2, CMP_LEN, HEAD_DIM), 0.1),
        'cmp_w1': nrm(7, (NE, 2, CMP_LEN * HEAD_DIM, CMP_HIDDEN), (CMP_LEN * HEAD_DIM) ** -0.5),
        'cmp_b1': nrm(8, (NE, 2, CMP_HIDDEN), 0.01),
        'cmp_w2': nrm(9, (NE, 2, CMP_HIDDEN, HEAD_DIM), CMP_HIDDEN ** -0.5),
        'cmp_b2': nrm(10, (NE, 2, HEAD_DIM), 0.01),
        'conv_w': nrm(11, (NE, CONV_WIDTH, 1, CONV_CH), CONV_WIDTH ** -0.5),
        'conv_b': nrm(12, (NE, CONV_CH), 0.01),
        'conv_ln_g': 1.0 + nrm(13, (NE, CONV_CH), 0.02),
        'conv_ln_b': nrm(14, (NE, CONV_CH), 0.01),
        'nsa_conv_w_out': nrm(15, (NE, MIX0_WIDTH, D), MIX0_WIDTH ** -0.5),
        'ffn_w_gate': nrm(16, (NE, D, DENSE_FF), D ** -0.5),
        'ffn_w_up': nrm(17, (NE, D, DENSE_FF), D ** -0.5),
        'ffn_w_down': nrm(18, (NE, DENSE_FF, D), DENSE_FF ** -0.5),
        'gmlp_w_in': nrm(19, (NO, D, 2 * GMLP_WIDTH), D ** -0.5),
        'gmlp_ln_g': 1.0 + nrm(20, (NO, GMLP_WIDTH), 0.02),
        'gmlp_ln_b': nrm(21, (NO, GMLP_WIDTH), 0.01),
        'gmlp_w_s': nrm(22, (NO, GMLP_GROUPS, GMLP_CHUNK, GMLP_CHUNK), GMLP_CHUNK ** -0.5),
        'gmlp_b_s': 1.0 + nrm(23, (NO, GMLP_GROUPS, GMLP_CHUNK), 0.01),
        'gmlp_w_out': nrm(24, (NO, GMLP_WIDTH, D), GMLP_WIDTH ** -0.5),
        'moe_w_router': nrm(25, (NO, D, N_EXPERTS), D ** -0.5),
        'moe_w_gate': nrm(26, (NO, N_EXPERTS, D, EXPERT_FF), D ** -0.5),
        'moe_w_up': nrm(27, (NO, N_EXPERTS, D, EXPERT_FF), D ** -0.5),
        'moe_w_down': nrm(28, (NO, N_EXPERTS, EXPERT_FF, D), EXPERT_FF ** -0.5),
    }


def reference(x, norm_mix_pre, norm_mix_post, norm_ffn_pre, norm_ffn_post,
              nsa_conv_w_in, cmp_pe, cmp_w1, cmp_b1, cmp_w2, cmp_b2,
              conv_w, conv_b, conv_ln_g, conv_ln_b, nsa_conv_w_out,
              ffn_w_gate, ffn_w_up, ffn_w_down,
              gmlp_w_in, gmlp_ln_g, gmlp_ln_b, gmlp_w_s, gmlp_b_s, gmlp_w_out,
              moe_w_router, moe_w_gate, moe_w_up, moe_w_down):
    h = x
    for layer in range(DEPTH):
        i = layer // 2
        u = rms_norm(h, norm_mix_pre[layer])
        if layer % 2 == 0:
            m = mixer_nsa_conv(u, nsa_conv_w_in[i], cmp_pe[i], cmp_w1[i], cmp_b1[i], cmp_w2[i], cmp_b2[i],
                               conv_w[i], conv_b[i], conv_ln_g[i], conv_ln_b[i], nsa_conv_w_out[i])
        else:
            m = mixer_gmlp(u, gmlp_w_in[i], gmlp_ln_g[i], gmlp_ln_b[i], gmlp_w_s[i], gmlp_b_s[i], gmlp_w_out[i])
        h = h + rms_norm(m, norm_mix_post[layer])
        u = rms_norm(h, norm_ffn_pre[layer])
        if layer % 2 == 0:
            f = swiglu(u, ffn_w_gate[i], ffn_w_up[i], ffn_w_down[i])
        else:
            f = moe_swiglu(u, moe_w_router[i], moe_w_gate[i], moe_w_up[i], moe_w_down[i])
        h = h + rms_norm(f, norm_ffn_post[layer])
    return h
```

```cpp
#include <hip/hip_runtime.h>
#include <hip/hip_cooperative_groups.h>
#include <cstdio>
#include <cstdint>
namespace cg = cooperative_groups;

#ifndef NSA_MODE
#define NSA_MODE 1
#endif
#ifndef NSA_FN
#define NSA_FN phase_nsa3
#endif
#ifndef N3_PROBE
#define N3_PROBE 0
#endif
#ifndef NSA_VT
#define NSA_VT 0
#endif
#ifndef FUSE_NORM
#define FUSE_NORM 1
#endif
#ifndef PROBE_GAIN
#define PROBE_GAIN 100.f
#endif
#define LAS __attribute__((address_space(3)))
typedef unsigned short bf16;
typedef short bf16x8 __attribute__((ext_vector_type(8)));
typedef float f32x4 __attribute__((ext_vector_type(4)));
typedef float f32x2 __attribute__((ext_vector_type(2)));
typedef unsigned u32x4 __attribute__((ext_vector_type(4)));
typedef unsigned u32x2 __attribute__((ext_vector_type(2)));
typedef float f32x16 __attribute__((ext_vector_type(16)));
typedef int i32x4 __attribute__((ext_vector_type(4)));
typedef int i32x8 __attribute__((ext_vector_type(8)));
#define MFMA32(a, b, c) __builtin_amdgcn_mfma_f32_32x32x16_bf16((a), (b), (c), 0, 0, 0)

constexpr int NT = 16384, D = 1024, SEQ = 4096, NB = 4;
constexpr int IN0 = 2328, IN0P = 2560;
constexpr int FF = 2816, EFF = 3584, NE = 8;
constexpr int EFFP = 3712;
constexpr int MOE_ROWS = 2 * NT + NE * 256;
constexpr float EPS = 1e-6f;
constexpr float QSCALE = 0.125f * 1.4426950408889634f;

constexpr size_t MiB = 1u << 20;
#ifndef FFN_F8
#define FFN_F8 0
#endif
#ifndef MOE_F8
#define MOE_F8 1
#endif
#if MOE_F8
constexpr size_t WS_WMGU = 0;
constexpr size_t WS_WMD = 56 * MiB;
constexpr size_t WS_Y = 85 * MiB;
constexpr size_t WS_U8 = 152 * MiB;
constexpr size_t WS_XG8 = 292 * MiB;
#else
constexpr size_t WS_WMGU = 0;
constexpr size_t WS_Y = 0;
constexpr size_t WS_WMD = 112 * MiB;
#endif
constexpr float MOE_SGU = 32.f, MOE_SD = 64.f;
constexpr size_t WS_C = 168 * MiB;
constexpr size_t WS_MACT = WS_C;
constexpr size_t WS_WIN = WS_C + 0 * MiB;
constexpr size_t WS_WOUT = WS_C + 5 * MiB;
constexpr size_t WS_WGU = WS_C + 7 * MiB;
constexpr size_t WS_WDN = WS_C + 18 * MiB;
constexpr size_t WS_WGIN = WS_C + 24 * MiB;
constexpr size_t WS_WGOUT = WS_C + 28 * MiB;
constexpr size_t WS_WC1 = WS_C + 30 * MiB;
constexpr size_t WS_WSB = WS_C + 32 * MiB;
constexpr size_t WS_KC = WS_WSB + 256 * 1024;
constexpr size_t WS_VC = WS_KC + 256 * 1024;
constexpr size_t WS_VCT = WS_VC + 256 * 1024;
constexpr size_t WS_BIAS1 = WS_C + 39 * MiB;
constexpr size_t WS_W2T = WS_BIAS1 + 2048;
constexpr size_t WS_PROBE = WS_BIAS1 + 4096 + 65536;
constexpr size_t WS_H1C = WS_C + 33 * MiB;
constexpr size_t WS_GATES = WS_C + 35 * MiB;
constexpr size_t WS_STATS = WS_C + 37 * MiB;
constexpr size_t WS_Q = WS_C + 40 * MiB;
constexpr size_t WS_KV = WS_C + 56 * MiB;
constexpr size_t WS_VT = WS_C + 80 * MiB;
constexpr size_t WS_CGLU = WS_C + 88 * MiB;
constexpr size_t WS_CAT = WS_C + 104 * MiB;
constexpr size_t WS_M = WS_C + 136 * MiB;
constexpr size_t WS_FACT = WS_C + 40 * MiB;
constexpr size_t WS_Z = WS_C + 40 * MiB;
constexpr size_t WS_H = WS_C + 200 * MiB;
constexpr size_t WS_U = 406 * MiB;
constexpr size_t WS_E = 438 * MiB;
constexpr size_t WS_CNT = WS_E;
constexpr size_t WS_LIST = WS_E + 4096;
constexpr size_t WS_TOKE = WS_LIST + 8 * 16384 * 4;
constexpr size_t WS_TOKW = WS_TOKE + 16384 * 8;
constexpr size_t WS_RS = WS_E + 832 * 1024;
constexpr size_t WS_BAR = 439 * MiB + 512 * 1024;
constexpr size_t WS_PACC = 439 * MiB;
constexpr size_t WS_XCNT = WS_BAR + 16384;
constexpr size_t WS_XSLOT = 406 * MiB;
constexpr size_t WS_END = 441 * MiB;

constexpr int LDS_BYTES = 163840;
constexpr int LDS_XB = 147456;
constexpr int LDS_MISC = 135168;

__device__ __forceinline__ unsigned f2bf(float f) { unsigned u = __float_as_uint(f); return (u + 0x7fffu + ((u >> 16) & 1u)) >> 16; }
typedef __bf16 bf16x2_t __attribute__((ext_vector_type(2)));
__device__ __forceinline__ unsigned pk2(float lo, float hi) { return __builtin_bit_cast(unsigned, __builtin_convertvector((f32x2){lo, hi}, bf16x2_t)); }
__device__ __forceinline__ float bflo(unsigned w) { return __uint_as_float(w << 16); }
__device__ __forceinline__ float bfhi(unsigned w) { return __uint_as_float(w & 0xffff0000u); }
__device__ __forceinline__ float bf2f(bf16 b) { return __uint_as_float((unsigned)b << 16); }
__device__ __forceinline__ float wave_sum(float v) {
#pragma unroll
    for (int o = 1; o < 64; o <<= 1) v += __shfl_xor(v, o);
    return v;
}
__device__ __forceinline__ float wave_max(float v) {
#pragma unroll
    for (int o = 1; o < 64; o <<= 1) v = fmaxf(v, __shfl_xor(v, o));
    return v;
}
__device__ __forceinline__ float sigm(float x) { return __builtin_amdgcn_rcpf(1.f + __expf(-x)); }
__device__ __forceinline__ float silu(float x) { return x * sigm(x); }
__device__ __forceinline__ float gelu_tanh(float x) { constexpr float C1 = -2.f * 0.7978845608028654f * 1.4426950408889634f, C2 = 0.044715f * C1;
    const float t = x * __builtin_fmaf(x * x, C2, C1); return x * __builtin_amdgcn_rcpf(1.f + __builtin_amdgcn_exp2f(t)); }
__device__ __forceinline__ f32x2 swiglu2(f32x2 g, f32x2 u, float k1, float k2) { f32x2 t = g * k1; t = (f32x2){__builtin_amdgcn_exp2f(t[0]), __builtin_amdgcn_exp2f(t[1])} + 1.f;
    t = (f32x2){__builtin_amdgcn_rcpf(t[0]), __builtin_amdgcn_rcpf(t[1])}; return ((g * u) * t) * k2; }
__device__ __forceinline__ f32x2 gelu_tanh2(f32x2 x) { constexpr float C1 = -2.f * 0.7978845608028654f * 1.4426950408889634f, C2 = 0.044715f * C1;
    f32x2 t = x * ((x * x) * C2 + C1); t = (f32x2){__builtin_amdgcn_exp2f(t[0]), __builtin_amdgcn_exp2f(t[1])} + 1.f; return x * (f32x2){__builtin_amdgcn_rcpf(t[0]), __builtin_amdgcn_rcpf(t[1])}; }
#define WAVE_FENCE() asm volatile("s_waitcnt lgkmcnt(0)" ::: "memory")
__device__ __forceinline__ int tid_fresh() { int t = threadIdx.x; asm volatile("" : "+v"(t)); return t; }
__device__ __forceinline__ float clamp8(float x) { float r; asm("v_med3_f32 %0, %1, %2, -%2" : "=v"(r) : "v"(x), "s"(448.f)); return r; }
__device__ __forceinline__ unsigned pk4f8(float a, float b, float c, float d) { unsigned r = 0u; r = __builtin_amdgcn_cvt_pk_fp8_f32(clamp8(a), clamp8(b), r, false); r = __builtin_amdgcn_cvt_pk_fp8_f32(clamp8(c), clamp8(d), r, true); return r; }


#define XB_TMO      128
#define XB_XCNT(j)  (256  + 64 * (j))
#define XB_XSUB(j)  (1280 + 64 * (j))
#define XB_XGEN(j)  (2304 + 64 * (j))
#define XB_TOP      3328
#define XB_TOPGEN   3392
#define XCD_BAR_WORDS 3456
#define XB_SPIN_CAP (1u << 22)
__device__ __forceinline__ unsigned xb_ld(unsigned* p)              { return __hip_atomic_load(p, __ATOMIC_RELAXED, __HIP_MEMORY_SCOPE_AGENT); }
__device__ __forceinline__ unsigned xb_add(unsigned* p, unsigned v) { return __hip_atomic_fetch_add(p, v, __ATOMIC_RELAXED, __HIP_MEMORY_SCOPE_AGENT); }
__device__ __forceinline__ unsigned xb_xcc_id() { return (unsigned)__builtin_amdgcn_s_getreg((3 << 11) | 20) & 0xFu; }
#define XB_SPIN(cond, bar) do { unsigned _sp = 0; while (cond) { __builtin_amdgcn_s_sleep(1); \
    if ((++_sp & 255u) == 0u) { if (xb_ld(&(bar)[XB_TMO])) break; if (_sp > XB_SPIN_CAP) { atomicAdd(&(bar)[XB_TMO], 1u); break; } } } } while (0)
struct XcdBarrier { unsigned* bar; unsigned x; volatile LAS unsigned* st; };
__device__ __forceinline__ XcdBarrier xcd_barrier_post(unsigned* bar, volatile LAS unsigned* st) {
    XcdBarrier b; b.bar = bar; b.x = xb_xcc_id(); b.st = st;
    if (threadIdx.x == 0) (void)xb_add(&bar[XB_XCNT(b.x)], 1u);
    return b;
}
__device__ __forceinline__ void xcd_barrier_complete(unsigned* bar, unsigned x, unsigned& nloc, unsigned& nx) {
    const unsigned G = gridDim.x * gridDim.y * gridDim.z;
    unsigned sum, cnt, mine, sp = 0u;
    for (;;) {
        sum = 0u; cnt = 0u; mine = 0u;
#pragma unroll
        for (unsigned j = 0; j < 16; ++j) { const unsigned c = xb_ld(&bar[XB_XCNT(j)]); sum += c; cnt += (c > 0u) ? 1u : 0u; mine = (j == x) ? c : mine; }
        if (sum == G) break;
        __builtin_amdgcn_s_sleep(1);
        if ((++sp & 255u) == 0u) { if (xb_ld(&bar[XB_TMO])) break; if (sp > XB_SPIN_CAP) { atomicAdd(&bar[XB_TMO], 1u); break; } }
    }
    nloc = mine > 0u ? mine : 1u; nx = cnt > 0u ? cnt : 1u;
}
__device__ __forceinline__ void xcd_barrier(const XcdBarrier& b) {
    asm volatile("s_waitcnt vmcnt(0)" ::: "memory");
    __syncthreads();
    if (threadIdx.x == 0) {
        unsigned* bar = b.bar;
        __builtin_amdgcn_s_waitcnt(0);
        unsigned nloc = b.st[0], nx = b.st[1];
        if (nloc == 0u) { xcd_barrier_complete(bar, b.x, nloc, nx); b.st[0] = nloc; b.st[1] = nx; }
        const unsigned old = xb_add(&bar[XB_XSUB(b.x)], 1u);
        const unsigned gen = old / nloc;
        if (old + 1u == (gen + 1u) * nloc) {
            __builtin_amdgcn_fence(__ATOMIC_RELEASE, "agent");
            asm volatile("s_waitcnt vmcnt(0)" ::: "memory");
            const unsigned og = xb_add(&bar[XB_TOP], 1u);
            const unsigned tg = og / nx;
            if (og + 1u == (tg + 1u) * nx) xb_add(&bar[XB_TOPGEN], 1u);
            else XB_SPIN(xb_ld(&bar[XB_TOPGEN]) == tg, bar);
            __builtin_amdgcn_fence(__ATOMIC_ACQUIRE, "agent");
            xb_add(&bar[XB_XGEN(b.x)], 1u);
            asm volatile("s_waitcnt vmcnt(0)" ::: "memory");
        } else {
            XB_SPIN(xb_ld(&bar[XB_XGEN(b.x)]) == gen, bar);
            __builtin_amdgcn_fence(__ATOMIC_ACQUIRE, "agent");
            asm volatile("s_waitcnt vmcnt(0)" ::: "memory");
        }
    }
    __syncthreads();
}

namespace g8 {
constexpr int BM = 256, BK = 64, HALF = 128, HTB = HALF * BK * 2, STAGE_BYTES = 8 * HTB, NXCD = 8, WGM = 8;
__host__ __device__ __forceinline__ int lds_byte(int r, int c) { const int st = (r >> 4) * 2 + (c >> 5), rr = r & 15, cc = c & 31, ob = rr * 64 + cc * 2; return st * 1024 + (ob ^ (((ob >> 9) & 1) << 5)); }
__host__ __device__ __forceinline__ void stage_rc(int b, int& R, int& C) { const int st = b / 1024, sb = b % 1024, swz = sb ^ (((sb >> 9) & 1) << 5); R = (st >> 1) * 16 + swz / 64; C = (st & 1) * 32 + (swz % 64) / 2; }

struct Unit { int pm, pn, e; unsigned ao, bo; };

__device__ __forceinline__ bool tile_order(int L, int nM, int nN, int& pm, int& pn) {
    const int nwg = nM * nN; if (L >= nwg) return false;
    int wgid = L; { const int q = nwg / NXCD, r = nwg % NXCD, xcd = wgid % NXCD, off = wgid / NXCD; wgid = (xcd < r ? xcd * (q + 1) : r * (q + 1) + (xcd - r) * q) + off; }
    const int nig = WGM * nN, gid = wgid / nig, fm = gid * WGM, gsz = (nM - fm) < WGM ? (nM - fm) : WGM;
    pm = fm + ((wgid % nig) % gsz); pn = (wgid % nig) / gsz; return true;
}
struct StaticSched {
    static constexpr bool GATHER = false;
    const void* A; const void* Bt; int apitch_, bpitch, nM, nN, G, c;
    __device__ __forceinline__ int apitch() const { return apitch_; }
    __device__ __forceinline__ const void* abase() const { return A; }
    __device__ __forceinline__ const void* bbase() const { return Bt; }
    __device__ __forceinline__ bool next(int i, Unit& u) const {
        if (!tile_order(i * G + c, nM, nN, u.pm, u.pn)) return false;
        u.e = 0; u.ao = (unsigned)u.pm * BM * (unsigned)apitch_; u.bo = (unsigned)u.pn * BM * (unsigned)bpitch; return true;
    }
    __device__ __forceinline__ void aoff(const Unit&, unsigned (&)[4]) const {}
};

#ifndef EPI_REP_MASK
#define EPI_REP_MASK 0
#endif
template <class E> struct EpiId { static constexpr int id = 31; };
template <class E> struct EpiLds { static constexpr bool v = false; };
template <class E> struct EpiRS { static constexpr bool v = false; };
constexpr int LDS_RS = 132096;
#define G8_WAIT_V(n) asm volatile("s_waitcnt vmcnt(" #n ")" ::: "memory")
#define G8_WAIT_L(n) asm volatile("s_waitcnt lgkmcnt(" #n ")" ::: "memory")
#define G8_BAR __builtin_amdgcn_s_barrier()
#define G8_SCHED __builtin_amdgcn_sched_barrier(0)

template <bool F8 = false, class Epi, class Sched>
__device__ __forceinline__ void gemm_phase(LAS unsigned char* lds, const int K, const Sched& S, const Epi& E, const int bpitch_bytes = 0) {
    const int tid = tid_fresh(), wid = __builtin_amdgcn_readfirstlane(tid >> 6), lane = tid & 63, wr = wid >> 2, wc = wid & 3, fr = lane & 15, fq = lane >> 4;
    constexpr int ES = F8 ? 1 : 2, KSTR = F8 ? 16 : 1024;
    const int nt = K * ES / 128;
    int R0, C0; stage_rc(tid * 16, R0, C0);
    const int bpitch = bpitch_bytes ? bpitch_bytes : K * ES, apitch = S.apitch();
    const unsigned vb0 = (unsigned)(R0 * bpitch + C0 * 2);
    unsigned va0 = (unsigned)(R0 * apitch + C0 * 2);
    const unsigned kstep = 128u;
    const unsigned hB = (unsigned)HALF * bpitch, qB = 64u * bpitch, hA = (unsigned)HALF * apitch, qA = 64u * apitch;
    const __amdgpu_buffer_rsrc_t rA = __builtin_amdgcn_make_buffer_rsrc((void*)S.abase(), 0, -1, 0x00020000), rB = __builtin_amdgcn_make_buffer_rsrc((void*)S.bbase(), 0, -1, 0x00020000);
    const unsigned ldsw = (unsigned)wid * 1024u;
    const int aoff = lds_byte(wr * 64 + fr, F8 ? fq * 16 : fq * 8), boff = lds_byte(wc * 32 + fr, F8 ? fq * 16 : fq * 8);
    unsigned ldsA = (unsigned)(size_t)lds + (unsigned)aoff, ldsB = (unsigned)(size_t)lds + 65536u + (unsigned)boff;
    asm volatile("" : "+v"(ldsA), "+v"(ldsB), "+v"(va0));
#define G8_SA(b, h) (((b) * 2 + (h)) * HTB)
#define G8_SB(b, h) ((4 + (b) * 2 + (h)) * HTB)
#define G8_BLDS(rsrc, voff, soff, ldsoff) __builtin_amdgcn_raw_ptr_buffer_load_lds(rsrc, (LAS void*)(lds + (ldsoff) + ldsw), 16, (int)(voff), (int)(soff), 0, 0)
#define G8_STAGE_B(b, h, sb) do { const unsigned s_ = (sb) + (h) * hB; G8_BLDS(rB, vb0, s_, G8_SB(b, h)); G8_BLDS(rB, vb0, s_ + qB, G8_SB(b, h) + 8192); } while (0)
#define G8_STAGE_A(b, h, sa, VV) do { if constexpr (Sched::GATHER) { G8_BLDS(rA, VV[2 * (h)], (sa), G8_SA(b, h)); G8_BLDS(rA, VV[2 * (h) + 1], (sa), G8_SA(b, h) + 8192); } \
        else { const unsigned s_ = (sa) + (h) * hA; G8_BLDS(rA, va0, s_, G8_SA(b, h)); G8_BLDS(rA, va0, s_ + qA, G8_SA(b, h) + 8192); } } while (0)
#define G8_LD16(base, off) (*(const LAS i32x4*)(size_t)((base) + (unsigned)(off)))
#define G8_LDA(dst, b, h) do { _Pragma("unroll") for (int m = 0; m < 4; ++m) dst[m] = __builtin_shufflevector(G8_LD16(ldsA, ((b) * 2 + (h)) * HTB + m * 2048), G8_LD16(ldsA, ((b) * 2 + (h)) * HTB + m * 2048 + KSTR), 0, 1, 2, 3, 4, 5, 6, 7); } while (0)
#define G8_LDB(dst, b, h) do { _Pragma("unroll") for (int n = 0; n < 2; ++n) dst[n] = __builtin_shufflevector(G8_LD16(ldsB, ((b) * 2 + (h)) * HTB + n * 2048), G8_LD16(ldsB, ((b) * 2 + (h)) * HTB + n * 2048 + KSTR), 0, 1, 2, 3, 4, 5, 6, 7); } while (0)
#define G8_LO(x) __builtin_bit_cast(bf16x8, __builtin_shufflevector((x), (x), 0, 1, 2, 3))
#define G8_HI(x) __builtin_bit_cast(bf16x8, __builtin_shufflevector((x), (x), 4, 5, 6, 7))
#define G8_MMA(ai, bj, At, Bt) do { __builtin_amdgcn_s_setprio(1); _Pragma("unroll") for (int m = 0; m < 4; ++m) _Pragma("unroll") for (int n = 0; n < 2; ++n) { \
        if constexpr (F8) acc[ai][bj][m][n] = __builtin_amdgcn_mfma_scale_f32_16x16x128_f8f6f4(Bt[n], At[m], acc[ai][bj][m][n], 0, 0, 0, 0x7f7f7f7f, 0, 0x7f7f7f7f); \
        else { acc[ai][bj][m][n] = __builtin_amdgcn_mfma_f32_16x16x32_bf16(G8_LO(Bt[n]), G8_LO(At[m]), acc[ai][bj][m][n], 0, 0, 0); \
               acc[ai][bj][m][n] = __builtin_amdgcn_mfma_f32_16x16x32_bf16(G8_HI(Bt[n]), G8_HI(At[m]), acc[ai][bj][m][n], 0, 0, 0); } } \
        __builtin_amdgcn_s_setprio(0); } while (0)
    Unit cur, nxt; int ui = 0;
    if (!S.next(0, cur)) return;
    f32x4 acc[2][2][4][2];
#pragma unroll
    for (int a = 0; a < 2; ++a)
#pragma unroll
        for (int b = 0; b < 2; ++b)
#pragma unroll
            for (int m = 0; m < 4; ++m)
#pragma unroll
                for (int n = 0; n < 2; ++n) acc[a][b][m][n] = (f32x4){0.f, 0.f, 0.f, 0.f};
    i32x8 At[4], B0[2], B1[2];
    unsigned vA[4] = {0u, 0u, 0u, 0u};
    LAS u32x4* vnext = (LAS u32x4*)(lds + 139264 + tid * 16);
    if constexpr (Sched::GATHER) { S.aoff(cur, vA); asm volatile("" : "+v"(vA[0]), "+v"(vA[1]), "+v"(vA[2]), "+v"(vA[3])); }
    unsigned cA = cur.ao, cB = cur.bo;
    G8_STAGE_B(0, 0, cB); G8_STAGE_A(0, 0, cA, vA); G8_STAGE_B(0, 1, cB); G8_STAGE_A(0, 1, cA, vA);
    if (wr == 1) G8_BAR;
    G8_WAIT_V(4); G8_BAR;
    G8_STAGE_B(1, 0, cB + kstep); G8_STAGE_A(1, 0, cA + kstep, vA); G8_STAGE_B(1, 1, cB + kstep);
    G8_WAIT_V(6); G8_BAR;
    for (;;) {
        const bool has_next = S.next(ui + 1, nxt);
        const unsigned nA = has_next ? nxt.ao : cA, nB = has_next ? nxt.bo : cB;
        if constexpr (Sched::GATHER) { unsigned vN[4] = {vA[0], vA[1], vA[2], vA[3]};
            if (has_next) S.aoff(nxt, vN);
            *vnext = (u32x4){vN[0], vN[1], vN[2], vN[3]}; }
        if constexpr (EpiRS<Epi>::v) {
            if (wid < 4) __builtin_amdgcn_global_load_lds(E.rs + cur.pm * 256 + wid * 64 + lane, (LAS void*)(lds + LDS_RS + (ui & 1) * 1024 + wid * 256), 4, 0, 0); }
        for (int t = 0; t < nt; t += 2) {
            const bool last = (t == nt - 2);
            const unsigned a1 = cA + (unsigned)(t + 1) * kstep;
            const unsigned a2 = last ? nA : cA + (unsigned)(t + 2) * kstep, b2 = last ? nB : cB + (unsigned)(t + 2) * kstep;
            const unsigned a3 = a2 + kstep, b3 = b2 + kstep;
            G8_LDB(B0, 0, 0); G8_SCHED; G8_LDA(At, 0, 0); G8_STAGE_A(1, 1, a1, vA);
            if constexpr (Sched::GATHER) { if (last) { const u32x4 v_ = *vnext; vA[0] = v_.x; vA[1] = v_.y; vA[2] = v_.z; vA[3] = v_.w; } }
            G8_WAIT_L(8); G8_BAR; G8_WAIT_L(0); G8_MMA(0, 0, At, B0); G8_BAR; G8_SCHED;
            G8_LDB(B1, 0, 1); G8_STAGE_B(0, 0, b2);
            G8_BAR; G8_WAIT_L(0); G8_MMA(0, 1, At, B1); G8_BAR;
            G8_LDA(At, 0, 1); G8_STAGE_A(0, 0, a2, vA);
            G8_BAR; G8_WAIT_L(0); G8_MMA(1, 0, At, B0); G8_BAR; G8_SCHED;
            G8_STAGE_B(0, 1, b2);
            G8_WAIT_V(6); G8_BAR; G8_MMA(1, 1, At, B1); G8_BAR;
            G8_LDB(B0, 1, 0); G8_SCHED; G8_LDA(At, 1, 0); G8_STAGE_A(0, 1, a2, vA);
            G8_WAIT_L(8); G8_BAR; G8_WAIT_L(0); G8_MMA(0, 0, At, B0); G8_BAR; G8_SCHED;
            G8_LDB(B1, 1, 1); G8_STAGE_B(1, 0, b3);
            G8_BAR; G8_WAIT_L(0); G8_MMA(0, 1, At, B1); G8_BAR;
            G8_LDA(At, 1, 1); G8_STAGE_A(1, 0, a3, vA);
            G8_BAR; G8_WAIT_L(0); G8_MMA(1, 0, At, B0); G8_BAR; G8_SCHED;
            G8_STAGE_B(1, 1, b3);
            G8_WAIT_V(6); G8_BAR; G8_MMA(1, 1, At, B1); G8_BAR;
        }
        if constexpr (!Epi::AFTER_DRAIN) {
            if constexpr (((EPI_REP_MASK >> EpiId<Epi>::id) & 1) != 0) { const int l0_ = tid_fresh() & 63;
                if constexpr (EpiRS<Epi>::v) E(acc, cur, wr, wc, l0_ & 15, l0_ >> 4, (const LAS float*)(lds + LDS_RS + (ui & 1) * 1024));
                else if constexpr (EpiLds<Epi>::v) E(acc, cur, wr, wc, l0_ & 15, l0_ >> 4, lds); else E(acc, cur, wr, wc, l0_ & 15, l0_ >> 4);
                asm volatile("" ::: "memory");
#pragma unroll
                for (int a = 0; a < 2; ++a)
#pragma unroll
                    for (int b = 0; b < 2; ++b)
#pragma unroll
                        for (int m = 0; m < 4; ++m)
#pragma unroll
                            for (int n = 0; n < 2; ++n) asm volatile("" : "+v"(acc[a][b][m][n])); }
            const int l_ = tid_fresh() & 63;
            if constexpr (EpiRS<Epi>::v) E(acc, cur, wr, wc, l_ & 15, l_ >> 4, (const LAS float*)(lds + LDS_RS + (ui & 1) * 1024));
            else if constexpr (EpiLds<Epi>::v) E(acc, cur, wr, wc, l_ & 15, l_ >> 4, lds);
            else E(acc, cur, wr, wc, l_ & 15, l_ >> 4); }
        if (!has_next) break;
#pragma unroll
        for (int a = 0; a < 2; ++a)
#pragma unroll
            for (int b = 0; b < 2; ++b)
#pragma unroll
                for (int m = 0; m < 4; ++m)
#pragma unroll
                    for (int n = 0; n < 2; ++n) acc[a][b][m][n] = (f32x4){0.f, 0.f, 0.f, 0.f};
        cur = nxt; cA = nA; cB = nB; ++ui;
    }
    G8_WAIT_V(0);
    if (wr == 0) G8_BAR;
    G8_BAR;
    if constexpr (Epi::AFTER_DRAIN) { const int l_ = tid_fresh() & 63; E.fused(acc, cur, wr, wc, l_ & 15, l_ >> 4, lds); }
#undef G8_SA
#undef G8_SB
#undef G8_BLDS
#undef G8_STAGE_A
#undef G8_STAGE_B
#undef G8_LDA
#undef G8_LDB
#undef G8_LD16
#undef G8_LO
#undef G8_HI
#undef G8_MMA
}

struct EpiBf16 {
    static constexpr bool AFTER_DRAIN = false;
    bf16* O; int ldc;
    __device__ __forceinline__ void operator()(const f32x4 (&acc)[2][2][4][2], const Unit& u, int wr, int wc, int fr, int fq) const {
        const int row0 = u.pm * BM + wr * 64 + fr, col0 = u.pn * BM + wc * 64 + 8 * fq;
#pragma unroll
        for (int ai = 0; ai < 2; ++ai)
#pragma unroll
            for (int m = 0; m < 4; ++m) { bf16* rowp = O + (size_t)(row0 + ai * HALF + m * 16) * ldc + col0;
#pragma unroll
                for (int bj = 0; bj < 2; ++bj) { const f32x4 v0 = acc[ai][bj][m][0], v1 = acc[ai][bj][m][1];
                    u32x4 w; w.x = pk2(v0[0], v0[1]); w.y = pk2(v0[2], v0[3]); w.z = pk2(v1[0], v1[1]); w.w = pk2(v1[2], v1[3]); *(u32x4*)(rowp + bj * 32) = w; } }
    }
};
struct EpiSwiGLU {
    static constexpr bool AFTER_DRAIN = false;
    bf16* O; int ldc; const float* rs;
    __device__ __forceinline__ void operator()(const f32x4 (&acc)[2][2][4][2], const Unit& u, int wr, int wc, int fr, int fq, const LAS float* rsl) const {
        const int row0 = u.pm * BM + wr * 64 + fr, col0 = u.pn * (BM / 2) + wc * 32 + 8 * fq;
#pragma unroll
        for (int ai = 0; ai < 2; ++ai)
#pragma unroll
            for (int m = 0; m < 4; ++m) { bf16* rowp = O + (size_t)(row0 + ai * HALF + m * 16) * ldc + col0; u32x4 w; const float rr = rsl[wr * 64 + fr + ai * HALF + m * 16];
#pragma unroll
                for (int bj = 0; bj < 2; ++bj) { const f32x4 g = acc[ai][bj][m][0], up = acc[ai][bj][m][1]; const float k1 = -rr * 1.4426950408889634f, k2 = rr * rr;
                    const f32x2 a = swiglu2((f32x2){g[0], g[1]}, (f32x2){up[0], up[1]}, k1, k2), b = swiglu2((f32x2){g[2], g[3]}, (f32x2){up[2], up[3]}, k1, k2);
                    const unsigned x = pk2(a[0], a[1]), y = pk2(b[0], b[1]); if (bj == 0) { w.x = x; w.y = y; } else { w.z = x; w.w = y; } }
                *(u32x4*)rowp = w; }
    }
};
}

struct Params {
    const float* in[29];
    float* out;
    unsigned char* ws;
    int ph_lo, ph_hi;
};
enum { I_X = 0, I_NMPRE, I_NMPOST, I_NFPRE, I_NFPOST, I_WIN, I_CPE, I_CW1, I_CB1, I_CW2, I_CB2, I_CONVW, I_CONVB, I_CLNG, I_CLNB, I_WOUT, I_FWG, I_FWU, I_FWD,
       I_GWIN, I_GLNG, I_GLNB, I_GWS, I_GBS, I_GWOUT, I_MWR, I_MWG, I_MWU, I_MWD };

__device__ __forceinline__ void tr_tile(const float* src0, const float* src1, int ld, int K, bf16* dst, int k0, int n0, int mode, LAS float* scr, int lane, float f8scale = 1.f, const float* kgain = nullptr) {
    const int q = lane & 15, kr = lane >> 4;
    const int v = n0 + 4 * q;
    const float* sp = src0; int col = v; bool zero = false;
    if (mode == 1) {
        if (v < 1280) col = v;
        else if (v < 2304) { const int w = v - 1280, g32 = w >> 5, r = w & 31, ch = g32 * 16 + (r & 15); col = (r < 16) ? 1304 + ch : 1816 + ch; }
        else if (v < 2328) col = 1280 + (v - 2304);
        else zero = true;
    } else if (mode == 2) {
        const int g32 = v >> 5, r = v & 31; col = g32 * 16 + (r & 15); sp = (r < 16) ? src0 : src1;
    } else if (mode == 3 || mode == 6) {
        col = ((v >> 8) << 7) + (((v >> 5) & 3) << 5) + (((v >> 2) & 3) << 3) + (((v >> 7) & 1) << 2); sp = ((v >> 4) & 1) ? src1 : src0;
    } else if (mode == 4 || mode == 5) {
        col = (v & ~255) + (((v >> 5) & 3) << 6) + (((v >> 7) & 1) << 5) + (((v >> 2) & 3) << 3) + (((v >> 4) & 1) << 2);
    }
    f32x4 xr[16];
#pragma unroll
    for (int i = 0; i < 16; ++i) { xr[i] = (f32x4){0.f, 0.f, 0.f, 0.f}; if (!zero) xr[i] = __builtin_nontemporal_load((const f32x4*)(sp + (size_t)(k0 + kr + 4 * i) * ld + col)); }
    if (kgain) {
#pragma unroll
        for (int i = 0; i < 16; ++i) xr[i] = xr[i] * kgain[k0 + kr + 4 * i]; }
#pragma unroll
    for (int i = 0; i < 16; ++i) { LAS float* d = scr + (kr + 4 * i) * 65 + 4 * q; d[0] = xr[i][0]; d[1] = xr[i][1]; d[2] = xr[i][2]; d[3] = xr[i][3]; }
    WAVE_FENCE();
    if (mode == 3 || mode == 4) {
        const int c = lane & 3;
#pragma unroll
        for (int j = 0; j < 4; ++j) { const int n = (lane >> 2) + 16 * j; const LAS float* s = scr + (16 * c) * 65 + n;
            u32x4 o; o.x = pk4f8(s[0 * 65] * f8scale, s[1 * 65] * f8scale, s[2 * 65] * f8scale, s[3 * 65] * f8scale); o.y = pk4f8(s[4 * 65] * f8scale, s[5 * 65] * f8scale, s[6 * 65] * f8scale, s[7 * 65] * f8scale);
            o.z = pk4f8(s[8 * 65] * f8scale, s[9 * 65] * f8scale, s[10 * 65] * f8scale, s[11 * 65] * f8scale); o.w = pk4f8(s[12 * 65] * f8scale, s[13 * 65] * f8scale, s[14 * 65] * f8scale, s[15 * 65] * f8scale);
            *(u32x4*)((unsigned char*)dst + (size_t)(n0 + n) * K + k0 + 16 * c) = o; }
        WAVE_FENCE(); return; }
    const int c = lane & 7;
#pragma unroll
    for (int j = 0; j < 8; ++j) { const int n = (lane >> 3) + 8 * j; const LAS float* s = scr + (8 * c) * 65 + n;
        u32x4 o; o.x = pk2(s[0 * 65], s[1 * 65]); o.y = pk2(s[2 * 65], s[3 * 65]); o.z = pk2(s[4 * 65], s[5 * 65]); o.w = pk2(s[6 * 65], s[7 * 65]);
        *(u32x4*)(dst + (size_t)(n0 + n) * K + k0 + 8 * c) = o; }
    WAVE_FENCE();
}

template <bool BF>
__device__ __forceinline__ void row_load(const void* rowp, int lane, f32x4 (&h)[4]) {
#pragma unroll
    for (int j = 0; j < 4; ++j) {
        if (BF) { const u32x2 w = *(const u32x2*)((const bf16*)rowp + 4 * lane + 256 * j); h[j] = (f32x4){bflo(w.x), bfhi(w.x), bflo(w.y), bfhi(w.y)}; }
        else h[j] = *(const f32x4*)((const float*)rowp + 4 * lane + 256 * j); }
}
template <bool BF>
__device__ __forceinline__ void row_norm(const void* base, const bf16* mrow, const float* gpost, bf16* hout, const float* gpre, bf16* urow, int lane, f32x4 (&h)[4]) {
    row_load<BF>(base, lane, h);
    if (mrow) {
        f32x4 mv[4]; float ss = 0.f;
#pragma unroll
        for (int j = 0; j < 4; ++j) { const u32x2 w = *(const u32x2*)(mrow + 4 * lane + 256 * j); mv[j] = (f32x4){bflo(w.x), bfhi(w.x), bflo(w.y), bfhi(w.y)};
            ss += mv[j][0] * mv[j][0] + mv[j][1] * mv[j][1] + mv[j][2] * mv[j][2] + mv[j][3] * mv[j][3]; }
        const float r = rsqrtf(wave_sum(ss) * (1.f / D) + EPS);
#pragma unroll
        for (int j = 0; j < 4; ++j) { const f32x4 g = *(const f32x4*)(gpost + 4 * lane + 256 * j); h[j] = h[j] + mv[j] * r * g;
            u32x2 w; w.x = pk2(h[j][0], h[j][1]); w.y = pk2(h[j][2], h[j][3]); *(u32x2*)(hout + 4 * lane + 256 * j) = w; }
    }
    if (urow) {
        float ss = 0.f;
#pragma unroll
        for (int j = 0; j < 4; ++j) ss += h[j][0] * h[j][0] + h[j][1] * h[j][1] + h[j][2] * h[j][2] + h[j][3] * h[j][3];
        const float r = rsqrtf(wave_sum(ss) * (1.f / D) + EPS);
#pragma unroll
        for (int j = 0; j < 4; ++j) { const f32x4 g = *(const f32x4*)(gpre + 4 * lane + 256 * j); h[j] = h[j] * r * g;
            u32x2 w; w.x = pk2(h[j][0], h[j][1]); w.y = pk2(h[j][2], h[j][3]); *(u32x2*)(urow + 4 * lane + 256 * j) = w; }
    }
}

constexpr int MOE_T_GU = 16 * 112, MOE_T_D = 56 * 16, MOE_TILES = NE * (MOE_T_GU + MOE_T_D);
constexpr int MOE_N1 = 2048, MOE_N6 = 6144, MOE_N2 = 9856, MOE_TILES_LATER = MOE_N1 + MOE_N6 + MOE_N2;
constexpr int MOE_N13 = 2816;
static_assert(MOE_TILES_LATER + MOE_N13 <= MOE_TILES && MOE_N13 <= NE * MOE_T_D, "tile split");
__device__ __forceinline__ void moe_convert_tile(const Params& p, int it, LAS float* scr, int lane) {
    unsigned char* ws = p.ws;
    if (it < NE * MOE_T_GU) { const int e = it / MOE_T_GU, rr = it % MOE_T_GU;
#if MOE_F8
        tr_tile(p.in[I_MWG] + (size_t)e * D * EFF, p.in[I_MWU] + (size_t)e * D * EFF, EFF, D, (bf16*)(ws + WS_WMGU + (size_t)e * 2 * EFF * D), (rr / 112) * 64, (rr % 112) * 64, 3, scr, lane, MOE_SGU);
#else
        tr_tile(p.in[I_MWG] + (size_t)e * D * EFF, p.in[I_MWU] + (size_t)e * D * EFF, EFF, D, (bf16*)(ws + WS_WMGU) + (size_t)e * 2 * EFF * D, (rr / 112) * 64, (rr % 112) * 64, 6, scr, lane);
#endif
    } else { const int r = it - NE * MOE_T_GU, e = r / MOE_T_D, rr = r % MOE_T_D;
#if MOE_F8
        tr_tile(p.in[I_MWD] + (size_t)e * EFF * D, nullptr, D, EFFP, (bf16*)(ws + WS_WMD + (size_t)e * D * EFFP), (rr / 16) * 64, (rr % 16) * 64, 4, scr, lane, MOE_SD);
#else
        tr_tile(p.in[I_MWD] + (size_t)e * EFF * D, nullptr, D, EFF, (bf16*)(ws + WS_WMD) + (size_t)e * D * EFF, (rr / 16) * 64, (rr % 16) * 64, 0, scr, lane);
#endif
    }
}
__device__ __forceinline__ void moe_convert_range(const Params& p, LAS unsigned char* lds, int t0, int t1, int widx, int nw) {
    const int tid = tid_fresh(), lane = tid & 63, wave = tid >> 6; LAS float* scr = (LAS float*)(lds + wave * 16640);
    for (int it = t0 + widx; it < t1; it += nw) moe_convert_tile(p, it, scr, lane);
}

template <bool BF>
__device__ __forceinline__ void row_norm2(const void* baseA, const bf16* mA, bf16* houtA, bf16* uA, const void* baseB, const bf16* mB, bf16* houtB, bf16* uB,
                                          const float* gpost, const float* gpre, int lane, f32x4 (&h)[4], f32x4 (&h2)[4], float* rsA = nullptr, float* rsB = nullptr) {
    f32x4 ma[4], mb[4]; float sa = 0.f, sb = 0.f;
    row_load<BF>(baseA, lane, h); row_load<BF>(baseB, lane, h2);
#pragma unroll
    for (int j = 0; j < 4; ++j) { const u32x2 wa = *(const u32x2*)(mA + 4 * lane + 256 * j), wb = *(const u32x2*)(mB + 4 * lane + 256 * j);
        ma[j] = (f32x4){bflo(wa.x), bfhi(wa.x), bflo(wa.y), bfhi(wa.y)}; mb[j] = (f32x4){bflo(wb.x), bfhi(wb.x), bflo(wb.y), bfhi(wb.y)}; }
#pragma unroll
    for (int j = 0; j < 4; ++j) { sa += ma[j][0] * ma[j][0] + ma[j][1] * ma[j][1] + ma[j][2] * ma[j][2] + ma[j][3] * ma[j][3]; sb += mb[j][0] * mb[j][0] + mb[j][1] * mb[j][1] + mb[j][2] * mb[j][2] + mb[j][3] * mb[j][3]; }
    const float ra = rsqrtf(wave_sum(sa) * (1.f / D) + EPS), rb = rsqrtf(wave_sum(sb) * (1.f / D) + EPS);
    sa = 0.f; sb = 0.f;
#pragma unroll
    for (int j = 0; j < 4; ++j) { const f32x4 g = *(const f32x4*)(gpost + 4 * lane + 256 * j); h[j] = h[j] + ma[j] * ra * g; h2[j] = h2[j] + mb[j] * rb * g;
        u32x2 wa; wa.x = pk2(h[j][0], h[j][1]); wa.y = pk2(h[j][2], h[j][3]); *(u32x2*)(houtA + 4 * lane + 256 * j) = wa;
        u32x2 wb; wb.x = pk2(h2[j][0], h2[j][1]); wb.y = pk2(h2[j][2], h2[j][3]); *(u32x2*)(houtB + 4 * lane + 256 * j) = wb;
        sa += h[j][0] * h[j][0] + h[j][1] * h[j][1] + h[j][2] * h[j][2] + h[j][3] * h[j][3]; sb += h2[j][0] * h2[j][0] + h2[j][1] * h2[j][1] + h2[j][2] * h2[j][2] + h2[j][3] * h2[j][3]; }
    const float qa = rsqrtf(wave_sum(sa) * (1.f / D) + EPS), qb = rsqrtf(wave_sum(sb) * (1.f / D) + EPS);
    if (rsA) { if (lane == 0) { *rsA = qa; *rsB = qb; } return; }
#pragma unroll
    for (int j = 0; j < 4; ++j) { const f32x4 g = *(const f32x4*)(gpre + 4 * lane + 256 * j); h[j] = h[j] * qa * g; h2[j] = h2[j] * qb * g;
        if (uA) {
        u32x2 w; w.x = pk2(h[j][0], h[j][1]); w.y = pk2(h[j][2], h[j][3]); *(u32x2*)(uA + 4 * lane + 256 * j) = w;
        u32x2 w2; w2.x = pk2(h2[j][0], h2[j][1]); w2.y = pk2(h2[j][2], h2[j][3]); *(u32x2*)(uB + 4 * lane + 256 * j) = w2; } }
}

__device__ __forceinline__ void phase_prep(const Params& p, LAS unsigned char* lds) {
    const int tid = tid_fresh(), lane = tid & 63, wave = tid >> 6;
    const int gw = blockIdx.x * 8 + wave, NGW = gridDim.x * 8;
    LAS float* scr = (LAS float*)(lds + wave * 16640);
    unsigned char* ws = p.ws;
    constexpr int T_IN = 16 * 40, T_OUT = 16 * 16, T_GU = 16 * 88, T_DN = 44 * 16, T_GIN = 16 * 32, T_GOUT = 16 * 16, T_C1 = 2 * 32 * 4;
    constexpr int TOTAL = T_IN + T_OUT + T_GU + T_DN + T_GIN + T_GOUT + T_C1 + (MOE_TILES - MOE_TILES_LATER - MOE_N13);
    for (int it = gw; it < TOTAL; it += NGW) {
        int r = it;
        if (r < T_IN) { tr_tile(p.in[I_WIN], nullptr, IN0, D, (bf16*)(ws + WS_WIN), (r / 40) * 64, (r % 40) * 64, 1, scr, lane); continue; } r -= T_IN;
        if (r < T_OUT) { tr_tile(p.in[I_WOUT], nullptr, D, D, (bf16*)(ws + WS_WOUT), (r / 16) * 64, (r % 16) * 64, 5, scr, lane); continue; } r -= T_OUT;
#if FFN_F8
        if (r < T_GU) { tr_tile(p.in[I_FWG], p.in[I_FWU], FF, D, (bf16*)(ws + WS_WGU), (r / 88) * 64, (r % 88) * 64, 3, scr, lane, MOE_SGU); continue; } r -= T_GU;
        if (r < T_DN) { tr_tile(p.in[I_FWD], nullptr, D, FF, (bf16*)(ws + WS_WDN), (r / 16) * 64, (r % 16) * 64, 4, scr, lane, MOE_SD); continue; } r -= T_DN;
#else
        if (r < T_GU) { tr_tile(p.in[I_FWG], p.in[I_FWU], FF, D, (bf16*)(ws + WS_WGU), (r / 88) * 64, (r % 88) * 64, 6, scr, lane, 1.f, p.in[I_NFPRE]); continue; } r -= T_GU;
        if (r < T_DN) { tr_tile(p.in[I_FWD], nullptr, D, FF, (bf16*)(ws + WS_WDN), (r / 16) * 64, (r % 16) * 64, 5, scr, lane); continue; } r -= T_DN;
#endif
        if (r < T_GIN) { tr_tile(p.in[I_GWIN], nullptr, 2 * D, D, (bf16*)(ws + WS_WGIN), (r / 32) * 64, (r % 32) * 64, 5, scr, lane, 1.f, p.in[I_NMPRE] + D); continue; } r -= T_GIN;
        if (r < T_GOUT) { tr_tile(p.in[I_GWOUT], nullptr, D, D, (bf16*)(ws + WS_WGOUT), (r / 16) * 64, (r % 16) * 64, 5, scr, lane); continue; } r -= T_GOUT;
        if (r < T_C1) { const int kv = r / 128, rr = r % 128; tr_tile(p.in[I_CW1] + (size_t)kv * 2048 * 256, nullptr, 256, 2048, (bf16*)(ws + WS_WC1) + (size_t)kv * 256 * 2048, (rr / 4) * 64, (rr % 4) * 64, 0, scr, lane); continue; } r -= T_C1;
        moe_convert_tile(p, r + MOE_TILES_LATER, scr, lane);
    }
    for (int m = gw; m < NT; m += 2 * NGW) { f32x4 h[4], h2[4]; const int m2 = m + NGW; float sa = 0.f, sb = 0.f;
        row_load<false>(p.in[I_X] + (size_t)m * D, lane, h); row_load<false>(p.in[I_X] + (size_t)m2 * D, lane, h2);
#pragma unroll
        for (int j = 0; j < 4; ++j) { sa += h[j][0] * h[j][0] + h[j][1] * h[j][1] + h[j][2] * h[j][2] + h[j][3] * h[j][3]; sb += h2[j][0] * h2[j][0] + h2[j][1] * h2[j][1] + h2[j][2] * h2[j][2] + h2[j][3] * h2[j][3]; }
        const float ra = rsqrtf(wave_sum(sa) * (1.f / D) + EPS), rb = rsqrtf(wave_sum(sb) * (1.f / D) + EPS);
#pragma unroll
        for (int j = 0; j < 4; ++j) { const f32x4 g = *(const f32x4*)(p.in[I_NMPRE] + 4 * lane + 256 * j); const f32x4 a = h[j] * ra * g, b = h2[j] * rb * g;
            u32x2 w; w.x = pk2(a[0], a[1]); w.y = pk2(a[2], a[3]); *(u32x2*)((bf16*)(ws + WS_U) + (size_t)m * D + 4 * lane + 256 * j) = w;
            u32x2 w2; w2.x = pk2(b[0], b[1]); w2.y = pk2(b[2], b[3]); *(u32x2*)((bf16*)(ws + WS_U) + (size_t)m2 * D + 4 * lane + 256 * j) = w2; } }
    { const int gt = blockIdx.x * 512 + tid, NGT = gridDim.x * 512; bf16* wsb = (bf16*)(ws + WS_WSB);
      for (int i = gt; i < 8 * 128 * 128; i += NGT) { const int t = (i >> 7) & 127, s = i & 127; wsb[i] = (bf16)f2bf(s <= t ? p.in[I_GWS][i] : 0.f); } }
    if (blockIdx.x >= gridDim.x - 16) { const int b = blockIdx.x - (gridDim.x - 16), kv = b >> 3, n = (b & 7) * 32 + (tid & 31), ks = tid >> 5;
        const float* pe = p.in[I_CPE] + kv * 2048 + ks * 128; const float* w1 = p.in[I_CW1] + (size_t)kv * 2048 * 256 + (size_t)ks * 128 * 256 + n;
        float a = 0.f;
#pragma unroll 16
        for (int k = 0; k < 128; ++k) a += pe[k] * w1[(size_t)k * 256];
        __syncthreads();
        LAS float* red = (LAS float*)lds; red[tid] = a;
        __syncthreads();
        if (tid < 32) { float s = p.in[I_CB1][kv * 256 + n];
#pragma unroll
            for (int i = 0; i < 16; ++i) s += red[i * 32 + tid];
            ((float*)(ws + WS_BIAS1))[kv * 256 + n] = s; } }
    if (blockIdx.x == 1 && tid < 16) ((unsigned*)(ws + WS_CNT))[tid] = 0u;
    if (blockIdx.x == 3) { bf16* w2t = (bf16*)(ws + WS_W2T); for (int i = tid; i < 2 * 64 * 256; i += 512) { const int kv = i >> 14, n = (i >> 8) & 63, k = i & 255; w2t[i] = (bf16)f2bf(p.in[I_CW2][(size_t)kv * 256 * 64 + k * 64 + n]); } }
#if NSA_MODE >= 2
    (void)0;
#endif
}

struct EpiInProj {
    static constexpr bool AFTER_DRAIN = false;
    bf16* Q; bf16* KV; bf16* CG; float* GT;
    __device__ __forceinline__ void operator()(const f32x4 (&acc)[2][2][4][2], const g8::Unit& u, int wr, int wc, int fr, int fq) const {
        const int row0 = u.pm * 256 + wr * 64 + fr;
#pragma unroll
        for (int ai = 0; ai < 2; ++ai)
#pragma unroll
            for (int m = 0; m < 4; ++m) { const int row = row0 + ai * 128 + m * 16;
#pragma unroll
                for (int bj = 0; bj < 2; ++bj) {
                    const int cb = u.pn * 256 + bj * 128 + wc * 32 + 4 * fq;
                    if (u.pn < 2) {
#pragma unroll
                        for (int n = 0; n < 2; ++n) { const f32x4 v = acc[ai][bj][m][n] * QSCALE; u32x2 w; w.x = pk2(v[0], v[1]); w.y = pk2(v[2], v[3]); *(u32x2*)(Q + (size_t)row * 512 + cb + 16 * n) = w; }
                    } else if (u.pn < 5) {
                        const int b = row >> 12, s = row & 4095;
#pragma unroll
                        for (int n = 0; n < 2; ++n) { const int cc = cb + 16 * n - 512, j = cc >> 7, g = (cc >> 6) & 1, d = cc & 63; const f32x4 v = acc[ai][bj][m][n];
                            u32x2 w; w.x = pk2(v[0], v[1]); w.y = pk2(v[2], v[3]); *(u32x2*)(KV + ((((size_t)j * 4 + b) * 2 + g) * 4096 + s) * 64 + d) = w; }
                    } else if (u.pn < 9) {
                        const int ch = (((cb - 1280) >> 5) << 4) + 4 * fq; const f32x4 a = acc[ai][bj][m][0], bb = acc[ai][bj][m][1];
                        u32x2 w; w.x = pk2(a[0] * sigm(bb[0]), a[1] * sigm(bb[1])); w.y = pk2(a[2] * sigm(bb[2]), a[3] * sigm(bb[3])); *(u32x2*)(CG + (size_t)row * 512 + ch) = w;
                    } else {
#pragma unroll
                        for (int n = 0; n < 2; ++n) { const int cg0 = cb + 16 * n - 2304;
                            if (cg0 < 24) { const f32x4 v = acc[ai][bj][m][n]; *(f32x4*)(GT + (size_t)row * 24 + cg0) = (f32x4){sigm(v[0]), sigm(v[1]), sigm(v[2]), sigm(v[3])}; } }
                    }
                } }
    }
};

struct CmpSched {
    static constexpr bool GATHER = false;
    const bf16* A; const bf16* Bt; int pm;
    __device__ __forceinline__ int apitch() const { return 2048; }
    __device__ __forceinline__ const void* abase() const { return A; }
    __device__ __forceinline__ const void* bbase() const { return Bt; }
    __device__ __forceinline__ bool next(int i, g8::Unit& u) const { if (i > 0) return false; u.pm = pm; u.pn = 0; u.e = 0; u.ao = (unsigned)pm * 256u * 2048u; u.bo = 0u; return true; }
    __device__ __forceinline__ void aoff(const g8::Unit&, unsigned (&)[4]) const {}
};
struct EpiCmp {
    static constexpr bool AFTER_DRAIN = false;
    bf16* O; const float* bias;
    __device__ __forceinline__ void operator()(const f32x4 (&acc)[2][2][4][2], const g8::Unit& u, int wr, int wc, int fr, int fq) const {
        const int row0 = u.pm * 256 + wr * 64 + fr, col0 = wc * 32 + 4 * fq;
#pragma unroll
        for (int ai = 0; ai < 2; ++ai)
#pragma unroll
            for (int m = 0; m < 4; ++m) { bf16* rowp = O + (size_t)(row0 + ai * 128 + m * 16) * 256 + col0;
#pragma unroll
                for (int bj = 0; bj < 2; ++bj)
#pragma unroll
                    for (int n = 0; n < 2; ++n) { const f32x4 bv = *(const f32x4*)(bias + col0 + bj * 128 + n * 16); const f32x4 v = acc[ai][bj][m][n] + bv;
                        u32x2 w; w.x = pk2(gelu_tanh(v[0]), gelu_tanh(v[1])); w.y = pk2(gelu_tanh(v[2]), gelu_tanh(v[3])); *(u32x2*)(rowp + bj * 128 + n * 16) = w; } }
    }
};

__device__ __forceinline__ void phase_cmp_conv(const Params& p, LAS unsigned char* lds) {
    const int tid = tid_fresh(), lane = tid & 63, wave = tid >> 6;
    unsigned char* ws = p.ws;
    if (blockIdx.x < 16) {
        const int kv = blockIdx.x >> 3, pm = blockIdx.x & 7;
        const bf16* A = (const bf16*)(ws + WS_KV) + (size_t)kv * (4 * 2 * 4096 * 64);
        bf16* H1 = (bf16*)(ws + WS_H1C) + (size_t)kv * 2048 * 256;
        CmpSched S{A, (const bf16*)(ws + WS_WC1) + (size_t)kv * 256 * 2048, pm};
        EpiCmp E{H1, (const float*)(ws + WS_BIAS1) + kv * 256};
        g8::gemm_phase(lds, 2048, S, E);
        __threadfence(); __syncthreads();
        { const int q = lane & 31, h = lane >> 5; const bf16* w2t = (const bf16*)(ws + WS_W2T) + (size_t)kv * 64 * 256;
          const bf16* hr = H1 + (size_t)(pm * 256 + 32 * wave + q) * 256 + 8 * h;
          f32x16 a0, a1;
#pragma unroll
          for (int r = 0; r < 16; ++r) { a0[r] = 0.f; a1[r] = 0.f; }
#pragma unroll 4
          for (int ks = 0; ks < 16; ++ks) { const bf16x8 Af = *(const bf16x8*)(hr + 16 * ks);
              const bf16x8 B0 = *(const bf16x8*)(w2t + (size_t)q * 256 + 16 * ks + 8 * h), B1 = *(const bf16x8*)(w2t + (size_t)(32 + q) * 256 + 16 * ks + 8 * h);
              a0 = MFMA32(Af, B0, a0); a1 = MFMA32(Af, B1, a1); }
          bf16* O = (bf16*)(ws + (kv == 0 ? WS_KC : WS_VC)); bf16* VCT = (bf16*)(ws + WS_VCT);
          const float b20 = p.in[I_CB2][kv * 64 + q], b21 = p.in[I_CB2][kv * 64 + 32 + q];
#pragma unroll
          for (int r = 0; r < 16; ++r) { const int rl = 32 * wave + (r & 3) + 8 * (r >> 2) + 4 * h, row = pm * 256 + rl;
              const bf16 v0 = (bf16)f2bf(a0[r] + b20), v1 = (bf16)f2bf(a1[r] + b21);
              O[(size_t)row * 64 + q] = v0; O[(size_t)row * 64 + 32 + q] = v1;
              if (kv == 1) { VCT[((size_t)pm * 64 + q) * 256 + rl] = v0; VCT[((size_t)pm * 64 + 32 + q) * 256 + rl] = v1; } } }
    } else {
        const bf16* CG = (const bf16*)(ws + WS_CGLU); bf16* CAT = (bf16*)(ws + WS_CAT);
        const int gw = (blockIdx.x - 16) * 8 + wave, NGW = (gridDim.x - 16) * 8;
        { LAS bf16* ct = (LAS bf16*)lds;
          LAS float* yb = (LAS float*)(lds + 73728);
          float wg[31];
#pragma unroll
          for (int w = 0; w < 31; ++w) wg[w] = p.in[I_CONVW][w * 512 + tid];
          const float cb = p.in[I_CONVB][tid];
          const int ch0 = 8 * lane;
          const f32x4 lg0 = *(const f32x4*)(p.in[I_CLNG] + ch0), lg1 = *(const f32x4*)(p.in[I_CLNG] + ch0 + 4), lb0 = *(const f32x4*)(p.in[I_CLNB] + ch0), lb1 = *(const f32x4*)(p.in[I_CLNB] + ch0 + 4);
          for (int tile = blockIdx.x - 16; tile < NT / 16; tile += gridDim.x - 16) {
            const int tok0 = tile * 16, s0 = tok0 & 4095;
#pragma unroll
            for (int it = 0; it < 6; ++it) { const int i = tid + 512 * it; if (i < 46 * 64) { const int j = i >> 6, c8 = (i & 63) * 8; u32x4 v = (u32x4){0u, 0u, 0u, 0u};
                if (s0 - 30 + j >= 0) v = *(const u32x4*)(CG + (size_t)(tok0 - 30 + j) * 512 + c8);
                *(LAS u32x4*)(ct + j * 512 + c8) = v; } }
            __syncthreads();
            { float c[46];
#pragma unroll
              for (int j = 0; j < 46; ++j) c[j] = bf2f(ct[j * 512 + tid]);
#pragma unroll
              for (int t = 0; t < 16; ++t) { float a = cb;
#pragma unroll
                  for (int w = 0; w < 31; ++w) a += c[t + w] * wg[w];
                  yb[t * 512 + tid] = a; } }
            __syncthreads();
#pragma unroll
            for (int i = 0; i < 2; ++i) { const int t = 2 * wave + i; const f32x4 y0 = *(const LAS f32x4*)(yb + t * 512 + ch0), y1 = *(const LAS f32x4*)(yb + t * 512 + ch0 + 4);
                const float mu = wave_sum((y0[0] + y0[1]) + (y0[2] + y0[3]) + (y1[0] + y1[1]) + (y1[2] + y1[3])) * (1.f / 512.f);
                const f32x4 d0 = y0 - mu, d1 = y1 - mu;
                const float rs = rsqrtf(wave_sum((d0[0] * d0[0] + d0[1] * d0[1]) + (d0[2] * d0[2] + d0[3] * d0[3]) + (d1[0] * d1[0] + d1[1] * d1[1]) + (d1[2] * d1[2] + d1[3] * d1[3])) * (1.f / 512.f) + EPS);
                const f32x4 o0 = d0 * rs * lg0 + lb0, o1 = d1 * rs * lg1 + lb1;
                u32x4 w; w.x = pk2(silu(o0[0]), silu(o0[1])); w.y = pk2(silu(o0[2]), silu(o0[3])); w.z = pk2(silu(o1[0]), silu(o1[1])); w.w = pk2(silu(o1[2]), silu(o1[3]));
                *(u32x4*)(CAT + (size_t)(tok0 + t) * 1024 + 512 + ch0) = w; }
          } }
#if NSA_VT
        LAS bf16* sc = (LAS bf16*)(lds + wave * 8704);
        const bf16* KV = (const bf16*)(ws + WS_KV); bf16* VT = (bf16*)(ws + WS_VT); const size_t kvs = (size_t)4 * 2 * 4096 * 64;
        for (int it = gw; it < 2 * 8 * 64; it += NGW) {
            const int jj = it >> 9, bgx = (it >> 6) & 7, st = it & 63;
            const bf16* src = KV + (size_t)(3 + 2 * jj) * kvs + ((size_t)bgx * 4096 + st * 64) * 64;
            bf16* dst = VT + ((size_t)(jj * 8 + bgx) * 64) * 4096 + st * 64;
#pragma unroll
            for (int i = 0; i < 8; ++i) { const int row = (lane >> 3) + 8 * i, ch = lane & 7; const u32x4 v = *(const u32x4*)(src + row * 64 + ch * 8);
                *(LAS u32x2*)(sc + row * 68 + ch * 8) = (u32x2){v.x, v.y}; *(LAS u32x2*)(sc + row * 68 + ch * 8 + 4) = (u32x2){v.z, v.w}; }
            WAVE_FENCE();
#pragma unroll
            for (int i = 0; i < 8; ++i) { const int d = (lane >> 3) + 8 * i, c8 = (lane & 7) * 8; const LAS bf16* s = sc + c8 * 68 + d;
                u32x4 o; o.x = (unsigned)s[0] | ((unsigned)s[68] << 16); o.y = (unsigned)s[2 * 68] | ((unsigned)s[3 * 68] << 16);
                o.z = (unsigned)s[4 * 68] | ((unsigned)s[5 * 68] << 16); o.w = (unsigned)s[6 * 68] | ((unsigned)s[7 * 68] << 16);
                *(u32x4*)(dst + (size_t)d * 4096 + c8) = o; }
            WAVE_FENCE();
        }
#endif
        __syncthreads();
        moe_convert_range(p, lds, MOE_N1 + MOE_N6, MOE_TILES_LATER, gw, NGW);
    }
}

__device__ __forceinline__ float dot64(const LAS float* q, const bf16* krow) {
    float a = 0.f;
#pragma unroll
    for (int c = 0; c < 8; ++c) { const u32x4 v = *(const u32x4*)(krow + 8 * c); const f32x4 q0 = *(const LAS f32x4*)(q + 8 * c), q1 = *(const LAS f32x4*)(q + 8 * c + 4);
        a += q0[0] * bflo(v.x) + q0[1] * bfhi(v.x) + q0[2] * bflo(v.y) + q0[3] * bfhi(v.y) + q1[0] * bflo(v.z) + q1[1] * bfhi(v.z) + q1[2] * bflo(v.w) + q1[3] * bfhi(v.w); }
    return a;
}
__device__ __forceinline__ void phase_nsa_simple(const Params& p, LAS unsigned char* lds) {
    const int tid = tid_fresh(), lane = tid & 63, wave = tid >> 6;
    unsigned char* ws = p.ws;
    LAS float* qs = (LAS float*)(lds + wave * 8192);
    LAS float* pb = qs + 256;
    LAS float* ocb = pb + 1024;
    const bf16* Q = (const bf16*)(ws + WS_Q); const bf16* KV = (const bf16*)(ws + WS_KV); const float* GT = (const float*)(ws + WS_GATES);
    const bf16* KC = (const bf16*)(ws + WS_KC); const bf16* VC = (const bf16*)(ws + WS_VC); bf16* CAT = (bf16*)(ws + WS_CAT);
    const int gw = blockIdx.x * 8 + wave, NGW = gridDim.x * 8;
    for (int it = gw; it < NT * 2; it += NGW) {
        const int g = it & 1, tok = it >> 1, b = tok >> 12, t = tok & 4095, bg = b * 2 + g;
        { const u32x2 w = *(const u32x2*)(Q + (size_t)tok * 512 + g * 256 + 4 * lane); *(LAS f32x4*)(qs + 4 * lane) = (f32x4){bflo(w.x), bfhi(w.x), bflo(w.y), bfhi(w.y)}; }
        WAVE_FENCE();
        const size_t kvs = (size_t)4 * 2 * 4096 * 64;
        const bf16* kslc = KV + 2 * kvs + (size_t)bg * 4096 * 64; const bf16* vslc = KV + 3 * kvs + (size_t)bg * 4096 * 64;
        const bf16* kwin = KV + 4 * kvs + (size_t)bg * 4096 * 64; const bf16* vwin = KV + 5 * kvs + (size_t)bg * 4096 * 64;
        const bf16* kc = KC + (size_t)bg * 256 * 64; const bf16* vc = VC + (size_t)bg * 256 * 64;
        const int nvis = t >= 31 ? (t - 31) / 16 + 1 : 0;
        float imp = 0.f;
        for (int hg = 0; hg < 4; ++hg) {
            float s[4]; float mx = -1e30f;
#pragma unroll
            for (int i = 0; i < 4; ++i) { const int n = lane + 64 * i; s[i] = (n < nvis) ? dot64(qs + hg * 64, kc + (size_t)n * 64) * (1.f / 1.4426950408889634f) : -1e30f; mx = fmaxf(mx, s[i]); }
            mx = wave_max(mx); float l = 0.f;
#pragma unroll
            for (int i = 0; i < 4; ++i) { const int n = lane + 64 * i; s[i] = (n < nvis) ? __expf(s[i] - mx) : 0.f; l += s[i]; }
            l = wave_sum(l); const float il = nvis > 0 ? 1.f / l : 0.f;
#pragma unroll
            for (int i = 0; i < 4; ++i) pb[lane + 64 * i] = s[i] * il;
            WAVE_FENCE();
            { float a = 0.f;
#pragma unroll
              for (int d = -1; d < 4; ++d) { const int n = 4 * lane + d; if (n >= 0) a += pb[n]; }
              imp += a; }
            float o = 0.f;
            for (int n = 0; n < nvis; ++n) o += pb[n] * bf2f(vc[(size_t)n * 64 + lane]);
            ocb[hg * 64 + lane] = o;
            WAVE_FENCE();
        }
        const int cur = t >> 6;
        const bool valid = lane <= cur, forced = (lane == 0) || (lane == cur) || (lane == cur - 1);
        const float score = valid ? imp + (forced ? 1e6f : 0.f) : -1e9f;
        int rank = 0;
        for (int i = 0; i < 64; ++i) { const float si = __shfl(score, i); rank += (si > score || (si == score && i < lane)) ? 1 : 0; }
        const unsigned long long selmask = __ballot(rank < 16);
#if NSA_MODE >= 2
        if (lane == 0) ((unsigned long long*)(ws + WS_PROBE + 4096))[(size_t)tok * 2 + g] = selmask;
#endif
        for (int hg = 0; hg < 4; ++hg) {
            const LAS float* qh = qs + hg * 64;
            float s[16]; float mx = -1e30f; unsigned long long mm = selmask;
#pragma unroll
            for (int i = 0; i < 16; ++i) { const int jb = __builtin_ctzll(mm); mm &= mm - 1; const int pos = jb * 64 + lane;
                s[i] = (pos <= t) ? dot64(qh, kslc + (size_t)pos * 64) * (1.f / 1.4426950408889634f) : -1e30f; mx = fmaxf(mx, s[i]); }
            mx = wave_max(mx); float l = 0.f; mm = selmask;
#pragma unroll
            for (int i = 0; i < 16; ++i) { const int jb = __builtin_ctzll(mm); mm &= mm - 1; const int pos = jb * 64 + lane; s[i] = (pos <= t) ? __expf(s[i] - mx) : 0.f; l += s[i]; }
            l = wave_sum(l); const float il = 1.f / l;
#pragma unroll
            for (int i = 0; i < 16; ++i) pb[i * 64 + lane] = s[i] * il;
            WAVE_FENCE();
            float os = 0.f; mm = selmask;
            for (int i = 0; i < 16; ++i) { const int jb = __builtin_ctzll(mm); mm &= mm - 1; if (jb * 64 > t) continue;
                const bf16* vb = vslc + (size_t)jb * 64 * 64 + lane;
                for (int k = 0; k < 64; ++k) os += pb[i * 64 + k] * bf2f(vb[k * 64]); }
            WAVE_FENCE();
            float sw[8]; mx = -1e30f;
#pragma unroll
            for (int i = 0; i < 8; ++i) { const int pos = t - 511 + lane + 64 * i; sw[i] = (pos >= 0) ? dot64(qh, kwin + (size_t)pos * 64) * (1.f / 1.4426950408889634f) : -1e30f; mx = fmaxf(mx, sw[i]); }
            mx = wave_max(mx); l = 0.f;
#pragma unroll
            for (int i = 0; i < 8; ++i) { const int pos = t - 511 + lane + 64 * i; sw[i] = (pos >= 0) ? __expf(sw[i] - mx) : 0.f; l += sw[i]; }
            l = wave_sum(l); const float ilw = 1.f / l;
#pragma unroll
            for (int i = 0; i < 8; ++i) pb[i * 64 + lane] = sw[i] * ilw;
            WAVE_FENCE();
            float ow = 0.f;
            { const int p0 = t - 511; for (int k = (p0 < 0 ? -p0 : 0); k < 512; ++k) ow += pb[k] * bf2f(vwin[(size_t)(p0 + k) * 64 + lane]); }
            WAVE_FENCE();
            const float* gt = GT + (size_t)tok * 24 + g * 12 + hg * 3;
            const float o = gt[0] * ocb[hg * 64 + lane] + gt[1] * os + gt[2] * ow;
            CAT[(size_t)tok * 1024 + g * 256 + hg * 64 + lane] = (bf16)f2bf(o);
        }
        WAVE_FENCE();
    }
}


#ifndef NSA_MODE
#define NSA_MODE 1
#endif
constexpr int NSA_KB = 0, NSA_VB = 16384, NSA_IMP = 32768, NSA_IST = 66, NSA_SEL = NSA_IMP + 4 * 64 * NSA_IST * 4;
constexpr float LOG2E = 1.0f;

__device__ __forceinline__ void nsa_load(const bf16* k, const bf16* vt, int vstride, int tid, u32x4& kr, u32x4& vr) {
    kr = *(const u32x4*)(k + tid * 8);
    vr = *(const u32x4*)(vt + (size_t)(tid >> 3) * vstride + (tid & 7) * 8);
}
__device__ __forceinline__ void nsa_store(LAS unsigned char* lds, int buf, int tid, const u32x4& kr, const u32x4& vr) {
    const int row = tid >> 3, ch = tid & 7, off = buf * 8192 + row * 128 + ((ch ^ (row & 7)) << 4);
    *(LAS u32x4*)(lds + NSA_KB + off) = kr; *(LAS u32x4*)(lds + NSA_VB + off) = vr;
}
__device__ __forceinline__ void nsa_qk(const LAS unsigned char* kb, const bf16x8 (&Qf)[4], const int (&koff)[4], f32x16& S0, f32x16& S1) {
#pragma unroll
    for (int r = 0; r < 16; ++r) { S0[r] = 0.f; S1[r] = 0.f; }
#pragma unroll
    for (int ks = 0; ks < 4; ++ks) { const bf16x8 k0 = *(const LAS bf16x8*)(kb + koff[ks]), k1 = *(const LAS bf16x8*)(kb + 4096 + koff[ks]);
        S0 = MFMA32(k0, Qf[ks], S0); S1 = MFMA32(k1, Qf[ks], S1); }
}
__device__ __forceinline__ void nsa_mask(f32x16& S0, f32x16& S1, int lo, int hi) {
#pragma unroll
    for (int r = 0; r < 16; ++r) { const int c = 16 * (r >> 3) + (r & 7);
        S0[r] = (c >= lo && c <= hi) ? S0[r] : -1e30f; S1[r] = (c + 32 >= lo && c + 32 <= hi) ? S1[r] : -1e30f; }
}
__device__ __forceinline__ float nsa_rowmax(const f32x16& S0, const f32x16& S1) {
    float mx = fmaxf(S0[0], S1[0]);
#pragma unroll
    for (int r = 1; r < 16; ++r) mx = fmaxf(mx, fmaxf(S0[r], S1[r]));
    return fmaxf(mx, __shfl_xor(mx, 32));
}
__device__ __forceinline__ void nsa_pv(const LAS unsigned char* vb, const f32x16& S0, const f32x16& S1, const int (&voff)[4], f32x16 (&O)[2]) {
#pragma unroll
    for (int s = 0; s < 4; ++s) { u32x4 w;
        if (s < 2) { w.x = pk2(S0[8 * (s & 1) + 0], S0[8 * (s & 1) + 1]); w.y = pk2(S0[8 * (s & 1) + 2], S0[8 * (s & 1) + 3]); w.z = pk2(S0[8 * (s & 1) + 4], S0[8 * (s & 1) + 5]); w.w = pk2(S0[8 * (s & 1) + 6], S0[8 * (s & 1) + 7]); }
        else       { w.x = pk2(S1[8 * (s & 1) + 0], S1[8 * (s & 1) + 1]); w.y = pk2(S1[8 * (s & 1) + 2], S1[8 * (s & 1) + 3]); w.z = pk2(S1[8 * (s & 1) + 4], S1[8 * (s & 1) + 5]); w.w = pk2(S1[8 * (s & 1) + 6], S1[8 * (s & 1) + 7]); }
        const bf16x8 Pf = __builtin_bit_cast(bf16x8, w);
#pragma unroll
        for (int mt = 0; mt < 2; ++mt) { const bf16x8 Vf = *(const LAS bf16x8*)(vb + mt * 4096 + voff[s]); O[mt] = MFMA32(Vf, Pf, O[mt]); } }
}
template <bool WITH_O>
__device__ __forceinline__ void nsa_online(f32x16& S0, f32x16& S1, float& m, float& l, f32x16 (&O)[2]) {
    const float mx = nsa_rowmax(S0, S1), mn = fmaxf(m, mx), alpha = __builtin_amdgcn_exp2f((m - mn) * LOG2E), mb = mn <= -1e29f ? 0.f : mn * LOG2E;
    float rs = 0.f;
#pragma unroll
    for (int r = 0; r < 16; ++r) { S0[r] = __builtin_amdgcn_exp2f(fmaf(S0[r], LOG2E, -mb)); S1[r] = __builtin_amdgcn_exp2f(fmaf(S1[r], LOG2E, -mb)); rs += S0[r] + S1[r]; }
    l = l * alpha + rs; m = mn;
    if (WITH_O) {
#pragma unroll
        for (int r = 0; r < 16; ++r) { O[0][r] *= alpha; O[1][r] *= alpha; } }
}

__device__ __forceinline__ void phase_nsa_fast(const Params& p, LAS unsigned char* lds, bf16* CATo, const unsigned long long* sel_in, unsigned long long* sel_out) {
    const int tid = tid_fresh(), lane = tid & 63, wave = __builtin_amdgcn_readfirstlane(tid >> 6);
    const int hg = wave & 3, th = wave >> 2, q = lane & 31, h = lane >> 5;
    unsigned char* ws = p.ws;
    const bf16* Q = (const bf16*)(ws + WS_Q); const bf16* KV = (const bf16*)(ws + WS_KV); const float* GT = (const float*)(ws + WS_GATES);
    const bf16* KC = (const bf16*)(ws + WS_KC); const bf16* VCT = (const bf16*)(ws + WS_VCT); const bf16* VT = (const bf16*)(ws + WS_VT);
    const size_t kvs = (size_t)4 * 2 * 4096 * 64;
    LAS float* imp = (LAS float*)(lds + NSA_IMP);
    LAS unsigned long long* sel = (LAS unsigned long long*)(lds + NSA_SEL);
    int koff[4], voff[4];
    { const int pr = (q & ~12) | ((q & 4) << 1) | ((q & 8) >> 1);
      const int hxk = h ^ (pr & 7), hxv = h ^ (q & 7);
#pragma unroll
      for (int s = 0; s < 4; ++s) { koff[s] = pr * 128 + (((2 * s) ^ hxk) << 4); voff[s] = q * 128 + (((2 * s) ^ hxv) << 4); } }
    for (int u = blockIdx.x; u < 256; u += gridDim.x) {
        const int bg = u & 7, pair = u >> 3, b = bg >> 1, g = bg & 1;
#ifndef NSA_HALVES
#define NSA_HALVES 2
#endif
        for (int half = 0; half < NSA_HALVES; ++half) {
            const int qt = (half & 1) ? pair : 63 - pair, t0 = qt * 64, tl = 32 * th + q, t = t0 + tl, tok = b * 4096 + t;
            bf16x8 Qf[4];
#pragma unroll
            for (int ks = 0; ks < 4; ++ks) { const u32x4 w = *(const u32x4*)(Q + (size_t)tok * 512 + g * 256 + hg * 64 + 16 * ks + 8 * h); u32x4 o;
                Qf[ks] = __builtin_bit_cast(bf16x8, w); }
            const float g0 = GT[(size_t)tok * 24 + g * 12 + hg * 3 + 0], g1 = GT[(size_t)tok * 24 + g * 12 + hg * 3 + 1], g2 = GT[(size_t)tok * 24 + g * 12 + hg * 3 + 2];
            if (tid == 0) sel[64] = 0ull;
            f32x16 OA[2], O[2], S0, S1; u32x4 kr, vr;
            const int nvis = t >= 31 ? (t - 31) / 16 + 1 : 0, ntc = (4 * qt + 3 + 63) >> 6;
            const bf16* kcb = KC + (size_t)bg * 256 * 64; const bf16* vcb = VCT + (size_t)bg * 64 * 256;
            float mc = -1e30f, lc = 0.f;
            nsa_load(kcb, vcb, 256, tid, kr, vr); nsa_store(lds, 0, tid, kr, vr); __syncthreads();
            for (int ct = 0; ct < ntc; ++ct) { const int buf = ct & 1;
                if (ct + 1 < ntc) nsa_load(kcb + (size_t)(ct + 1) * 64 * 64, vcb + (ct + 1) * 64, 256, tid, kr, vr);
                nsa_qk(lds + NSA_KB + buf * 8192, Qf, koff, S0, S1); nsa_mask(S0, S1, -1000, nvis - 64 * ct - 1 - 8 * h);
                nsa_online<false>(S0, S1, mc, lc, O);
                if (ct + 1 < ntc) nsa_store(lds, buf ^ 1, tid, kr, vr);
                __syncthreads(); }
            { const float lt = lc + __shfl_xor(lc, 32), il = lt > 0.f ? 1.f / lt : 0.f, mb = mc <= -1e29f ? 0.f : mc * LOG2E;
#pragma unroll
              for (int r = 0; r < 16; ++r) { O[0][r] = 0.f; O[1][r] = 0.f; }
              float carry_prev = 0.f;
              nsa_load(kcb, vcb, 256, tid, kr, vr); nsa_store(lds, 0, tid, kr, vr); __syncthreads();
              for (int ct = 0; ct < ntc; ++ct) { const int buf = ct & 1;
                if (ct + 1 < ntc) nsa_load(kcb + (size_t)(ct + 1) * 64 * 64, vcb + (ct + 1) * 64, 256, tid, kr, vr);
                nsa_qk(lds + NSA_KB + buf * 8192, Qf, koff, S0, S1); nsa_mask(S0, S1, -1000, nvis - 64 * ct - 1 - 8 * h);
#pragma unroll
                for (int r = 0; r < 16; ++r) { S0[r] = __builtin_amdgcn_exp2f(fmaf(S0[r], LOG2E, -mb)) * il; S1[r] = __builtin_amdgcn_exp2f(fmaf(S1[r], LOG2E, -mb)) * il; }
                LAS float* row = imp + (hg * 64 + tl) * NSA_IST + 16 * ct + 2 * h;
#pragma unroll
                for (int sx = 0; sx < 4; ++sx) { const int x8 = 8 * (sx & 1);
                    float p0, p1, p2, p3, p4, p5, p6, p7;
                    if (sx < 2) { p0 = S0[x8]; p1 = S0[x8 + 1]; p2 = S0[x8 + 2]; p3 = S0[x8 + 3]; p4 = S0[x8 + 4]; p5 = S0[x8 + 5]; p6 = S0[x8 + 6]; p7 = S0[x8 + 7]; }
                    else        { p0 = S1[x8]; p1 = S1[x8 + 1]; p2 = S1[x8 + 2]; p3 = S1[x8 + 3]; p4 = S1[x8 + 4]; p5 = S1[x8 + 5]; p6 = S1[x8 + 6]; p7 = S1[x8 + 7]; }
                    const float recv = __shfl_xor(p7, 32), cin = h ? recv : carry_prev; carry_prev = recv;
                    const float a0 = (((cin + p0) + p1) + p2) + p3, a1 = (((p3 + p4) + p5) + p6) + p7;
                    *(LAS f32x2*)(row + 4 * sx) = (f32x2){a0, a1}; }
                nsa_pv(lds + NSA_VB + buf * 8192, S0, S1, voff, O);
                if (ct + 1 < ntc) nsa_store(lds, buf ^ 1, tid, kr, vr);
                __syncthreads(); }
#pragma unroll
              for (int r = 0; r < 16; ++r) { OA[0][r] = g0 * O[0][r]; OA[1][r] = g0 * O[1][r]; } }
            { unsigned long long orm = 0ull;
              for (int i = 0; i < 8; ++i) { const int tk = wave * 8 + i; unsigned long long msk;
                if (sel_in) msk = sel_in[(size_t)(b * 4096 + t0 + tk) * 2 + g];
                else { const LAS float* sl = imp + tk * NSA_IST + lane;
                    const float im = ((sl[0] + sl[64 * NSA_IST]) + sl[2 * 64 * NSA_IST]) + sl[3 * 64 * NSA_IST];
                    const bool valid = lane <= qt, forced = (lane == 0) || (lane == qt) || (lane == qt - 1);
                    const float score = valid ? im + (forced ? 1e6f : 0.f) : -1e9f; int rank = 0;
#pragma unroll
                    for (int j = 0; j < 64; ++j) { const float sj = __builtin_bit_cast(float, __builtin_amdgcn_readlane(__builtin_bit_cast(int, score), j)); rank += (sj > score || (sj == score && j < lane)) ? 1 : 0; }
                    msk = __ballot(rank < 16); }
                if (lane == 0) { sel[tk] = msk; if (sel_out) sel_out[(size_t)(b * 4096 + t0 + tk) * 2 + g] = msk; }
                orm |= msk; }
              if (lane == 0) __hip_atomic_fetch_or(sel + 64, orm, __ATOMIC_RELAXED, __HIP_MEMORY_SCOPE_WORKGROUP); }
            __syncthreads();
            const unsigned long long mysel = sel[tl];
            const unsigned long long orall = sel[64];
            const unsigned olo = __builtin_amdgcn_readfirstlane((unsigned)orall), ohi = __builtin_amdgcn_readfirstlane((unsigned)(orall >> 32));
            { unsigned long long rem = (((unsigned long long)ohi << 32) | olo) & (qt == 63 ? ~0ull : ((2ull << qt) - 1ull));
              const bf16* kb = KV + 2 * kvs + (size_t)bg * 4096 * 64; const bf16* vb = VT + (size_t)bg * 64 * 4096;
              float m = -1e30f, l = 0.f;
#pragma unroll
              for (int r = 0; r < 16; ++r) { O[0][r] = 0.f; O[1][r] = 0.f; }
              int j = __builtin_ctzll(rem); rem &= rem - 1; int buf = 0;
              nsa_load(kb + (size_t)j * 64 * 64, vb + j * 64, 4096, tid, kr, vr); nsa_store(lds, 0, tid, kr, vr); __syncthreads();
              for (;;) { const bool more = rem != 0ull; int jn = 0;
                if (more) { jn = __builtin_ctzll(rem); rem &= rem - 1; nsa_load(kb + (size_t)jn * 64 * 64, vb + jn * 64, 4096, tid, kr, vr); }
                nsa_qk(lds + NSA_KB + buf * 8192, Qf, koff, S0, S1);
                const bool rv = (mysel >> j) & 1ull;
                if (j == qt || __ballot(rv) != ~0ull) nsa_mask(S0, S1, -1000, rv ? (j == qt ? tl - 8 * h : 1000) : -2000);
                nsa_online<true>(S0, S1, m, l, O);
                nsa_pv(lds + NSA_VB + buf * 8192, S0, S1, voff, O);
                if (more) nsa_store(lds, buf ^ 1, tid, kr, vr);
                __syncthreads();
                if (!more) break; j = jn; buf ^= 1; }
              const float lt = l + __shfl_xor(l, 32), sc = g1 / lt;
#pragma unroll
              for (int r = 0; r < 16; ++r) { OA[0][r] += sc * O[0][r]; OA[1][r] += sc * O[1][r]; } }
            { const bf16* kb = KV + 4 * kvs + (size_t)bg * 4096 * 64; const bf16* vb = VT + (size_t)(8 + bg) * 64 * 4096;
              float m = -1e30f, l = 0.f;
#pragma unroll
              for (int r = 0; r < 16; ++r) { O[0][r] = 0.f; O[1][r] = 0.f; }
              const int j0 = qt > 8 ? qt - 8 : 0;
              nsa_load(kb + (size_t)j0 * 64 * 64, vb + j0 * 64, 4096, tid, kr, vr); nsa_store(lds, 0, tid, kr, vr); __syncthreads();
              for (int j = j0; j <= qt; ++j) { const int buf = (j - j0) & 1;
                if (j < qt) nsa_load(kb + (size_t)(j + 1) * 64 * 64, vb + (j + 1) * 64, 4096, tid, kr, vr);
                nsa_qk(lds + NSA_KB + buf * 8192, Qf, koff, S0, S1);
                if (j == qt || j == qt - 8) nsa_mask(S0, S1, j == qt - 8 ? tl + 1 - 8 * h : -1000, j == qt ? tl - 8 * h : 1000);
                nsa_online<true>(S0, S1, m, l, O);
                nsa_pv(lds + NSA_VB + buf * 8192, S0, S1, voff, O);
                if (j < qt) nsa_store(lds, buf ^ 1, tid, kr, vr);
                __syncthreads(); }
              const float lt = l + __shfl_xor(l, 32), sc = g2 / lt;
#pragma unroll
              for (int r = 0; r < 16; ++r) { OA[0][r] += sc * O[0][r]; OA[1][r] += sc * O[1][r]; } }
            { bf16* orow = CATo + (size_t)tok * 1024 + g * 256 + hg * 64 + 4 * h;
#pragma unroll
              for (int mt = 0; mt < 2; ++mt)
#pragma unroll
                for (int r4 = 0; r4 < 4; ++r4) { u32x2 w; w.x = pk2(OA[mt][4 * r4], OA[mt][4 * r4 + 1]); w.y = pk2(OA[mt][4 * r4 + 2], OA[mt][4 * r4 + 3]); *(u32x2*)(orow + 32 * mt + 8 * r4) = w; } }
        }
    }
}

namespace n3 {
constexpr int SLOTB = 8192, NSLOT = 3;
constexpr int L_K = 0, L_V = NSLOT * SLOTB, L_WS = 2 * NSLOT * SLOTB  , L_ACC = L_WS + 2048  ;
constexpr int ACCP = 65, L_SEL = L_ACC + 67584  , L_TL = L_SEL + 528  , L_END = L_TL + 160;
static_assert(L_END <= LDS_MISC, "NSA LDS map");
typedef short s16x4 __attribute__((ext_vector_type(4)));
typedef short v4i16_t __attribute__((ext_vector_type(4)));
typedef LAS const char* lds_cptr;
__device__ __forceinline__ int crow(int r, int hi) { return (r & 3) + 8 * (r >> 2) + 4 * hi; }
__device__ __forceinline__ void glds16(const void* gsrc, unsigned lds_dst) { unsigned keep;
    asm volatile("s_mov_b32 %0, m0\n\ts_mov_b32 m0, %2\n\ts_nop 0\n\tglobal_load_lds_dwordx4 %1, off\n\ts_mov_b32 m0, %0" : "=&s"(keep) : "v"(gsrc), "s"(lds_dst) : "memory"); }
__device__ __forceinline__ float fadd_s(float a, float b) { float r; asm("v_add_f32_e32 %0, %1, %2" : "=v"(r) : "v"(a), "v"(b)); return r; }
__device__ __forceinline__ float fsub_s(float a, float b) { float r; asm("v_sub_f32_e32 %0, %1, %2" : "=v"(r) : "v"(a), "v"(b)); return r; }
__device__ __forceinline__ void kload8(bf16x8* kf, lds_cptr kp) {
    kf[0] = *(const LAS bf16x8*)(kp);        kf[1] = *(const LAS bf16x8*)(kp + 512);  kf[2] = *(const LAS bf16x8*)(kp + 2048); kf[3] = *(const LAS bf16x8*)(kp + 2560);
    kf[4] = *(const LAS bf16x8*)(kp + 4096); kf[5] = *(const LAS bf16x8*)(kp + 4608); kf[6] = *(const LAS bf16x8*)(kp + 6144); kf[7] = *(const LAS bf16x8*)(kp + 6656); }
__device__ __forceinline__ void kload2(bf16x8* kf, lds_cptr kp, int j) { kf[2 * j] = *(const LAS bf16x8*)(kp + j * 2048); kf[2 * j + 1] = *(const LAS bf16x8*)(kp + j * 2048 + 512); }
__device__ __forceinline__ s16x4 vtr(lds_cptr p) { return __builtin_bit_cast(s16x4, __builtin_amdgcn_ds_read_tr16_b64_v4i16((LAS v4i16_t*)p)); }
#define N3_SBAR() __builtin_amdgcn_sched_barrier(0)
#define N3_WAIT_BAR(N) asm volatile("s_waitcnt vmcnt(" #N ") lgkmcnt(0)\n\ts_barrier" ::: "memory")
__device__ __forceinline__ void kmask(f32x16& p0, f32x16& p1, int lo, int hi_) {
#pragma unroll
    for (int r = 0; r < 16; ++r) { const int kv = (r & 3) + 8 * (r >> 2); if (kv < lo || kv > hi_) p0[r] = -INFINITY; if (kv + 32 < lo || kv + 32 > hi_) p1[r] = -INFINITY; }
}
__device__ __forceinline__ void prefetch0(LAS unsigned char* lds, const bf16* Kh, const bf16* Vh) {
    const int tid = tid_fresh(), lane = tid & 63; const int wid = __builtin_amdgcn_readfirstlane(tid >> 6); const unsigned lds0 = (unsigned)(size_t)lds;
    glds16(Kh + (size_t)lane * 64 + wid * 8, (unsigned)__builtin_amdgcn_readfirstlane(lds0 + L_K + wid * 1024));
    glds16(Vh + (size_t)(16 * (wid & 3) + (lane >> 2)) * 64 + (wid >> 2) * 32 + (lane & 3) * 8, (unsigned)__builtin_amdgcn_readfirstlane(lds0 + L_V + wid * 1024));
}
template <int MODE, bool PRE = false>
__device__ __forceinline__ void stream(LAS unsigned char* lds, const bf16* Qw, const bf16* Kh, const bf16* Vh, unsigned long long tmask, int NT, int qt, int tl, unsigned long long mysel, float gate) {
    constexpr int THRL = 8;
    const int tid = tid_fresh(), lane = tid & 63, r32 = lane & 31, hi = lane >> 5; const int wid = __builtin_amdgcn_readfirstlane(tid >> 6);
    const unsigned lds0 = (unsigned)(size_t)lds;
    LAS float* wsf = (LAS float*)(lds + L_WS) + wid * 64;
    LAS float* acc = (LAS float*)(lds + L_ACC) + wid * 32 * ACCP;
    const bf16* ksrc = Kh + (size_t)lane * 64 + wid * 8;
    const bf16* vsrc = Vh + (size_t)(16 * (wid & 3) + (lane >> 2)) * 64 + (wid >> 2) * 32 + (lane & 3) * 8;
    const unsigned kdst = lds0 + L_K + wid * 1024, vdst = lds0 + L_V + wid * 1024;
    unsigned long long it = tmask; int q0, q1, q2, q3 = 0;
#define N3_NEXT(Q) do { if (it != 0ull) { Q = __builtin_ctzll(it); it &= it - 1ull; } else Q = 128 | qt; } while (0)
#define N3_DMA_K(Q, slot) do { glds16(ksrc + (size_t)((Q) & 63) * 4096, (unsigned)__builtin_amdgcn_readfirstlane(kdst + (slot))); } while (0)
#define N3_DMA_V(Q, slot) do { glds16(vsrc + (size_t)((Q) & 63) * 4096, (unsigned)__builtin_amdgcn_readfirstlane(vdst + (slot))); } while (0)
    bf16x8 kf[8];
    const lds_cptr shm3 = (lds_cptr)lds; const lds_cptr kp0 = shm3 + L_K + hi * 1024 + r32 * 16; const lds_cptr vp0 = shm3 + L_V + ((lane >> 4) & 1) * 32 + (lane & 3) * 8 + (4 * hi + ((lane & 15) >> 2)) * 64;
    N3_NEXT(q0); N3_NEXT(q1); N3_NEXT(q2);
    if (!PRE) { N3_DMA_K(q0, 0); N3_DMA_V(q0, 0); }
    N3_DMA_K(q1, SLOTB);
    bf16x8 qr[4];
#pragma unroll
    for (int d0 = 0; d0 < 4; ++d0) qr[d0] = *(const bf16x8*)(Qw + (size_t)r32 * 512 + d0 * 16 + hi * 8);
    float mhat = 0.f, l_reg = 0.f; f32x16 o[2];
#pragma unroll
    for (int r = 0; r < 16; ++r) { o[0][r] = 0.f; o[1][r] = 0.f; }
    f32x16 negm;
    { float z_; asm volatile("v_mov_b32 %0, 0" : "=v"(z_));
#pragma unroll
      for (int r = 0; r < 16; ++r) negm[r] = z_; }
    asm volatile("" : "+v"(negm));
    unsigned fprev = 0xffffffffu, fnew = 0xffffffffu;
#define N3_MASK(P0, P1, Q) do { const int jt_ = (Q); const int j_ = jt_ & 63; \
        if (MODE == 1) { fnew = ((((mysel >> j_) & 1ull) != 0ull) && !(jt_ & 128)) ? 0xffffffffu : 0u; if (jt_ == qt) kmask(P0, P1, -4 * hi, tl - 4 * hi); } \
        else { if ((qt >= 8 && j_ == qt - 8) || j_ == qt || (jt_ & 128)) { int lo_ = 0, hi__ = 63; if (qt >= 8 && j_ == qt - 8) lo_ = tl + 1; if (j_ == qt) hi__ = tl; if (jt_ & 128) hi__ = -1; \
                 kmask(P0, P1, lo_ - 4 * hi, hi__ - 4 * hi); } } } while (0)
    bool resc = false;
#define N3_RESC() do { if (resc) { asm volatile("s_waitcnt lgkmcnt(0)" ::: "memory"); \
        _Pragma("unroll") for (int d_ = 0; d_ < 2; ++d_) _Pragma("unroll") for (int r = 0; r < 16; ++r) o[d_][r] *= wsf[crow(r, hi)]; } } while (0)
    f32x16 pA0, pA1, pB0, pB1;
    int sl_prev = 0, sl_cur = 0, sl_next = SLOTB;
#define N3_ROT() do { sl_prev = sl_cur; sl_cur = sl_next; sl_next = (sl_next == (NSLOT - 1) * SLOTB) ? 0 : sl_next + SLOTB; } while (0)
    N3_DMA_K(q2, 2 * SLOTB);
    N3_WAIT_BAR(3);
    { const lds_cptr kb = kp0;
#pragma unroll
      for (int d0 = 0; d0 < 4; ++d0) { const bf16x8 b0 = *(const LAS bf16x8*)(kb + d0 * 2048), b1 = *(const LAS bf16x8*)(kb + d0 * 2048 + 512);
          if (d0 == 0) { pA0 = MFMA32(b0, qr[0], negm); pA1 = MFMA32(b1, qr[0], negm); } else { pA0 = MFMA32(b0, qr[d0], pA0); pA1 = MFMA32(b1, qr[d0], pA1); } } }
    asm volatile("s_nop 15\n\ts_nop 7" : "+v"(pA0), "+v"(pA1));
    N3_MASK(pA0, pA1, q0);
    { float rm = fmaxf(pA0[0], pA1[0]);
#pragma unroll
      for (int r = 1; r < 16; ++r) rm = fmaxf(rm, fmaxf(pA0[r], pA1[r]));
      { auto rr = __builtin_amdgcn_permlane32_swap(__float_as_uint(rm), __float_as_uint(rm), false, false); rm = fmaxf(__uint_as_float(rr[0]), __uint_as_float(rr[1])); }
      if (MODE == 1) { rm = fnew ? rm : -INFINITY; fprev = fnew; }
      const float dl = rm > -3e38f ? rm : 0.f; mhat = fadd_s(mhat, dl);
#pragma unroll
      for (int r = 0; r < 16; ++r) { pA0[r] = fsub_s(pA0[r], dl); pA1[r] = fsub_s(pA1[r], dl); }
#pragma unroll
      for (int r = 0; r < 16; ++r) negm[r] = -mhat;
      asm volatile("" : "+v"(negm));
#pragma unroll
      for (int r = 0; r < 16; ++r) { pA0[r] = __builtin_amdgcn_exp2f(pA0[r]); pA1[r] = __builtin_amdgcn_exp2f(pA1[r]); } }
    N3_WAIT_BAR(0);
    N3_NEXT(q3);
    if (3 < NT) N3_DMA_K(q3, 0);
    N3_DMA_V(q1, SLOTB);
    q0 = q1; q1 = q2; q2 = q3;
    N3_ROT();
    kload8(kf, kp0 + sl_cur);
    if (3 < NT) N3_WAIT_BAR(2); else N3_WAIT_BAR(1);
    s16x4 vlo[8], vhi[8]; u32x4 pw0, pw1, pw2, pw3;
#define N3_PKW(P, B) (MODE == 1 ? (pk2(P[B], P[B + 1]) & fprev) : pk2(P[B], P[B + 1]))
#define N3_PAF(k) __builtin_bit_cast(bf16x8, pw##k)
#define N3_VFR(i) (bf16x8){vlo[i][0], vlo[i][1], vlo[i][2], vlo[i][3], vhi[i][0], vhi[i][1], vhi[i][2], vhi[i][3]}
#define N3_PIN(x) asm volatile("" : "+v"(x))
#define N3_MX3(a, b, c) __builtin_fmaxf(__builtin_fmaxf((a), (b)), (c))
#define N3_GAPA(MF, A0, A1, A2, A3, W0, W1, PW) do { MF; sacc += A0; sacc += A1; sacc += A2; sacc += A3; N3_PIN(sacc); W0; W1; N3_PIN(PW); N3_SBAR(); } while (0)
#define N3_EX(v) __builtin_amdgcn_exp2f(v)
#define N3_GAPB(MF, X, B) do { MF; X[B] = N3_EX(X[B]); X[B + 1] = N3_EX(X[B + 1]); X[B + 2] = N3_EX(X[B + 2]); X[B + 3] = N3_EX(X[B + 3]); N3_PIN(X); N3_SBAR(); } while (0)
#define N3_VRD(i) do { vlo[i] = vtr(vp_ + (((i) >> 2) * 4096 + ((i) & 3) * 1024)); vhi[i] = vtr(vp_ + (((i) >> 2) * 4096 + ((i) & 3) * 1024 + 512)); } while (0)
#define N3_KRD(G, j) do { if (G) { kload2(kf, kp0 + sl_next, j); N3_SBAR(); } } while (0)
#define N3_STEP(C0, C1, P0, P1, t, GK, GV, GL) do { N3_SBAR(); \
    const lds_cptr vp_ = vp0 + sl_prev; \
    N3_VRD(0); N3_SBAR(); float sacc = (P0[0] + P0[1]); \
    N3_GAPA(C0 = MFMA32(kf[0], qr[0], negm), P0[2], P0[3], P0[4], P0[5],     pw0[0] = N3_PKW(P0, 0), pw0[1] = N3_PKW(P0, 2), pw0); \
    N3_VRD(4); N3_SBAR(); N3_GAPA(C1 = MFMA32(kf[1], qr[0], negm), P0[6], P0[7], P0[8], P0[9],     pw0[2] = N3_PKW(P0, 4), pw0[3] = N3_PKW(P0, 6), pw0); \
    N3_VRD(1); N3_SBAR(); N3_GAPA(C0 = MFMA32(kf[2], qr[1], C0),   P0[10], P0[11], P0[12], P0[13], pw1[0] = N3_PKW(P0, 8), pw1[1] = N3_PKW(P0, 10), pw1); \
    N3_VRD(5); N3_SBAR(); N3_GAPA(C1 = MFMA32(kf[3], qr[1], C1),   P0[14], P0[15], P1[0], P1[1],   pw1[2] = N3_PKW(P0, 12), pw1[3] = N3_PKW(P0, 14), pw1); \
    N3_VRD(2); N3_SBAR(); N3_GAPA(C0 = MFMA32(kf[4], qr[2], C0),   P1[2], P1[3], P1[4], P1[5],     pw2[0] = N3_PKW(P1, 0), pw2[1] = N3_PKW(P1, 2), pw2); \
    N3_VRD(6); N3_SBAR(); N3_GAPA(C1 = MFMA32(kf[5], qr[2], C1),   P1[6], P1[7], P1[8], P1[9],     pw2[2] = N3_PKW(P1, 4), pw2[3] = N3_PKW(P1, 6), pw2); \
    N3_VRD(3); N3_SBAR(); N3_GAPA(C0 = MFMA32(kf[6], qr[3], C0),   P1[10], P1[11], P1[12], P1[13], pw3[0] = N3_PKW(P1, 8), pw3[1] = N3_PKW(P1, 10), pw3); \
    N3_VRD(7); N3_SBAR(); N3_GAPA(C1 = MFMA32(kf[7], qr[3], C1),   P1[14], P1[15], 0.f, 0.f,       pw3[2] = N3_PKW(P1, 12), pw3[3] = N3_PKW(P1, 14), pw3); \
    l_reg += (MODE == 1 ? (fprev ? sacc : 0.f) : sacc); \
    N3_NEXT(q3); if (GK) { N3_DMA_K(q3, sl_cur); } if (GV) { N3_DMA_V(q1, sl_next); } \
    N3_MASK(C0, C1, q0); q0 = q1; q1 = q2; q2 = q3; \
    { float a = N3_MX3(C0[0], C0[1], C1[0]), b = N3_MX3(C0[2], C0[3], C1[1]); a = N3_MX3(a, C1[2], C1[3]); \
      _Pragma("unroll") for (int r = 4; r < 16; r += 4) { a = N3_MX3(a, C0[r], C0[r + 1]); b = N3_MX3(b, C0[r + 2], C0[r + 3]); a = N3_MX3(a, C1[r], C1[r + 1]); b = N3_MX3(b, C1[r + 2], C1[r + 3]); } \
      float rm = __builtin_fmaxf(a, b); { auto rr = __builtin_amdgcn_permlane32_swap(__float_as_uint(rm), __float_as_uint(rm), false, false); rm = __builtin_fmaxf(__uint_as_float(rr[0]), __uint_as_float(rr[1])); } \
      if (MODE == 1) { rm = fnew ? rm : -INFINITY; fprev = fnew; } \
      resc = false; \
      if (__builtin_expect(__any(rm > (float)THRL), 0)) { const float dl = __builtin_fmaxf(rm, 0.f); mhat += dl; \
        _Pragma("unroll") for (int r = 0; r < 16; ++r) { C0[r] -= dl; C1[r] -= dl; } \
        _Pragma("unroll") for (int r = 0; r < 16; ++r) negm[r] = -mhat; asm volatile("" : "+v"(negm)); \
        const float f = __builtin_amdgcn_exp2f(-dl); l_reg *= f; if (hi == 0) wsf[r32] = f; resc = true; } } \
    N3_SBAR(); \
    N3_GAPB(o[0] = MFMA32(N3_PAF(0), N3_VFR(0), o[0]), C0, 0); \
    N3_GAPB(o[1] = MFMA32(N3_PAF(0), N3_VFR(4), o[1]), C0, 4); \
    N3_KRD(GL, 0); N3_GAPB(o[0] = MFMA32(N3_PAF(1), N3_VFR(1), o[0]), C0, 8); \
    N3_KRD(GL, 1); N3_GAPB(o[1] = MFMA32(N3_PAF(1), N3_VFR(5), o[1]), C0, 12); \
    N3_KRD(GL, 2); N3_GAPB(o[0] = MFMA32(N3_PAF(2), N3_VFR(2), o[0]), C1, 0); \
    N3_KRD(GL, 3); N3_GAPB(o[1] = MFMA32(N3_PAF(2), N3_VFR(6), o[1]), C1, 4); \
    N3_GAPB(o[0] = MFMA32(N3_PAF(3), N3_VFR(3), o[0]), C1, 8); \
    N3_GAPB(o[1] = MFMA32(N3_PAF(3), N3_VFR(7), o[1]), C1, 12); \
    } while (0)
#define N3_ENDW(tt) do { if ((tt) + 3 < NT) { N3_WAIT_BAR(2); } else if ((tt) + 2 < NT) { N3_WAIT_BAR(1); } else { N3_WAIT_BAR(0); } } while (0)
    int t = 1;
    for (; t + 5 < NT; t += 2) {
        N3_STEP(pB0, pB1, pA0, pA1, t, true, true, true);     N3_WAIT_BAR(2); N3_RESC(); N3_ROT();
        N3_STEP(pA0, pA1, pB0, pB1, t + 1, true, true, true); N3_WAIT_BAR(2); N3_RESC(); N3_ROT();
    }
    for (; t + 1 < NT; t += 2) {
        N3_STEP(pB0, pB1, pA0, pA1, t, (t + 3 < NT), (t + 1 < NT), (t + 1 < NT));     N3_ENDW(t);     N3_RESC(); N3_ROT();
        N3_STEP(pA0, pA1, pB0, pB1, t + 1, (t + 4 < NT), (t + 2 < NT), (t + 2 < NT)); N3_ENDW(t + 1); N3_RESC(); N3_ROT();
    }
    N3_STEP(pB0, pB1, pA0, pA1, NT - 1, false, false, false); N3_RESC();
    { float sacc = pB0[0] + pB0[1];
#pragma unroll
      for (int r = 2; r < 16; ++r) sacc += pB0[r];
#pragma unroll
      for (int r = 0; r < 16; ++r) sacc += pB1[r];
      l_reg += (MODE == 1 ? (fprev ? sacc : 0.f) : sacc);
      pw0 = (u32x4){N3_PKW(pB0, 0), N3_PKW(pB0, 2), N3_PKW(pB0, 4), N3_PKW(pB0, 6)}; pw1 = (u32x4){N3_PKW(pB0, 8), N3_PKW(pB0, 10), N3_PKW(pB0, 12), N3_PKW(pB0, 14)};
      pw2 = (u32x4){N3_PKW(pB1, 0), N3_PKW(pB1, 2), N3_PKW(pB1, 4), N3_PKW(pB1, 6)}; pw3 = (u32x4){N3_PKW(pB1, 8), N3_PKW(pB1, 10), N3_PKW(pB1, 12), N3_PKW(pB1, 14)};
      N3_SBAR();
      const lds_cptr vp_ = vp0 + sl_cur;
#pragma unroll
      for (int i = 0; i < 8; ++i) N3_VRD(i);
      asm volatile("s_waitcnt lgkmcnt(0)" ::: "memory"); N3_SBAR();
      o[0] = MFMA32(N3_PAF(0), N3_VFR(0), o[0]); o[0] = MFMA32(N3_PAF(1), N3_VFR(1), o[0]); o[0] = MFMA32(N3_PAF(2), N3_VFR(2), o[0]); o[0] = MFMA32(N3_PAF(3), N3_VFR(3), o[0]);
      o[1] = MFMA32(N3_PAF(0), N3_VFR(4), o[1]); o[1] = MFMA32(N3_PAF(1), N3_VFR(5), o[1]); o[1] = MFMA32(N3_PAF(2), N3_VFR(6), o[1]); o[1] = MFMA32(N3_PAF(3), N3_VFR(7), o[1]); }
    { auto rr = __builtin_amdgcn_permlane32_swap(__float_as_uint(l_reg), __float_as_uint(l_reg), false, false); l_reg = __uint_as_float(rr[0]) + __uint_as_float(rr[1]); }
    if (hi == 0) wsf[32 + r32] = gate / l_reg;
    asm volatile("s_waitcnt lgkmcnt(0)" ::: "memory");
#pragma unroll
    for (int r = 0; r < 16; ++r) { const int row = crow(r, hi); const float f = wsf[32 + row];
#pragma unroll
        for (int d0 = 0; d0 < 2; ++d0) { LAS float* a = acc + row * ACCP + d0 * 32 + r32; *a = *a + o[d0][r] * f; } }
    asm volatile("s_waitcnt lgkmcnt(0)\n\ts_barrier" ::: "memory");
#undef N3_NEXT
#undef N3_DMA_K
#undef N3_DMA_V
#undef N3_MASK
#undef N3_RESC
#undef N3_ROT
#undef N3_PKW
#undef N3_PAF
#undef N3_VFR
#undef N3_PIN
#undef N3_MX3
#undef N3_GAPA
#undef N3_EX
#undef N3_GAPB
#undef N3_VRD
#undef N3_KRD
#undef N3_STEP
#undef N3_ENDW
}
}

__device__ __forceinline__ void phase_nsa3(const Params& p, LAS unsigned char* lds, bf16* CATo, const unsigned long long* sel_in, unsigned long long* sel_out) {
    unsigned char* ws = p.ws;
    const bf16* Q = (const bf16*)(ws + WS_Q); const bf16* KV = (const bf16*)(ws + WS_KV); const float* GT = (const float*)(ws + WS_GATES);
    const bf16* KC = (const bf16*)(ws + WS_KC); const bf16* VCT = (const bf16*)(ws + WS_VCT);
    const size_t kvs = (size_t)4 * 2 * 4096 * 64;
    LAS float* imp = (LAS float*)(lds + n3::L_ACC);
    LAS unsigned long long* sel = (LAS unsigned long long*)(lds + n3::L_SEL);
    for (int u = blockIdx.x; u < 256; u += gridDim.x) {
        const int bg = u & 7, pair = u >> 3, b = bg >> 1, g = bg & 1;
        for (int half = 0; half < NSA_HALVES; ++half) {
            const int tid = tid_fresh(), lane = tid & 63, wave = __builtin_amdgcn_readfirstlane(tid >> 6);
            const int hg = wave & 3, th = wave >> 2, q = lane & 31, h = lane >> 5;
            int koff[4], voff[4];
            { const int pr = (q & ~12) | ((q & 4) << 1) | ((q & 8) >> 1); const int hxk = h ^ (pr & 7), hxv = h ^ (q & 7);
#pragma unroll
              for (int s = 0; s < 4; ++s) { koff[s] = pr * 128 + (((2 * s) ^ hxk) << 4); voff[s] = q * 128 + (((2 * s) ^ hxv) << 4); } }
            const int qt = (half & 1) ? pair : 63 - pair, t0 = qt * 64, tl = 32 * th + q, t = t0 + tl, tok = b * 4096 + t;
            bf16x8 Qf[4];
#pragma unroll
            for (int ks = 0; ks < 4; ++ks) Qf[ks] = *(const bf16x8*)(Q + (size_t)tok * 512 + g * 256 + hg * 64 + 16 * ks + 8 * h);
            const float g0 = GT[(size_t)tok * 24 + g * 12 + hg * 3 + 0], g1 = GT[(size_t)tok * 24 + g * 12 + hg * 3 + 1], g2 = GT[(size_t)tok * 24 + g * 12 + hg * 3 + 2];
            if (tid == 0) sel[64] = 0ull;
            f32x16 O[2], S0, S1; u32x4 kr, vr;
            const int nvis = t >= 31 ? (t - 31) / 16 + 1 : 0, ntc = (4 * qt + 3 + 63) >> 6;
            const bf16* kcb = KC + (size_t)bg * 256 * 64; const bf16* vcb = VCT + (size_t)bg * 64 * 256;
            float mc = -1e30f, lc = 0.f;
            nsa_load(kcb, vcb, 256, tid, kr, vr); nsa_store(lds, 0, tid, kr, vr); __syncthreads();
            for (int ct = 0; ct < ntc; ++ct) { const int buf = ct & 1;
                if (ct + 1 < ntc) nsa_load(kcb + (size_t)(ct + 1) * 64 * 64, vcb + (ct + 1) * 64, 256, tid, kr, vr);
                else nsa_load(kcb, vcb, 256, tid, kr, vr);
                nsa_qk(lds + NSA_KB + buf * 8192, Qf, koff, S0, S1); nsa_mask(S0, S1, -1000, nvis - 64 * ct - 1 - 8 * h);
                nsa_online<false>(S0, S1, mc, lc, O);
                nsa_store(lds, buf ^ 1, tid, kr, vr);
                __syncthreads(); }
            { const float lt = lc + __shfl_xor(lc, 32), il = lt > 0.f ? 1.f / lt : 0.f, mb = mc <= -1e29f ? 0.f : mc;
#pragma unroll
              for (int r = 0; r < 16; ++r) { O[0][r] = 0.f; O[1][r] = 0.f; }
              float carry_prev = 0.f;
              for (int ct = 0; ct < ntc; ++ct) { const int buf = (ntc + ct) & 1;
                if (ct + 1 < ntc) nsa_load(kcb + (size_t)(ct + 1) * 64 * 64, vcb + (ct + 1) * 64, 256, tid, kr, vr);
                nsa_qk(lds + NSA_KB + buf * 8192, Qf, koff, S0, S1); nsa_mask(S0, S1, -1000, nvis - 64 * ct - 1 - 8 * h);
#pragma unroll
                for (int r = 0; r < 16; ++r) { S0[r] = __builtin_amdgcn_exp2f(S0[r] - mb) * il; S1[r] = __builtin_amdgcn_exp2f(S1[r] - mb) * il; }
                LAS float* row = imp + (hg * 64 + tl) * NSA_IST + 16 * ct + 2 * h;
#pragma unroll
                for (int sx = 0; sx < 4; ++sx) { const int x8 = 8 * (sx & 1);
                    float p0, p1, p2, p3, p4, p5, p6, p7;
                    if (sx < 2) { p0 = S0[x8]; p1 = S0[x8 + 1]; p2 = S0[x8 + 2]; p3 = S0[x8 + 3]; p4 = S0[x8 + 4]; p5 = S0[x8 + 5]; p6 = S0[x8 + 6]; p7 = S0[x8 + 7]; }
                    else        { p0 = S1[x8]; p1 = S1[x8 + 1]; p2 = S1[x8 + 2]; p3 = S1[x8 + 3]; p4 = S1[x8 + 4]; p5 = S1[x8 + 5]; p6 = S1[x8 + 6]; p7 = S1[x8 + 7]; }
                    const float recv = __shfl_xor(p7, 32), cin = h ? recv : carry_prev; carry_prev = recv;
                    const float a0 = (((cin + p0) + p1) + p2) + p3, a1 = (((p3 + p4) + p5) + p6) + p7;
                    *(LAS f32x2*)(row + 4 * sx) = (f32x2){a0, a1}; }
                nsa_pv(lds + NSA_VB + buf * 8192, S0, S1, voff, O);
                if (ct + 1 < ntc) nsa_store(lds, buf ^ 1, tid, kr, vr);
                __syncthreads(); } }
            n3::prefetch0(lds, KV + 2 * kvs + (size_t)bg * 4096 * 64, KV + 3 * kvs + (size_t)bg * 4096 * 64);
            { unsigned long long orm = 0ull;
              for (int i = 0; i < 8; ++i) { const int tk = wave * 8 + i; unsigned long long msk;
                if (sel_in) msk = sel_in[(size_t)(b * 4096 + t0 + tk) * 2 + g];
                else { const LAS float* sl = imp + tk * NSA_IST + lane;
                    const float im = ((sl[0] + sl[64 * NSA_IST]) + sl[2 * 64 * NSA_IST]) + sl[3 * 64 * NSA_IST];
                    const bool valid = lane <= qt, forced = (lane == 0) || (lane == qt) || (lane == qt - 1);
                    const float score = valid ? im + (forced ? 1e6f : 0.f) : -1e9f;
                    const unsigned key = valid ? __float_as_uint(score) + 1u : 0u; unsigned pre = 0u;
#pragma unroll
                    for (int bit = 30; bit >= 0; --bit) { const unsigned cand = pre | (1u << bit); if (__builtin_popcountll(__ballot(key >= cand)) >= 16) pre = cand; }
                    const unsigned long long gt = __ballot(key > pre), eq = __ballot(key == pre); const int need = 16 - __builtin_popcountll(gt);
                    const int below = __builtin_amdgcn_mbcnt_hi((unsigned)(eq >> 32), __builtin_amdgcn_mbcnt_lo((unsigned)eq, 0u));
                    msk = __ballot(key > pre || (key == pre && below < need)); }
                if (lane == 0) { sel[tk] = msk; if (sel_out) sel_out[(size_t)(b * 4096 + t0 + tk) * 2 + g] = msk; }
                orm |= msk; }
              if (lane == 0) __hip_atomic_fetch_or(sel + 64, orm, __ATOMIC_RELAXED, __HIP_MEMORY_SCOPE_WORKGROUP); }
            __syncthreads();
            const unsigned long long mysel = sel[tl];
            unsigned long long oms, omw;
            { const unsigned long long o_ = sel[64] & (qt == 63 ? ~0ull : ((2ull << qt) - 1ull));
              oms = ((unsigned long long)(unsigned)__builtin_amdgcn_readfirstlane((int)(o_ >> 32)) << 32) | (unsigned)__builtin_amdgcn_readfirstlane((int)o_);
              const int jlo = qt > 8 ? qt - 8 : 0; omw = (qt == 63 ? ~0ull : ((2ull << qt) - 1ull)) & ~((1ull << jlo) - 1ull); }
            __syncthreads();
            { LAS float* acc = (LAS float*)(lds + n3::L_ACC) + wave * 32 * n3::ACCP + q * n3::ACCP + 4 * h;
#pragma unroll
              for (int mt = 0; mt < 2; ++mt)
#pragma unroll
                for (int r = 0; r < 16; ++r) acc[32 * mt + (r & 3) + 8 * (r >> 2)] = g0 * O[mt][r]; }
            const int NTs = (__builtin_popcountll(oms) + 1) & ~1, NTw = qt == 0 ? 2 : ((__builtin_popcountll(omw) + 1) & ~1);
            const bf16* Qw = Q + (size_t)(b * 4096 + t0 + 32 * th) * 512 + g * 256 + hg * 64;
#if N3_PROBE & 1
            n3::stream<1>(lds, Qw, KV + 2 * kvs + (size_t)bg * 4096 * 64, KV + 3 * kvs + (size_t)bg * 4096 * 64, oms, NTs, qt, tl, mysel, 0.f);
#endif
            n3::stream<1, (N3_PROBE & 1) == 0>(lds, Qw, KV + 2 * kvs + (size_t)bg * 4096 * 64, KV + 3 * kvs + (size_t)bg * 4096 * 64, oms, NTs, qt, tl, mysel, g1);
#if N3_PROBE & 2
            n3::stream<2>(lds, Qw, KV + 4 * kvs + (size_t)bg * 4096 * 64, KV + 5 * kvs + (size_t)bg * 4096 * 64, omw, NTw, qt, tl, mysel, 0.f);
#endif
            n3::stream<2>(lds, Qw, KV + 4 * kvs + (size_t)bg * 4096 * 64, KV + 5 * kvs + (size_t)bg * 4096 * 64, omw, NTw, qt, tl, mysel, g2);
            { const LAS float* accw = (const LAS float*)(lds + n3::L_ACC) + wave * 32 * n3::ACCP;
#pragma unroll
              for (int i = 0; i < 4; ++i) { const int row = i * 8 + (lane >> 3), ch = lane & 7; const LAS float* a = accw + row * n3::ACCP + ch * 8;
                  u32x4 w; w.x = pk2(a[0], a[1]); w.y = pk2(a[2], a[3]); w.z = pk2(a[4], a[5]); w.w = pk2(a[6], a[7]);
                  *(u32x4*)(CATo + (size_t)(b * 4096 + t0 + 32 * th + row) * 1024 + g * 256 + hg * 64 + ch * 8) = w; } }
            __syncthreads();
        }
    }
}
#if NSA_MODE >= 2
__device__ __forceinline__ void phase_probe_cmp(const Params& p) {
    const int gt = blockIdx.x * 512 + threadIdx.x, NGT = gridDim.x * 512; float num = 0.f, den = 0.f;
#if NSA_MODE == 2
    const bf16* A = (const bf16*)(p.ws + WS_CAT); const bf16* B = (const bf16*)(p.ws + WS_M);
    for (int i = gt; i < NT * 512; i += NGT) { const size_t o = (size_t)(i >> 9) * 1024 + (i & 511); const float a = bf2f(A[o]), b = bf2f(B[o]); num += (a - b) * (a - b); den += a * a; }
#else
    const unsigned long long* A = (const unsigned long long*)(p.ws + WS_PROBE + 4096); const unsigned long long* B = A + NT * 2;
    for (int i = gt; i < NT * 2; i += NGT) { num += (A[i] != B[i]) ? 1.f : 0.f; den += 1.f; }
#endif
    num = wave_sum(num); den = wave_sum(den);
    __shared__ float red[16];
    if ((threadIdx.x & 63) == 0) { red[(threadIdx.x >> 6) * 2] = num; red[(threadIdx.x >> 6) * 2 + 1] = den; }
    __syncthreads();
    if (threadIdx.x == 0) { float a = 0.f, b = 0.f; for (int i = 0; i < 8; ++i) { a += red[2 * i]; b += red[2 * i + 1]; } float* slot = (float*)(p.ws + WS_PACC) + 2 * blockIdx.x; slot[0] = a; slot[1] = b; }
}
#endif


struct EpiRmsRes {
    static constexpr bool AFTER_DRAIN = true;
    const float* base; float* hout; bf16* U; const float* gpost; const float* gpre; float* slots; unsigned* cnts; int ex;
    __device__ __forceinline__ void operator()(const f32x4 (&)[2][2][4][2], const g8::Unit&, int, int, int, int) const {}
    __device__ __forceinline__ float row_scale(const f32x4 (&v)[2][2][4][2], const g8::Unit& u, int wr, int wc, int fr, int fq, LAS unsigned char* lds, int bank, int ai, int m) const { return 0.f; }
    __device__ __forceinline__ void exchange(const f32x4 (&v)[2][2][4][2], const g8::Unit& u, int wr, int wc, int fr, int fq, LAS unsigned char* lds, int bank) const {
        LAS float* P = (LAS float*)lds; LAS float* S = (LAS float*)(lds + 4096);
        const int tid = tid_fresh();
#pragma unroll
        for (int ai = 0; ai < 2; ++ai)
#pragma unroll
            for (int m = 0; m < 4; ++m) { float s = 0.f;
#pragma unroll
                for (int bj = 0; bj < 2; ++bj)
#pragma unroll
                    for (int n = 0; n < 2; ++n) { const f32x4 x = v[ai][bj][m][n]; s += (x[0] * x[0] + x[1] * x[1]) + (x[2] * x[2] + x[3] * x[3]); }
                s += __shfl_xor(s, 16); s += __shfl_xor(s, 32);
                if (fq == 0) P[(ai * 128 + wr * 64 + m * 16 + fr) * 4 + wc] = s; }
        __syncthreads();
        float* slot = slots + ((size_t)(bank * 64 + u.pm) * 256) * 4; unsigned* cnt = cnts + (size_t)(bank * 64 + u.pm) * 64;
        if (tid < 256) { const float t = (P[tid * 4 + 0] + P[tid * 4 + 1]) + (P[tid * 4 + 2] + P[tid * 4 + 3]);
            __hip_atomic_store(slot + tid * 4 + u.pn, t, __ATOMIC_RELAXED, __HIP_MEMORY_SCOPE_AGENT);
            asm volatile("s_waitcnt vmcnt(0)" ::: "memory");
            if ((tid & 63) == 0) __hip_atomic_fetch_add(cnt, 1u, __ATOMIC_RELAXED, __HIP_MEMORY_SCOPE_AGENT); }
        if (tid < 64) { unsigned sp = 0;
            while ((unsigned)__builtin_amdgcn_readfirstlane(__hip_atomic_load(cnt, __ATOMIC_RELAXED, __HIP_MEMORY_SCOPE_AGENT)) < 16u) { __builtin_amdgcn_s_sleep(1); if (++sp > (1u << 22)) break; }
            __builtin_amdgcn_fence(__ATOMIC_ACQUIRE, "agent");
            asm volatile("s_waitcnt vmcnt(0)" ::: "memory"); }
        __syncthreads();
        if (tid < 256) { const float a = __hip_atomic_load(slot + tid * 4 + 0, __ATOMIC_RELAXED, __HIP_MEMORY_SCOPE_AGENT), b = __hip_atomic_load(slot + tid * 4 + 1, __ATOMIC_RELAXED, __HIP_MEMORY_SCOPE_AGENT),
                        c = __hip_atomic_load(slot + tid * 4 + 2, __ATOMIC_RELAXED, __HIP_MEMORY_SCOPE_AGENT), d = __hip_atomic_load(slot + tid * 4 + 3, __ATOMIC_RELAXED, __HIP_MEMORY_SCOPE_AGENT);
            S[tid] = rsqrtf(((a + b) + (c + d)) * (1.f / 1024.f) + EPS); }
        __syncthreads();
    }
    __device__ __forceinline__ void fused(f32x4 (&acc)[2][2][4][2], const g8::Unit& u, int wr, int wc, int fr, int fq, LAS unsigned char* lds) const {
        const LAS float* S = (const LAS float*)(lds + 4096);
        const int col0 = u.pn * 256 + wc * 32 + 4 * fq;
        exchange(acc, u, wr, wc, fr, fq, lds, ex);
#pragma unroll
        for (int ai = 0; ai < 2; ++ai)
#pragma unroll
            for (int m = 0; m < 4; ++m) { const int rl = ai * 128 + wr * 64 + m * 16 + fr; const float r = S[rl]; const size_t off = (size_t)(u.pm * 256 + rl) * 1024 + col0;
#pragma unroll
                for (int bj = 0; bj < 2; ++bj)
#pragma unroll
                    for (int n = 0; n < 2; ++n) { const f32x4 g = *(const f32x4*)(gpost + col0 + bj * 128 + n * 16), bs = *(const f32x4*)(base + off + bj * 128 + n * 16);
                        const f32x4 h = bs + acc[ai][bj][m][n] * r * g; acc[ai][bj][m][n] = h; *(f32x4*)(hout + off + bj * 128 + n * 16) = h; }
                asm volatile("" ::: "memory"); }
        exchange(acc, u, wr, wc, fr, fq, lds, ex + 1);
#pragma unroll
        for (int ai = 0; ai < 2; ++ai)
#pragma unroll
            for (int m = 0; m < 4; ++m) { const int rl = ai * 128 + wr * 64 + m * 16 + fr; const float r = S[rl]; const size_t off = (size_t)(u.pm * 256 + rl) * 1024 + col0;
#pragma unroll
                for (int bj = 0; bj < 2; ++bj)
#pragma unroll
                    for (int n = 0; n < 2; ++n) { const f32x4 g = *(const f32x4*)(gpre + col0 + bj * 128 + n * 16); const f32x4 o = acc[ai][bj][m][n] * r * g;
                        u32x2 w; w.x = pk2(o[0], o[1]); w.y = pk2(o[2], o[3]); *(u32x2*)(U + off + bj * 128 + n * 16) = w; }
                asm volatile("" ::: "memory"); }
    }
};

template <bool BF>
struct EpiRmsRes2 {
    static constexpr bool AFTER_DRAIN = true;
    const void* base; bf16* H; float* rs; const float* gpost; float* slots; unsigned* cnts; int ex;
    __device__ __forceinline__ void operator()(const f32x4 (&)[2][2][4][2], const g8::Unit&, int, int, int, int) const {}
    __device__ __forceinline__ void fused(f32x4 (&acc)[2][2][4][2], const g8::Unit& u, int wr, int wc, int fr, int fq, LAS unsigned char* lds) const {
        const LAS float* S = (const LAS float*)(lds + 4096);
        const EpiRmsRes X{nullptr, nullptr, nullptr, nullptr, nullptr, slots, cnts, ex};
        const int col0 = u.pn * 256 + wc * 64 + 8 * fq;
        X.exchange(acc, u, wr, wc, fr, fq, lds, ex);
#pragma unroll
        for (int ai = 0; ai < 2; ++ai)
#pragma unroll
            for (int m = 0; m < 4; ++m) { const int rl = ai * 128 + wr * 64 + m * 16 + fr; const float r = S[rl]; const size_t off = (size_t)(u.pm * 256 + rl) * 1024 + col0;
#pragma unroll
                for (int bj = 0; bj < 2; ++bj) { const f32x4 g0 = *(const f32x4*)(gpost + col0 + bj * 32), g1 = *(const f32x4*)(gpost + col0 + bj * 32 + 4); f32x4 b0, b1;
                    if (BF) { const u32x4 w = *(const u32x4*)((const bf16*)base + off + bj * 32); b0 = (f32x4){bflo(w.x), bfhi(w.x), bflo(w.y), bfhi(w.y)}; b1 = (f32x4){bflo(w.z), bfhi(w.z), bflo(w.w), bfhi(w.w)}; }
                    else { b0 = *(const f32x4*)((const float*)base + off + bj * 32); b1 = *(const f32x4*)((const float*)base + off + bj * 32 + 4); }
                    const f32x4 h0 = b0 + acc[ai][bj][m][0] * r * g0, h1 = b1 + acc[ai][bj][m][1] * r * g1; acc[ai][bj][m][0] = h0; acc[ai][bj][m][1] = h1;
                    u32x4 o; o.x = pk2(h0[0], h0[1]); o.y = pk2(h0[2], h0[3]); o.z = pk2(h1[0], h1[1]); o.w = pk2(h1[2], h1[3]); *(u32x4*)(H + off + bj * 32) = o; }
                asm volatile("" ::: "memory"); }
        X.exchange(acc, u, wr, wc, fr, fq, lds, ex + 1);
        if (u.pn == 0) { const int tid = tid_fresh(); if (tid < 256) rs[u.pm * 256 + tid] = S[tid]; }
    }
};

template <bool BF>
__device__ __forceinline__ void phase_norm(const Params& p, const void* base, const float* gpost, const float* gpre, unsigned char* u8, float* rs = nullptr) {
    const int tid_ = tid_fresh(), lane = tid_ & 63, wave = tid_ >> 6; const int gw = blockIdx.x * 8 + wave, NGW = gridDim.x * 8;
    const bf16* M = (const bf16*)(p.ws + WS_M); bf16* U = (bf16*)(p.ws + WS_U); bf16* H = (bf16*)(p.ws + WS_H);
    constexpr int ES = BF ? 2 : 4;
    for (int m = gw; m < NT; m += 2 * NGW) { f32x4 h[4], h2[4]; const int m2 = m + NGW;
        row_norm2<BF>((const char*)base + (size_t)m * D * ES, M + (size_t)m * D, H + (size_t)m * D, U + (size_t)m * D, (const char*)base + (size_t)m2 * D * ES, M + (size_t)m2 * D, H + (size_t)m2 * D, U + (size_t)m2 * D, gpost, gpre, lane, h, h2, rs ? rs + m : nullptr, rs ? rs + m2 : nullptr);
        if (u8) {
#pragma unroll
            for (int j = 0; j < 4; ++j) { *(unsigned*)(u8 + (size_t)m * D + 4 * lane + 256 * j) = pk4f8(h[j][0], h[j][1], h[j][2], h[j][3]); *(unsigned*)(u8 + (size_t)m2 * D + 4 * lane + 256 * j) = pk4f8(h2[j][0], h2[j][1], h2[j][2], h2[j][3]); } } }
}

struct EpiGmlpIn {
    static constexpr bool AFTER_DRAIN = false;
    bf16* Z; f32x2* ST; const float* rs;
    __device__ __forceinline__ void operator()(const f32x4 (&acc)[2][2][4][2], const g8::Unit& u, int wr, int wc, int fr, int fq, const LAS float* rsl) const {
        const int row0 = u.pm * 256 + wr * 64 + fr, col0 = u.pn * 256 + wc * 64 + 8 * fq;
#pragma unroll
        for (int ai = 0; ai < 2; ++ai)
#pragma unroll
            for (int m = 0; m < 4; ++m) { const int row = row0 + ai * 128 + m * 16; bf16* rowp = Z + (size_t)row * 2048 + col0; float s = 0.f, q = 0.f; const float rr = rsl[row - u.pm * 256];
#pragma unroll
                for (int bj = 0; bj < 2; ++bj) { u32x4 w;
#pragma unroll
                    for (int n = 0; n < 2; ++n) { const f32x4 v = acc[ai][bj][m][n]; const f32x2 y0 = gelu_tanh2((f32x2){v[0], v[1]} * rr), y1 = gelu_tanh2((f32x2){v[2], v[3]} * rr), q2 = y0 * y0 + y1 * y1, s2 = y0 + y1;
                        const float a = y0[0], b = y0[1], c = y1[0], d = y1[1];
                        s += s2[0] + s2[1]; q += q2[0] + q2[1];
                        if (n == 0) { w.x = pk2(a, b); w.y = pk2(c, d); } else { w.z = pk2(a, b); w.w = pk2(c, d); } }
                    *(u32x4*)(rowp + bj * 32) = w; }
                if (u.pn >= 4) { s += __shfl_xor(s, 16); s += __shfl_xor(s, 32); q += __shfl_xor(q, 16); q += __shfl_xor(q, 32);
                    if (fq == 0) ST[(size_t)row * 16 + (u.pn - 4) * 4 + wc] = (f32x2){s, q}; } }
    }
};
__device__ __forceinline__ void phase_gmlp_sgu(const Params& p, LAS unsigned char* lds) {
    const int tid = tid_fresh(); unsigned char* ws = p.ws;
    LAS float* zt = (LAS float*)lds;
    LAS float* mu = zt + 128 * 128; LAS float* rs = mu + 128;
    const bf16* Z = (const bf16*)(ws + WS_Z); const f32x2* ST = (const f32x2*)(ws + WS_STATS); const bf16* WSB = (const bf16*)(ws + WS_WSB); bf16* O = (bf16*)(ws + WS_CAT);
    const float* lng = p.in[I_GLNG]; const float* lnb = p.in[I_GLNB]; const float* bs = p.in[I_GBS];
    for (int unit = blockIdx.x; unit < 4 * 32 * 8; unit += gridDim.x) {
        const int g = unit & 7, bc = unit >> 3, row0 = bc * 128;
        __syncthreads();
        if (tid < 128) { float s = 0.f, q = 0.f; const f32x2* st = ST + (size_t)(row0 + tid) * 16;
            for (int i = 0; i < 16; ++i) { s += st[i].x; q += st[i].y; }
            const float m = s * (1.f / 1024.f); mu[tid] = m; rs[tid] = rsqrtf(fmaxf(q * (1.f / 1024.f) - m * m, 0.f) + EPS); }
        __syncthreads();
        for (int i = tid; i < 128 * 16; i += 512) { const int s = i >> 4, c8 = (i & 15) * 8; const u32x4 v = *(const u32x4*)(Z + (size_t)(row0 + s) * 2048 + 1024 + g * 128 + c8);
            const float m = mu[s], r = rs[s]; const float* gg = lng + g * 128 + c8; const float* bb = lnb + g * 128 + c8; LAS float* d = zt + s * 128 + c8;
            d[0] = (bflo(v.x) - m) * r * gg[0] + bb[0]; d[1] = (bfhi(v.x) - m) * r * gg[1] + bb[1]; d[2] = (bflo(v.y) - m) * r * gg[2] + bb[2]; d[3] = (bfhi(v.y) - m) * r * gg[3] + bb[3];
            d[4] = (bflo(v.z) - m) * r * gg[4] + bb[4]; d[5] = (bfhi(v.z) - m) * r * gg[5] + bb[5]; d[6] = (bflo(v.w) - m) * r * gg[6] + bb[6]; d[7] = (bfhi(v.w) - m) * r * gg[7] + bb[7]; }
        __syncthreads();
        const int d = tid & 127;
        for (int i = 0; i < 32; ++i) { const int t = (tid >> 7) + 4 * i; const bf16* wr = WSB + ((size_t)g * 128 + t) * 128; float a = bs[g * 128 + t];
            for (int s = 0; s <= t; ++s) a += bf2f(wr[s]) * zt[s * 128 + d];
            const size_t row = (size_t)(row0 + t); const float z1 = bf2f(Z[row * 2048 + g * 128 + d]);
            O[row * 1024 + g * 128 + d] = (bf16)f2bf(z1 * a); }
    }
}


__device__ __forceinline__ void phase_gmlp_sgu_fast(const Params& p, LAS unsigned char* lds) {
    const int tid = tid_fresh(), lane = tid & 63, wave = __builtin_amdgcn_readfirstlane(tid >> 6); unsigned char* ws = p.ws;
    LAS unsigned char* zt = lds;
    LAS float* mu = (LAS float*)(lds + 32768); LAS float* rs = mu + 128;
    LAS float* mx = (LAS float*)(lds + 40960);
    const bf16* Z = (const bf16*)(ws + WS_Z); const f32x2* ST = (const f32x2*)(ws + WS_STATS); const bf16* WSB = (const bf16*)(ws + WS_WSB); bf16* O = (bf16*)(ws + WS_CAT);
    const float* bs = p.in[I_GBS];
    const int q = lane & 31, h = lane >> 5, tt = wave & 3, dp = wave >> 2;
    const int c8 = (tid & 15) * 8;
    const int NU = 4 * 32 * 8;
#define SGU_MAP(unit_, g_, row0_) do { const int ui_ = gridDim.x == 256 ? (int)(blockIdx.x >> 3) + 32 * ((unit_) >> 8) : (unit_); g_ = ui_ & 7; \
        row0_ = (gridDim.x == 256 ? 16 * (int)(blockIdx.x & 7) + (ui_ >> 3) : (unit_) >> 3) * 128; } while (0)
    u32x4 z2n[4], z1n[4]; f32x4 stn[2];
#define SGU_LOAD(unit_) do { int g_, r0_; SGU_MAP(unit_, g_, r0_); \
        { const f32x4* sp_ = (const f32x4*)(ST + (size_t)(r0_ + (tid >> 2)) * 16 + (tid & 3) * 4); stn[0] = sp_[0]; stn[1] = sp_[1]; } \
        _Pragma("unroll") for (int it = 0; it < 4; ++it) { const size_t row_ = (size_t)(r0_ + (tid >> 4) + 32 * it); \
            z2n[it] = *(const u32x4*)(Z + row_ * 2048 + 1024 + g_ * 128 + c8); z1n[it] = *(const u32x4*)(Z + row_ * 2048 + g_ * 128 + c8); } } while (0)
    int unit = blockIdx.x; if (unit >= NU) return;
    SGU_LOAD(unit);
    int gprev = -1; bf16x8 Wf[8]; f32x4 ga, gb, ba, bb;
    for (; unit < NU; unit += gridDim.x) {
        int g, row0; SGU_MAP(unit, g, row0);
        u32x4 z2c[4], z1c[4]; const f32x4 st0 = stn[0], st1 = stn[1];
#pragma unroll
        for (int it = 0; it < 4; ++it) { z2c[it] = z2n[it]; z1c[it] = z1n[it]; }
        if (unit + (int)gridDim.x < NU) SGU_LOAD(unit + (int)gridDim.x);
        if (g != gprev) { gprev = g;
            ga = *(const f32x4*)(p.in[I_GLNG] + g * 128 + c8); gb = *(const f32x4*)(p.in[I_GLNG] + g * 128 + c8 + 4);
            ba = *(const f32x4*)(p.in[I_GLNB] + g * 128 + c8); bb = *(const f32x4*)(p.in[I_GLNB] + g * 128 + c8 + 4);
#pragma unroll
            for (int ks = 0; ks < 8; ++ks) Wf[ks] = *(const bf16x8*)(WSB + ((size_t)g * 128 + 32 * tt + q) * 128 + 16 * ks + 8 * h); }
        __syncthreads();
        { float s = (st0[0] + st0[2]) + (st1[0] + st1[2]), qq = (st0[1] + st0[3]) + (st1[1] + st1[3]);
          s += __shfl_xor(s, 1); qq += __shfl_xor(qq, 1); s += __shfl_xor(s, 2); qq += __shfl_xor(qq, 2);
          if ((tid & 3) == 0) { const float m = s * (1.f / 1024.f); mu[tid >> 2] = m; rs[tid >> 2] = rsqrtf(fmaxf(qq * (1.f / 1024.f) - m * m, 0.f) + EPS); } }
        __syncthreads();
#pragma unroll
        for (int it = 0; it < 4; ++it) { const int s = (tid >> 4) + 32 * it; const u32x4 v = z2c[it];
            const float m = mu[s], r = rs[s];
            float y[8]; y[0] = (bflo(v.x) - m) * r * ga[0] + ba[0]; y[1] = (bfhi(v.x) - m) * r * ga[1] + ba[1]; y[2] = (bflo(v.y) - m) * r * ga[2] + ba[2]; y[3] = (bfhi(v.y) - m) * r * ga[3] + ba[3];
            y[4] = (bflo(v.z) - m) * r * gb[0] + bb[0]; y[5] = (bfhi(v.z) - m) * r * gb[1] + bb[1]; y[6] = (bflo(v.w) - m) * r * gb[2] + bb[2]; y[7] = (bfhi(v.w) - m) * r * gb[3] + bb[3];
#pragma unroll
            for (int e = 0; e < 8; ++e) { const int d = c8 + e; *(LAS bf16*)(zt + d * 256 + ((((s >> 3) ^ (d ^ (d >> 3))) & 15) << 4) + (s & 7) * 2) = (bf16)f2bf(y[e]); } }
        __syncthreads();
#pragma unroll
        for (int di = 0; di < 2; ++di) { const int d = 64 * dp + 32 * di + q; f32x16 acc;
#pragma unroll
            for (int r = 0; r < 16; ++r) acc[r] = 0.f;
            const LAS unsigned char* zr = zt + d * 256; const int sw = (d ^ (d >> 3)) & 15;
#pragma unroll
            for (int ks = 0; ks < 8; ++ks) if (ks <= 2 * tt + 1) { const bf16x8 Zf = *(const LAS bf16x8*)(zr + (((2 * ks + h) ^ sw) << 4)); acc = MFMA32(Wf[ks], Zf, acc); }
#pragma unroll
            for (int r = 0; r < 16; ++r) { const int t = 32 * tt + (r & 3) + 8 * (r >> 2) + 4 * h; mx[t * 128 + d] = acc[r] + bs[g * 128 + t]; } }
        __syncthreads();
#pragma unroll
        for (int it = 0; it < 4; ++it) { const int t = (tid >> 4) + 32 * it; const size_t row = (size_t)(row0 + t);
            const u32x4 zv = z1c[it]; const f32x4 m0 = *(const LAS f32x4*)(mx + t * 128 + c8), m1 = *(const LAS f32x4*)(mx + t * 128 + c8 + 4);
            u32x4 o; o.x = pk2(bflo(zv.x) * m0[0], bfhi(zv.x) * m0[1]); o.y = pk2(bflo(zv.y) * m0[2], bfhi(zv.y) * m0[3]); o.z = pk2(bflo(zv.z) * m1[0], bfhi(zv.z) * m1[1]); o.w = pk2(bflo(zv.w) * m1[2], bfhi(zv.w) * m1[3]);
            *(u32x4*)(O + row * 1024 + g * 128 + c8) = o; }
    }
#undef SGU_LOAD
#undef SGU_MAP
}

__device__ __forceinline__ void moe_tables(const Params& p, LAS unsigned char* lds) {
    LAS int* tb = (LAS int*)(lds + LDS_MISC);
    __syncthreads();
    if (threadIdx.x == 0) { const unsigned* cnt = (const unsigned*)(p.ws + WS_CNT); int acc = 0;
        for (int e = 0; e < 8; ++e) { const int c = (int)__hip_atomic_load(cnt + e, __ATOMIC_RELAXED, __HIP_MEMORY_SCOPE_AGENT); tb[e] = c; tb[8 + e] = acc; acc += (c + 255) >> 8; }
        tb[16] = acc; }
    __syncthreads();
}
template <bool GATHER_>
struct MoeSched {
    static constexpr bool GATHER = GATHER_;
    const char* A; const char* Wt; const int* list; LAS int* tb; int apitch_, bpitch, nN, G, c; size_t wstride;
    int nM; unsigned long long tp8;
    __device__ __forceinline__ void init() { nM = __builtin_amdgcn_readfirstlane(tb[16]); unsigned lo = 0u, hi = 0u;
#pragma unroll
        for (int x = 1; x < 4; ++x) lo |= ((unsigned)__builtin_amdgcn_readfirstlane(tb[8 + x]) & 0xffu) << (8 * x);
#pragma unroll
        for (int x = 4; x < 8; ++x) hi |= ((unsigned)__builtin_amdgcn_readfirstlane(tb[8 + x]) & 0xffu) << (8 * (x - 4));
        tp8 = ((unsigned long long)hi << 32) | lo; }
    __device__ __forceinline__ int apitch() const { return apitch_; }
    __device__ __forceinline__ const void* abase() const { return A; }
    __device__ __forceinline__ const void* bbase() const { return Wt; }
    __device__ __forceinline__ bool next(int i, g8::Unit& u) const {
        if (!g8::tile_order(i * G + c, nM, nN, u.pm, u.pn)) return false;
        int e = 0;
#pragma unroll
        for (int x = 1; x < 8; ++x) e += (u.pm >= (int)((tp8 >> (8 * x)) & 0xffull)) ? 1 : 0;
        u.e = e; u.bo = (unsigned)e * (unsigned)wstride + (unsigned)u.pn * 256u * (unsigned)bpitch;
        u.ao = GATHER ? 0u : (unsigned)u.pm * 256u * (unsigned)apitch_; return true;
    }
    __device__ __forceinline__ void aoff(const g8::Unit& u, unsigned (&v)[4]) const {
        int R0, C0; g8::stage_rc(tid_fresh() * 16, R0, C0);
        const int cnt = __builtin_amdgcn_readfirstlane(tb[u.e]), l0 = (u.pm - (int)((tp8 >> (8 * u.e)) & 0xffull)) * 256;
#pragma unroll
        for (int x = 0; x < 4; ++x) { const int lr = l0 + 64 * x + R0; const int tok = lr < cnt ? list[u.e * 16384 + lr] : 0; v[x] = (unsigned)(tok * apitch_ + C0 * 2); }
    }
};
struct EpiSwiGLU8 {
    static constexpr bool AFTER_DRAIN = false;
    unsigned char* O; int ldc; float sc;
    __device__ __forceinline__ void operator()(const f32x4 (&acc)[2][2][4][2], const g8::Unit& u, int wr, int wc, int fr, int fq, LAS unsigned char* lds) const {
        const int row0 = u.pm * 256 + wr * 64 + fr, col0 = u.pn * 128 + wc * 32 + 8 * fq; const float k1 = -sc * 1.4426950408889634f, k2 = sc * sc;
#pragma unroll
        for (int ai = 0; ai < 2; ++ai)
#pragma unroll
            for (int m = 0; m < 4; ++m) { u32x2 w;
#pragma unroll
                for (int bj = 0; bj < 2; ++bj) { const f32x4 g = acc[ai][bj][m][0], up = acc[ai][bj][m][1]; unsigned x = 0u;
                    { const f32x2 a = swiglu2((f32x2){g[0], g[1]}, (f32x2){up[0], up[1]}, k1, k2); x = __builtin_amdgcn_cvt_pk_fp8_f32(clamp8(a[0]), clamp8(a[1]), x, false); }
                    { const f32x2 b = swiglu2((f32x2){g[2], g[3]}, (f32x2){up[2], up[3]}, k1, k2); x = __builtin_amdgcn_cvt_pk_fp8_f32(clamp8(b[0]), clamp8(b[1]), x, true); }
                    if (bj == 0) w.x = x; else w.y = x; }
                *(u32x2*)(O + (size_t)(row0 + ai * 128 + m * 16) * ldc + col0) = w;
                asm volatile("" ::: "memory"); }
    }
};
struct EpiBf16S {
    static constexpr bool AFTER_DRAIN = false;
    bf16* O; int ldc; float sc;
    __device__ __forceinline__ void operator()(const f32x4 (&acc)[2][2][4][2], const g8::Unit& u, int wr, int wc, int fr, int fq) const {
        const int row0 = u.pm * 256 + wr * 64 + fr, col0 = u.pn * 256 + wc * 64 + 8 * fq;
#pragma unroll
        for (int ai = 0; ai < 2; ++ai)
#pragma unroll
            for (int m = 0; m < 4; ++m) { bf16* rowp = O + (size_t)(row0 + ai * 128 + m * 16) * ldc + col0;
#pragma unroll
                for (int bj = 0; bj < 2; ++bj) { const f32x4 v0 = acc[ai][bj][m][0] * sc, v1 = acc[ai][bj][m][1] * sc;
                    u32x4 w; w.x = pk2(v0[0], v0[1]); w.y = pk2(v0[2], v0[3]); w.z = pk2(v1[0], v1[1]); w.w = pk2(v1[2], v1[3]); *(u32x4*)(rowp + bj * 32) = w; } }
    }
};

__device__ __forceinline__ void phase_norm_router(const Params& p, LAS unsigned char* lds) {
    const int tid = tid_fresh(), lane = tid & 63, wave = tid >> 6; unsigned char* ws = p.ws;
    LAS int* lc = (LAS int*)(lds + LDS_MISC + 256);
    LAS int* rec = lc + 16;
    const bf16* M = (const bf16*)(ws + WS_M); bf16* U = (bf16*)(ws + WS_U);
    const float* wrt = p.in[I_MWR];
    int* list = (int*)(ws + WS_LIST); int* toke = (int*)(ws + WS_TOKE); float* tokw = (float*)(ws + WS_TOKW); unsigned* gcnt = (unsigned*)(ws + WS_CNT);
    for (int r0 = (gridDim.x == 256 ? (int)((blockIdx.x & 7) * 2048 + (blockIdx.x >> 3) * 64) : (int)blockIdx.x * 64); r0 < NT; r0 += gridDim.x * 64) {
        __syncthreads();
        if (tid < 16) lc[tid] = 0;
        LAS unsigned char* wl = lds + 65536;
#pragma unroll
        for (int kk = 0; kk < 2; ++kk) { const int k = tid + 512 * kk, l_ = (k & 255) >> 2, jx = (k >> 8) * 4 + (k & 3); const f32x4 a = *(const f32x4*)(wrt + (size_t)k * 8), b = *(const f32x4*)(wrt + (size_t)k * 8 + 4);
            *(LAS f32x4*)(wl + (jx * 64 + l_) * 48) = a; *(LAS f32x4*)(wl + (jx * 64 + l_) * 48 + 16) = b; }
        __syncthreads();
#if FUSE_NORM
        u32x2 nA[4], nB[4]; float nra, nrb;
#define RT_LOAD(i_) do { const int a_ = r0 + wave * 8 + (i_), b_ = a_ + 4; const bf16* H_ = (const bf16*)(ws + WS_H); \
            _Pragma("unroll") for (int j = 0; j < 4; ++j) { nA[j] = *(const u32x2*)(H_ + (size_t)a_ * D + 4 * lane + 256 * j); nB[j] = *(const u32x2*)(H_ + (size_t)b_ * D + 4 * lane + 256 * j); } \
            nra = ((const float*)(ws + WS_RS))[a_]; nrb = ((const float*)(ws + WS_RS))[b_]; } while (0)
        RT_LOAD(0);
#endif
        for (int i = 0; i < 4; ++i) { const int lrA = wave * 8 + i, lrB = lrA + 4, mA = r0 + lrA, mB = r0 + lrB; f32x4 h[4], h2[4];
            bf16* H = (bf16*)(ws + WS_H);
#if FUSE_NORM
            { const float ra = nra, rb = nrb; const float* gp = p.in[I_NFPRE] + D;
#pragma unroll
              for (int j = 0; j < 4; ++j) { h[j] = (f32x4){bflo(nA[j].x), bfhi(nA[j].x), bflo(nA[j].y), bfhi(nA[j].y)}; h2[j] = (f32x4){bflo(nB[j].x), bfhi(nB[j].x), bflo(nB[j].y), bfhi(nB[j].y)}; }
              if (i + 1 < 4) RT_LOAD(i + 1);
#pragma unroll
              for (int j = 0; j < 4; ++j) { const f32x4 g = *(const f32x4*)(gp + 4 * lane + 256 * j); h[j] = h[j] * ra * g; h2[j] = h2[j] * rb * g; } }
#else
            row_norm2<true>(H + (size_t)mA * D, M + (size_t)mA * D, H + (size_t)mA * D, MOE_F8 ? nullptr : U + (size_t)mA * D, H + (size_t)mB * D, M + (size_t)mB * D, H + (size_t)mB * D, MOE_F8 ? nullptr : U + (size_t)mB * D, p.in[I_NMPOST] + D, p.in[I_NFPRE] + D, lane, h, h2);
#endif
#if MOE_F8
            if (gridDim.x == 256) {
#pragma unroll
                for (int j = 0; j < 4; ++j) { *(LAS unsigned*)(lds + lrA * 1024 + 4 * lane + 256 * j) = pk4f8(h[j][0], h[j][1], h[j][2], h[j][3]); *(LAS unsigned*)(lds + lrB * 1024 + 4 * lane + 256 * j) = pk4f8(h2[j][0], h2[j][1], h2[j][2], h2[j][3]); }
            } else {
#pragma unroll
            for (int j = 0; j < 4; ++j) { *(unsigned*)(ws + WS_U8 + (size_t)mA * D + 4 * lane + 256 * j) = pk4f8(h[j][0], h[j][1], h[j][2], h[j][3]); *(unsigned*)(ws + WS_U8 + (size_t)mB * D + 4 * lane + 256 * j) = pk4f8(h2[j][0], h2[j][1], h2[j][2], h2[j][3]); } }
#endif
            float lg[8], lh[8];
#pragma unroll
            for (int e = 0; e < 8; ++e) { lg[e] = 0.f; lh[e] = 0.f; }
#pragma unroll
            for (int j = 0; j < 4; ++j)
#pragma unroll
                for (int x = 0; x < 4; ++x) { const f32x4 wa = *(const LAS f32x4*)(wl + ((j * 4 + x) * 64 + lane) * 48), wb = *(const LAS f32x4*)(wl + ((j * 4 + x) * 64 + lane) * 48 + 16); const float hv = h[j][x], hw = h2[j][x];
                    lg[0] += hv * wa[0]; lg[1] += hv * wa[1]; lg[2] += hv * wa[2]; lg[3] += hv * wa[3]; lg[4] += hv * wb[0]; lg[5] += hv * wb[1]; lg[6] += hv * wb[2]; lg[7] += hv * wb[3];
                    lh[0] += hw * wa[0]; lh[1] += hw * wa[1]; lh[2] += hw * wa[2]; lh[3] += hw * wa[3]; lh[4] += hw * wb[0]; lh[5] += hw * wb[1]; lh[6] += hw * wb[2]; lh[7] += hw * wb[3]; }
            float w1;
            { const bool b5 = (lane & 32) != 0, b4 = (lane & 16) != 0, b3 = (lane & 8) != 0, b2 = (lane & 4) != 0; float w8[8], w4[4], w2[2];
#pragma unroll
              for (int e = 0; e < 8; ++e) { const float snd = b5 ? lg[e] : lh[e], kp = b5 ? lh[e] : lg[e]; w8[e] = kp + __shfl_xor(snd, 32); }
#pragma unroll
              for (int e = 0; e < 4; ++e) { const float snd = b4 ? w8[e] : w8[e + 4], kp = b4 ? w8[e + 4] : w8[e]; w4[e] = kp + __shfl_xor(snd, 16); }
#pragma unroll
              for (int e = 0; e < 2; ++e) { const float snd = b3 ? w4[e] : w4[e + 2], kp = b3 ? w4[e + 2] : w4[e]; w2[e] = kp + __shfl_xor(snd, 8); }
              { const float snd = b2 ? w2[0] : w2[1], kp = b2 ? w2[1] : w2[0]; w1 = kp + __shfl_xor(snd, 4); }
              w1 += __shfl_xor(w1, 2); w1 += __shfl_xor(w1, 1); }
#pragma unroll
            for (int rr = 0; rr < 2; ++rr) { const int lr = rr ? lrB : lrA, m = rr ? mB : mA;
                float l8[8];
#pragma unroll
                for (int e = 0; e < 8; ++e) l8[e] = __builtin_bit_cast(float, __builtin_amdgcn_readlane(__builtin_bit_cast(int, w1), 32 * rr + 16 * (e >> 2) + 8 * ((e >> 1) & 1) + 4 * (e & 1)));
                int e0 = 0; float v0 = l8[0];
#pragma unroll
                for (int e = 1; e < 8; ++e) if (l8[e] > v0) { v0 = l8[e]; e0 = e; }
                int e1 = e0 == 0 ? 1 : 0; float v1 = -3.4e38f;
#pragma unroll
                for (int e = 0; e < 8; ++e) if (e != e0 && l8[e] > v1) { v1 = l8[e]; e1 = e; }
                if (lane == 0) { const float x = __expf(v1 - v0), w0 = 1.f / (1.f + x), w1 = x / (1.f + x);
                    const int p0 = __hip_atomic_fetch_add(lc + e0, 1, __ATOMIC_RELAXED, __HIP_MEMORY_SCOPE_WORKGROUP), p1 = __hip_atomic_fetch_add(lc + e1, 1, __ATOMIC_RELAXED, __HIP_MEMORY_SCOPE_WORKGROUP);
                    rec[lr * 4 + 0] = e0; rec[lr * 4 + 1] = e1; rec[lr * 4 + 2] = p0; rec[lr * 4 + 3] = p1; tokw[m * 2] = w0; tokw[m * 2 + 1] = w1; } }
        }
        __syncthreads();
        if (tid < 8) lc[8 + tid] = (int)atomicAdd(gcnt + tid, (unsigned)lc[tid]);
        __syncthreads();
        if (tid < 128) { const int lr = tid >> 1, k = tid & 1, e = rec[lr * 4 + k], pos = lc[8 + e] + rec[lr * 4 + 2 + k], m = r0 + lr;
            list[e * 16384 + pos] = m; toke[m * 2 + k] = (e << 16) | pos; }
    }
}

__device__ __forceinline__ void phase_moe_gather(const Params& p, LAS unsigned char* lds) {
    const int tid_ = tid_fresh(), lane = tid_ & 63, wave = tid_ >> 6; const int gw = blockIdx.x * 8 + wave, NGW = gridDim.x * 8; unsigned char* ws = p.ws;
    LAS int* tb = (LAS int*)(lds + LDS_MISC); const int* list = (const int*)(ws + WS_LIST);
    if (gridDim.x == 256) {
        const LAS int* lc = (const LAS int*)(lds + LDS_MISC + 256); const LAS int* rec = lc + 16;
        for (int idx = wave; idx < 128; idx += 8) { const int lr = idx >> 1, k = idx & 1, e = rec[lr * 4 + k], pos = lc[8 + e] + rec[lr * 4 + 2 + k];
            const u32x4 v = *(const LAS u32x4*)(lds + lr * 1024 + 16 * lane);
            *(u32x4*)(ws + WS_XG8 + ((size_t)tb[8 + e] * 256 + pos) * D + 16 * lane) = v; }
        return; }
    for (int e = 0; e < NE; ++e) { const int cnt = tb[e]; const size_t base = (size_t)tb[8 + e] * 256;
        for (int r = gw; r < cnt; r += 2 * NGW) { const int r2 = r + NGW; const int t0 = list[e * 16384 + r], t1 = r2 < cnt ? list[e * 16384 + r2] : t0;
            const u32x4 a = *(const u32x4*)(ws + WS_U8 + (size_t)t0 * D + 16 * lane), b = *(const u32x4*)(ws + WS_U8 + (size_t)t1 * D + 16 * lane);
            *(u32x4*)(ws + WS_XG8 + (base + r) * D + 16 * lane) = a; if (r2 < cnt) *(u32x4*)(ws + WS_XG8 + (base + r2) * D + 16 * lane) = b; } }
}
__device__ __forceinline__ void phase_final(const Params& p, LAS unsigned char* lds) {
    const int tid_ = tid_fresh(), lane = tid_ & 63, wave = tid_ >> 6; const int gw = blockIdx.x * 8 + wave, NGW = gridDim.x * 8; unsigned char* ws = p.ws;
    LAS int* tb = (LAS int*)(lds + LDS_MISC);
    const bf16* Y = (const bf16*)(ws + WS_Y); const int* toke = (const int*)(ws + WS_TOKE); const float* tokw = (const float*)(ws + WS_TOKW); const float* g = p.in[I_NFPOST] + D;
    const f32x4 gg0 = *(const f32x4*)(g + 4 * lane), gg1 = *(const f32x4*)(g + 4 * lane + 256), gg2 = *(const f32x4*)(g + 4 * lane + 512), gg3 = *(const f32x4*)(g + 4 * lane + 768);
    for (int mm = gw; mm < NT; mm += 2 * NGW) {
        int c0[2], c1[2]; float w0[2], w1[2]; size_t s0[2], s1[2];
#pragma unroll
        for (int z = 0; z < 2; ++z) { const int m = mm + z * NGW; c0[z] = toke[m * 2]; c1[z] = toke[m * 2 + 1]; w0[z] = tokw[m * 2]; w1[z] = tokw[m * 2 + 1]; }
#pragma unroll
        for (int z = 0; z < 2; ++z) { s0[z] = (size_t)tb[8 + (c0[z] >> 16)] * 256 + (c0[z] & 0xffff); s1[z] = (size_t)tb[8 + (c1[z] >> 16)] * 256 + (c1[z] & 0xffff); }
        f32x4 f[2][4]; u32x2 hw[2][4]; float ss[2] = {0.f, 0.f};
#pragma unroll
        for (int z = 0; z < 2; ++z)
#pragma unroll
            for (int j = 0; j < 4; ++j) { const u32x2 a = *(const u32x2*)(Y + s0[z] * D + 4 * lane + 256 * j), b = *(const u32x2*)(Y + s1[z] * D + 4 * lane + 256 * j);
                hw[z][j] = *(const u32x2*)((const bf16*)(ws + WS_H) + (size_t)(mm + z * NGW) * D + 4 * lane + 256 * j);
                f[z][j] = (f32x4){bflo(a.x), bfhi(a.x), bflo(a.y), bfhi(a.y)} * w0[z] + (f32x4){bflo(b.x), bfhi(b.x), bflo(b.y), bfhi(b.y)} * w1[z];
                ss[z] += f[z][j][0] * f[z][j][0] + f[z][j][1] * f[z][j][1] + f[z][j][2] * f[z][j][2] + f[z][j][3] * f[z][j][3]; }
#pragma unroll
        for (int z = 0; z < 2; ++z) { const float r = rsqrtf(wave_sum(ss[z]) * (1.f / D) + EPS);
#pragma unroll
            for (int j = 0; j < 4; ++j) { float* o = p.out + (size_t)(mm + z * NGW) * D + 4 * lane + 256 * j; const f32x4 gg = j == 0 ? gg0 : j == 1 ? gg1 : j == 2 ? gg2 : gg3;
                f32x4 res = (f32x4){bflo(hw[z][j].x), bfhi(hw[z][j].x), bflo(hw[z][j].y), bfhi(hw[z][j].y)} + f[z][j] * r * gg;
#if NSA_MODE >= 2
                { const float* pa = (const float*)(ws + WS_PACC); float a = 0.f, bq = 0.f; for (int i = 0; i < (int)gridDim.x; ++i) { a += pa[2 * i]; bq += pa[2 * i + 1]; } const float dd = a / bq; res = res * (1.f + sqrtf(fminf(PROBE_GAIN * dd, 4.f))); }
#endif
                *(f32x4*)o = res; } }
    }
}

constexpr int N_PHASES = 17;
template <> struct g8::EpiLds<EpiSwiGLU8> { static constexpr bool v = true; };
template <> struct g8::EpiRS<g8::EpiSwiGLU> { static constexpr bool v = true; };
template <> struct g8::EpiRS<EpiGmlpIn> { static constexpr bool v = true; };
template <> struct g8::EpiId<EpiInProj> { static constexpr int id = 0; };
template <> struct g8::EpiId<g8::EpiBf16> { static constexpr int id = 1; };
template <> struct g8::EpiId<g8::EpiSwiGLU> { static constexpr int id = 2; };
template <> struct g8::EpiId<EpiGmlpIn> { static constexpr int id = 3; };
template <> struct g8::EpiId<EpiSwiGLU8> { static constexpr int id = 4; };
template <> struct g8::EpiId<EpiBf16S> { static constexpr int id = 5; };
__global__ void __launch_bounds__(512, 2) mega(Params p) {
    extern __shared__ __attribute__((aligned(16))) unsigned char lds_raw[];
    LAS unsigned char* lds = (LAS unsigned char*)lds_raw;
    cg::grid_group grid = cg::this_grid();
    unsigned char* ws = p.ws;
    const int G = gridDim.x, c = blockIdx.x;
    const int lo = p.ph_lo, hi = p.ph_hi;
#define IN(k) (lo <= (k) && (k) < hi)
#ifndef REPEAT_MASK
#define REPEAT_MASK 0
#endif
#define REP(k) for (int rep_ = 0; rep_ < 1 + ((REPEAT_MASK >> (k)) & 1); ++rep_)
    volatile LAS unsigned* bst = (volatile LAS unsigned*)(lds + LDS_MISC + 2048);
    if (threadIdx.x < 2) bst[threadIdx.x] = 0u;
    __syncthreads();
    const XcdBarrier xbar = xcd_barrier_post((unsigned*)(ws + WS_BAR), bst);
    if (lo > 0) grid.sync();
#ifdef BAR_PROBE
#define SEAM(k) do { if (IN(k) && IN((k) + 1)) { xcd_barrier(xbar); xcd_barrier(xbar); xcd_barrier(xbar); } } while (0)
#else
#define SEAM(k) do { if (IN(k) && IN((k) + 1)) xcd_barrier(xbar); } while (0)
#endif
    bf16* U = (bf16*)(ws + WS_U); bf16* Mb = (bf16*)(ws + WS_M);

    if (IN(0)) REP(0) phase_prep(p, lds);
    SEAM(0);
    if (IN(1)) REP(1) {
        g8::StaticSched S{U, ws + WS_WIN, 2 * D, 2 * D, NT / 256, IN0P / 256, G, c};
        EpiInProj E{(bf16*)(ws + WS_Q), (bf16*)(ws + WS_KV), (bf16*)(ws + WS_CGLU), (float*)(ws + WS_GATES)};
        g8::gemm_phase(lds, D, S, E);
        if (2 * c >= G) moe_convert_range(p, lds, 0, MOE_N1, (c - G / 2) * 8 + (tid_fresh() >> 6), (G - G / 2) * 8);
    }
    SEAM(1);
    if (IN(2)) REP(2) phase_cmp_conv(p, lds);
    SEAM(2);
#if NSA_MODE == 0
    if (IN(3)) REP(3) phase_nsa_simple(p, lds);
#elif NSA_MODE == 1
    if (IN(3)) REP(3) NSA_FN(p, lds, (bf16*)(ws + WS_CAT), nullptr, nullptr);
#elif NSA_MODE == 4
    if (IN(3)) { bf16* cz = (bf16*)(ws + WS_CAT); for (int i = blockIdx.x * 512 + threadIdx.x; i < NT * 64; i += gridDim.x * 512) *(u32x4*)(cz + (size_t)(i >> 6) * 1024 + (i & 63) * 8) = (u32x4){0u, 0u, 0u, 0u}; }
#else
    if (IN(3)) REP(3) { phase_nsa_simple(p, lds); grid.sync();
        NSA_FN(p, lds, (bf16*)(ws + WS_M), NSA_MODE == 2 ? (const unsigned long long*)(ws + WS_PROBE + 4096) : nullptr, (unsigned long long*)(ws + WS_PROBE + 4096) + NT * 2);
        grid.sync(); phase_probe_cmp(p); }
#endif
    SEAM(3);

    if (IN(4)) REP(4) {
        g8::StaticSched S{ws + WS_CAT, ws + WS_WOUT, 2 * D, 2 * D, NT / 256, D / 256, G, c};
#if FUSE_NORM
        EpiRmsRes2<false> E{p.in[I_X], (bf16*)(ws + WS_H), (float*)(ws + WS_RS), p.in[I_NMPOST], (float*)(ws + WS_XSLOT), (unsigned*)(ws + WS_XCNT), 0};
#else
        g8::EpiBf16 E{Mb, D};
#endif
        g8::gemm_phase(lds, D, S, E);
    }
#if !FUSE_NORM
    SEAM(4);
    if (IN(5)) REP(5) phase_norm<false>(p, p.in[I_X], p.in[I_NMPOST], p.in[I_NFPRE], FFN_F8 ? ws + WS_U8 : nullptr, FFN_F8 ? nullptr : (float*)(ws + WS_RS));
#endif
    SEAM(5);
    if (IN(6)) REP(6) {
#if FFN_F8
        g8::StaticSched S{ws + WS_U8, ws + WS_WGU, D, D, NT / 256, 2 * FF / 256, G, c};
        EpiSwiGLU8 E{ws + WS_FACT, FF, 1.f / MOE_SGU};
        g8::gemm_phase<true>(lds, D, S, E);
#else
        g8::StaticSched S{ws + WS_H, ws + WS_WGU, 2 * D, 2 * D, NT / 256, 2 * FF / 256, G, c};
        g8::EpiSwiGLU E{(bf16*)(ws + WS_FACT), FF, (const float*)(ws + WS_RS)};
        g8::gemm_phase(lds, D, S, E);
#endif
        if (2 * c >= G) moe_convert_range(p, lds, MOE_N1, MOE_N1 + MOE_N6, (c - G / 2) * 8 + (tid_fresh() >> 6), (G - G / 2) * 8);
    }
    SEAM(6);
    if (IN(7)) REP(7) {
#if FFN_F8
        g8::StaticSched S{ws + WS_FACT, ws + WS_WDN, FF, FF, NT / 256, D / 256, G, c};
        EpiBf16S E{Mb, D, 1.f / MOE_SD};
        g8::gemm_phase<true>(lds, FF, S, E);
#else
        g8::StaticSched S{ws + WS_FACT, ws + WS_WDN, 2 * FF, 2 * FF, NT / 256, D / 256, G, c};
#if FUSE_NORM
        EpiRmsRes2<true> E{ws + WS_H, (bf16*)(ws + WS_H), (float*)(ws + WS_RS), p.in[I_NFPOST], (float*)(ws + WS_XSLOT), (unsigned*)(ws + WS_XCNT), 2};
#else
        g8::EpiBf16 E{Mb, D};
#endif
        g8::gemm_phase(lds, FF, S, E);
#endif
    }
#if !FUSE_NORM || FFN_F8
    SEAM(7);
    if (IN(8)) REP(8) phase_norm<true>(p, ws + WS_H, p.in[I_NFPOST], p.in[I_NMPRE] + D, nullptr, (float*)(ws + WS_RS));
#endif
    SEAM(8);
    if (IN(9)) REP(9) {
        g8::StaticSched S{ws + WS_H, ws + WS_WGIN, 2 * D, 2 * D, NT / 256, 2 * D / 256, G, c};
        EpiGmlpIn E{(bf16*)(ws + WS_Z), (f32x2*)(ws + WS_STATS), (const float*)(ws + WS_RS)};
        g8::gemm_phase(lds, D, S, E);
    }
    SEAM(9);
#ifdef SGU_SIMPLE
    if (IN(10)) REP(10) phase_gmlp_sgu(p, lds);
#else
    if (IN(10)) REP(10) phase_gmlp_sgu_fast(p, lds);
#endif
    SEAM(10);
    if (IN(11)) REP(11) {
        g8::StaticSched S{ws + WS_CAT, ws + WS_WGOUT, 2 * D, 2 * D, NT / 256, D / 256, G, c};
#if FUSE_NORM
        EpiRmsRes2<true> E{ws + WS_H, (bf16*)(ws + WS_H), (float*)(ws + WS_RS), p.in[I_NMPOST] + D, (float*)(ws + WS_XSLOT), (unsigned*)(ws + WS_XCNT), 4};
#else
        g8::EpiBf16 E{Mb, D};
#endif
        g8::gemm_phase(lds, D, S, E);
    }
    SEAM(11);
    if (IN(12)) REP(12) phase_norm_router(p, lds);
    SEAM(12);
    if (IN(13)) { moe_tables(p, lds); phase_moe_gather(p, lds); }
    SEAM(13);
    if (IN(14)) REP(14) {
        if (!IN(13)) moe_tables(p, lds);
#if MOE_F8
        MoeSched<false> S{(const char*)(ws + WS_XG8), (const char*)(ws + WS_WMGU), nullptr, (LAS int*)(lds + LDS_MISC), D, D, 2 * EFF / 256, G, c, (size_t)2 * EFF * D}; S.init();
        EpiSwiGLU8 E{ws + WS_MACT, EFFP, 1.f / MOE_SGU};
#ifdef MOE_UP_PROBE
        g8::gemm_phase<true>(lds, D, S, E);
#endif
        g8::gemm_phase<true>(lds, D, S, E);
        { const int units = S.nM * S.nN, rounds = (units + G - 1) / G, first_idle = units - (rounds - 1) * G;
          const int nidle = G - first_idle;
          if (nidle > 0) { if (c >= first_idle) moe_convert_range(p, lds, MOE_TILES - MOE_N13, MOE_TILES, (c - first_idle) * 8 + (tid_fresh() >> 6), nidle * 8); }
          else moe_convert_range(p, lds, MOE_TILES - MOE_N13, MOE_TILES, c * 8 + (tid_fresh() >> 6), G * 8); }
#else
        MoeSched<true> S{(const char*)U, (const char*)(ws + WS_WMGU), (const int*)(ws + WS_LIST), (LAS int*)(lds + LDS_MISC), 2 * D, 2 * D, 2 * EFF / 256, G, c, (size_t)2 * EFF * D * 2}; S.init();
        g8::EpiSwiGLU E{(bf16*)(ws + WS_MACT), EFF};
        g8::gemm_phase(lds, D, S, E);
#endif
    }
    SEAM(14);
    if (IN(15)) REP(15) {
        if (!IN(13)) moe_tables(p, lds);
#if MOE_F8
        MoeSched<false> S{(const char*)(ws + WS_MACT), (const char*)(ws + WS_WMD), nullptr, (LAS int*)(lds + LDS_MISC), EFFP, EFFP, D / 256, G, c, (size_t)D * EFFP}; S.init();
        EpiBf16S E{(bf16*)(ws + WS_Y), D, 1.f / MOE_SD};
        g8::gemm_phase<true>(lds, EFF, S, E, EFFP);
#else
        MoeSched<false> S{(const char*)(ws + WS_MACT), (const char*)(ws + WS_WMD), nullptr, (LAS int*)(lds + LDS_MISC), 2 * EFF, 2 * EFF, D / 256, G, c, (size_t)D * EFF * 2}; S.init();
        g8::EpiBf16 E{(bf16*)(ws + WS_Y), D};
        g8::gemm_phase(lds, EFF, S, E);
#endif
    }
    SEAM(15);
    if (IN(16)) REP(16) { if (!IN(13)) moe_tables(p, lds); phase_final(p, lds); }
#undef IN
#undef SEAM
}

extern "C" void kernel_launch(void* const* d_in, const int* in_sizes, int n_in, void* d_out, int out_size, void* d_ws, size_t ws_size, hipStream_t stream) {
    static int grid = 0;
    if (grid == 0) {
        if (n_in != 29 || out_size != NT * D || ws_size < WS_END) { fprintf(stderr, "kernel_launch: unexpected shapes: n_in %d out %d ws %zu (need %zu)\n", n_in, out_size, ws_size, (size_t)WS_END); grid = -1; return; }
        int dev = 0, cus = 0, per_cu = 0;
        hipGetDevice(&dev); hipDeviceGetAttribute(&cus, hipDeviceAttributeMultiprocessorCount, dev);
        hipFuncSetAttribute((const void*)mega, hipFuncAttributeMaxDynamicSharedMemorySize, LDS_BYTES);
        hipOccupancyMaxActiveBlocksPerMultiprocessor(&per_cu, (const void*)mega, 512, LDS_BYTES);
        if (per_cu < 1) { fprintf(stderr, "kernel_launch: occupancy query says %d blocks per CU\n", per_cu); per_cu = 1; }
        grid = cus * 1;
        fprintf(stderr, "kernel_launch: cus %d per_cu %d grid %d ws %zu\n", cus, per_cu, grid, ws_size);
    }
    if (grid < 0) return;
    if (hipMemsetAsync((char*)d_ws + WS_BAR, 0, 16384 + 98304, stream) != hipSuccess) { fprintf(stderr, "kernel_launch: memset failed\n"); return; }
    Params p{};
    for (int i = 0; i < 29; ++i) p.in[i] = (const float*)d_in[i];
    p.out = (float*)d_out; p.ws = (unsigned char*)d_ws; p.ph_lo = 0; p.ph_hi = N_PHASES;
    void* args[] = {&p};
    hipError_t e = hipLaunchCooperativeKernel((const void*)mega, dim3(grid), dim3(512), args, LDS_BYTES, stream);
    if (e != hipSuccess) fprintf(stderr, "cooperative launch failed: %s (grid %d)\n", hipGetErrorString(e), grid);
}
```

```cpp
#include <hip/hip_runtime.h>
#include <hip/hip_cooperative_groups.h>
#include <cstdio>
#include <cstdint>
namespace cg = cooperative_groups;

#ifndef NSA_MODE
#define NSA_MODE 1
#endif
#ifndef NSA_FN
#define NSA_FN phase_nsa3
#endif
#ifndef N3_PROBE
#define N3_PROBE 0
#endif
#ifndef NSA_VT
#define NSA_VT 0
#endif
#ifndef FUSE_NORM
#define FUSE_NORM 1
#endif
#ifndef PROBE_GAIN
#define PROBE_GAIN 100.f
#endif
#define LAS __attribute__((address_space(3)))
typedef unsigned short bf16;
typedef short bf16x8 __attribute__((ext_vector_type(8)));
typedef float f32x4 __attribute__((ext_vector_type(4)));
typedef float f32x2 __attribute__((ext_vector_type(2)));
typedef unsigned u32x4 __attribute__((ext_vector_type(4)));
typedef unsigned u32x2 __attribute__((ext_vector_type(2)));
typedef float f32x16 __attribute__((ext_vector_type(16)));
typedef int i32x4 __attribute__((ext_vector_type(4)));
typedef int i32x8 __attribute__((ext_vector_type(8)));
#define MFMA32(a, b, c) __builtin_amdgcn_mfma_f32_32x32x16_bf16((a), (b), (c), 0, 0, 0)

constexpr int NT = 16384, D = 1024, SEQ = 4096, NB = 4;
constexpr int IN0 = 2328, IN0P = 2560;
constexpr int FF = 2816, EFF = 3584, NE = 8;
constexpr int EFFP = 3712;
constexpr int MOE_ROWS = 2 * NT + NE * 256;
constexpr float EPS = 1e-6f;
constexpr float QSCALE = 0.125f * 1.4426950408889634f;

constexpr size_t MiB = 1u << 20;
#ifndef FFN_F8
#define FFN_F8 0
#endif
#ifndef MOE_F8
#define MOE_F8 1
#endif
#if MOE_F8
constexpr size_t WS_WMGU = 0;
constexpr size_t WS_WMD = 56 * MiB;
constexpr size_t WS_Y = 85 * MiB;
constexpr size_t WS_U8 = 152 * MiB;
constexpr size_t WS_XG8 = 292 * MiB;
#else
constexpr size_t WS_WMGU = 0;
constexpr size_t WS_Y = 0;
constexpr size_t WS_WMD = 112 * MiB;
#endif
constexpr float MOE_SGU = 32.f, MOE_SD = 64.f;
constexpr size_t WS_C = 168 * MiB;
constexpr size_t WS_MACT = WS_C;
constexpr size_t WS_WIN = WS_C + 0 * MiB;
constexpr size_t WS_WOUT = WS_C + 5 * MiB;
constexpr size_t WS_WGU = WS_C + 7 * MiB;
constexpr size_t WS_WDN = WS_C + 18 * MiB;
constexpr size_t WS_WGIN = WS_C + 24 * MiB;
constexpr size_t WS_WGOUT = WS_C + 28 * MiB;
constexpr size_t WS_WC1 = WS_C + 30 * MiB;
constexpr size_t WS_WSB = WS_C + 32 * MiB;
constexpr size_t WS_KC = WS_WSB + 256 * 1024;
constexpr size_t WS_VC = WS_KC + 256 * 1024;
constexpr size_t WS_VCT = WS_VC + 256 * 1024;
constexpr size_t WS_BIAS1 = WS_C + 39 * MiB;
constexpr size_t WS_W2T = WS_BIAS1 + 2048;
constexpr size_t WS_PROBE = WS_BIAS1 + 4096 + 65536;
constexpr size_t WS_H1C = WS_C + 33 * MiB;
constexpr size_t WS_GATES = WS_C + 35 * MiB;
constexpr size_t WS_STATS = WS_C + 37 * MiB;
constexpr size_t WS_Q = WS_C + 40 * MiB;
constexpr size_t WS_KV = WS_C + 56 * MiB;
constexpr size_t WS_VT = WS_C + 80 * MiB;
constexpr size_t WS_CGLU = WS_C + 88 * MiB;
constexpr size_t WS_CAT = WS_C + 104 * MiB;
constexpr size_t WS_M = WS_C + 136 * MiB;
constexpr size_t WS_FACT = WS_C + 40 * MiB;
constexpr size_t WS_Z = WS_C + 40 * MiB;
constexpr size_t WS_H = WS_C + 200 * MiB;
constexpr size_t WS_U = 406 * MiB;
constexpr size_t WS_E = 438 * MiB;
constexpr size_t WS_CNT = WS_E;
constexpr size_t WS_LIST = WS_E + 4096;
constexpr size_t WS_TOKE = WS_LIST + 8 * 16384 * 4;
constexpr size_t WS_TOKW = WS_TOKE + 16384 * 8;
constexpr size_t WS_RS = WS_E + 832 * 1024;
constexpr size_t WS_BAR = 439 * MiB + 512 * 1024;
constexpr size_t WS_PACC = 439 * MiB;
constexpr size_t WS_XCNT = WS_BAR + 16384;
constexpr size_t WS_XSLOT = 406 * MiB;
constexpr size_t WS_END = 441 * MiB;

constexpr int LDS_BYTES = 163840;
constexpr int LDS_XB = 147456;
constexpr int LDS_MISC = 135168;

__device__ __forceinline__ unsigned f2bf(float f) { unsigned u = __float_as_uint(f); return (u + 0x7fffu + ((u >> 16) & 1u)) >> 16; }
typedef __bf16 bf16x2_t __attribute__((ext_vector_type(2)));
__device__ __forceinline__ unsigned pk2(float lo, float hi) { return __builtin_bit_cast(unsigned, __builtin_convertvector((f32x2){lo, hi}, bf16x2_t)); }
__device__ __forceinline__ float bflo(unsigned w) { return __uint_as_float(w << 16); }
__device__ __forceinline__ float bfhi(unsigned w) { return __uint_as_float(w & 0xffff0000u); }
__device__ __forceinline__ float bf2f(bf16 b) { return __uint_as_float((unsigned)b << 16); }
__device__ __forceinline__ float wave_sum(float v) {
#pragma unroll
    for (int o = 1; o < 64; o <<= 1) v += __shfl_xor(v, o);
    return v;
}
__device__ __forceinline__ float wave_max(float v) {
#pragma unroll
    for (int o = 1; o < 64; o <<= 1) v = fmaxf(v, __shfl_xor(v, o));
    return v;
}
__device__ __forceinline__ float sigm(float x) { return __builtin_amdgcn_rcpf(1.f + __expf(-x)); }
__device__ __forceinline__ float silu(float x) { return x * sigm(x); }
__device__ __forceinline__ float gelu_tanh(float x) { constexpr float C1 = -2.f * 0.7978845608028654f * 1.4426950408889634f, C2 = 0.044715f * C1;
    const float t = x * __builtin_fmaf(x * x, C2, C1); return x * __builtin_amdgcn_rcpf(1.f + __builtin_amdgcn_exp2f(t)); }
__device__ __forceinline__ f32x2 swiglu2(f32x2 g, f32x2 u, float k1, float k2) { f32x2 t = g * k1; t = (f32x2){__builtin_amdgcn_exp2f(t[0]), __builtin_amdgcn_exp2f(t[1])} + 1.f;
    t = (f32x2){__builtin_amdgcn_rcpf(t[0]), __builtin_amdgcn_rcpf(t[1])}; return ((g * u) * t) * k2; }
__device__ __forceinline__ f32x2 gelu_tanh2(f32x2 x) { constexpr float C1 = -2.f * 0.7978845608028654f * 1.4426950408889634f, C2 = 0.044715f * C1;
    f32x2 t = x * ((x * x) * C2 + C1); t = (f32x2){__builtin_amdgcn_exp2f(t[0]), __builtin_amdgcn_exp2f(t[1])} + 1.f; return x * (f32x2){__builtin_amdgcn_rcpf(t[0]), __builtin_amdgcn_rcpf(t[1])}; }
#define WAVE_FENCE() asm volatile("s_waitcnt lgkmcnt(0)" ::: "memory")
__device__ __forceinline__ int tid_fresh() { int t = threadIdx.x; asm volatile("" : "+v"(t)); return t; }
__device__ __forceinline__ float clamp8(float x) { float r; asm("v_med3_f32 %0, %1, %2, -%2" : "=v"(r) : "v"(x), "s"(448.f)); return r; }
__device__ __forceinline__ unsigned pk4f8(float a, float b, float c, float d) { unsigned r = 0u; r = __builtin_amdgcn_cvt_pk_fp8_f32(clamp8(a), clamp8(b), r, false); r = __builtin_amdgcn_cvt_pk_fp8_f32(clamp8(c), clamp8(d), r, true); return r; }


#define XB_TMO      128
#define XB_XCNT(j)  (256  + 64 * (j))
#define XB_XSUB(j)  (1280 + 64 * (j))
#define XB_XGEN(j)  (2304 + 64 * (j))
#define XB_TOP      3328
#define XB_TOPGEN   3392
#define XCD_BAR_WORDS 3456
#define XB_SPIN_CAP (1u << 22)
__device__ __forceinline__ unsigned xb_ld(unsigned* p)              { return __hip_atomic_load(p, __ATOMIC_RELAXED, __HIP_MEMORY_SCOPE_AGENT); }
__device__ __forceinline__ unsigned xb_add(unsigned* p, unsigned v) { return __hip_atomic_fetch_add(p, v, __ATOMIC_RELAXED, __HIP_MEMORY_SCOPE_AGENT); }
__device__ __forceinline__ unsigned xb_xcc_id() { return (unsigned)__builtin_amdgcn_s_getreg((3 << 11) | 20) & 0xFu; }
#define XB_SPIN(cond, bar) do { unsigned _sp = 0; while (cond) { __builtin_amdgcn_s_sleep(1); \
    if ((++_sp & 255u) == 0u) { if (xb_ld(&(bar)[XB_TMO])) break; if (_sp > XB_SPIN_CAP) { atomicAdd(&(bar)[XB_TMO], 1u); break; } } } } while (0)
struct XcdBarrier { unsigned* bar; unsigned x; volatile LAS unsigned* st; };
__device__ __forceinline__ XcdBarrier xcd_barrier_post(unsigned* bar, volatile LAS unsigned* st) {
    XcdBarrier b; b.bar = bar; b.x = xb_xcc_id(); b.st = st;
    if (threadIdx.x == 0) (void)xb_add(&bar[XB_XCNT(b.x)], 1u);
    return b;
}
__device__ __forceinline__ void xcd_barrier_complete(unsigned* bar, unsigned x, unsigned& nloc, unsigned& nx) {
    const unsigned G = gridDim.x * gridDim.y * gridDim.z;
    unsigned sum, cnt, mine, sp = 0u;
    for (;;) {
        sum = 0u; cnt = 0u; mine = 0u;
#pragma unroll
        for (unsigned j = 0; j < 16; ++j) { const unsigned c = xb_ld(&bar[XB_XCNT(j)]); sum += c; cnt += (c > 0u) ? 1u : 0u; mine = (j == x) ? c : mine; }
        if (sum == G) break;
        __builtin_amdgcn_s_sleep(1);
        if ((++sp & 255u) == 0u) { if (xb_ld(&bar[XB_TMO])) break; if (sp > XB_SPIN_CAP) { atomicAdd(&bar[XB_TMO], 1u); break; } }
    }
    nloc = mine > 0u ? mine : 1u; nx = cnt > 0u ? cnt : 1u;
}
__device__ __forceinline__ void xcd_barrier(const XcdBarrier& b) {
    asm volatile("s_waitcnt vmcnt(0)" ::: "memory");
    __syncthreads();
    if (threadIdx.x == 0) {
        unsigned* bar = b.bar;
        __builtin_amdgcn_s_waitcnt(0);
        unsigned nloc = b.st[0], nx = b.st[1];
        if (nloc == 0u) { xcd_barrier_complete(bar, b.x, nloc, nx); b.st[0] = nloc; b.st[1] = nx; }
        const unsigned old = xb_add(&bar[XB_XSUB(b.x)], 1u);
        const unsigned gen = old / nloc;
        if (old + 1u == (gen + 1u) * nloc) {
            __builtin_amdgcn_fence(__ATOMIC_RELEASE, "agent");
            asm volatile("s_waitcnt vmcnt(0)" ::: "memory");
            const unsigned og = xb_add(&bar[XB_TOP], 1u);
            const unsigned tg = og / nx;
            if (og + 1u == (tg + 1u) * nx) xb_add(&bar[XB_TOPGEN], 1u);
            else XB_SPIN(xb_ld(&bar[XB_TOPGEN]) == tg, bar);
            __builtin_amdgcn_fence(__ATOMIC_ACQUIRE, "agent");
            xb_add(&bar[XB_XGEN(b.x)], 1u);
            asm volatile("s_waitcnt vmcnt(0)" ::: "memory");
        } else {
            XB_SPIN(xb_ld(&bar[XB_XGEN(b.x)]) == gen, bar);
            __builtin_amdgcn_fence(__ATOMIC_ACQUIRE, "agent");
            asm volatile("s_waitcnt vmcnt(0)" ::: "memory");
        }
    }
    __syncthreads();
}

namespace g8 {
constexpr int BM = 256, BK = 64, HALF = 128, HTB = HALF * BK * 2, STAGE_BYTES = 8 * HTB, NXCD = 8, WGM = 8;
__host__ __device__ __forceinline__ int lds_byte(int r, int c) { const int st = (r >> 4) * 2 + (c >> 5), rr = r & 15, cc = c & 31, ob = rr * 64 + cc * 2; return st * 1024 + (ob ^ (((ob >> 9) & 1) << 5)); }
__host__ __device__ __forceinline__ void stage_rc(int b, int& R, int& C) { const int st = b / 1024, sb = b % 1024, swz = sb ^ (((sb >> 9) & 1) << 5); R = (st >> 1) * 16 + swz / 64; C = (st & 1) * 32 + (swz % 64) / 2; }

struct Unit { int pm, pn, e; unsigned ao, bo; };

__device__ __forceinline__ bool tile_order(int L, int nM, int nN, int& pm, int& pn) {
    const int nwg = nM * nN; if (L >= nwg) return false;
    int wgid = L; { const int q = nwg / NXCD, r = nwg % NXCD, xcd = wgid % NXCD, off = wgid / NXCD; wgid = (xcd < r ? xcd * (q + 1) : r * (q + 1) + (xcd - r) * q) + off; }
    const int nig = WGM * nN, gid = wgid / nig, fm = gid * WGM, gsz = (nM - fm) < WGM ? (nM - fm) : WGM;
    pm = fm + ((wgid % nig) % gsz); pn = (wgid % nig) / gsz; return true;
}
struct StaticSched {
    static constexpr bool GATHER = false;
    const void* A; const void* Bt; int apitch_, bpitch, nM, nN, G, c;
    __device__ __forceinline__ int apitch() const { return apitch_; }
    __device__ __forceinline__ const void* abase() const { return A; }
    __device__ __forceinline__ const void* bbase() const { return Bt; }
    __device__ __forceinline__ bool next(int i, Unit& u) const {
        if (!tile_order(i * G + c, nM, nN, u.pm, u.pn)) return false;
        u.e = 0; u.ao = (unsigned)u.pm * BM * (unsigned)apitch_; u.bo = (unsigned)u.pn * BM * (unsigned)bpitch; return true;
    }
    __device__ __forceinline__ void aoff(const Unit&, unsigned (&)[4]) const {}
};

#ifndef EPI_REP_MASK
#define EPI_REP_MASK 0
#endif
template <class E> struct EpiId { static constexpr int id = 31; };
template <class E> struct EpiLds { static constexpr bool v = false; };
template <class E> struct EpiRS { static constexpr bool v = false; };
constexpr int LDS_RS = 132096;
#define G8_WAIT_V(n) asm volatile("s_waitcnt vmcnt(" #n ")" ::: "memory")
#define G8_WAIT_L(n) asm volatile("s_waitcnt lgkmcnt(" #n ")" ::: "memory")
#define G8_BAR __builtin_amdgcn_s_barrier()
#define G8_SCHED __builtin_amdgcn_sched_barrier(0)

template <bool F8 = false, class Epi, class Sched>
__device__ __forceinline__ void gemm_phase(LAS unsigned char* lds, const int K, const Sched& S, const Epi& E, const int bpitch_bytes = 0) {
    const int tid = tid_fresh(), wid = __builtin_amdgcn_readfirstlane(tid >> 6), lane = tid & 63, wr = wid >> 2, wc = wid & 3, fr = lane & 15, fq = lane >> 4;
    constexpr int ES = F8 ? 1 : 2, KSTR = F8 ? 16 : 1024;
    const int nt = K * ES / 128;
    int R0, C0; stage_rc(tid * 16, R0, C0);
    const int bpitch = bpitch_bytes ? bpitch_bytes : K * ES, apitch = S.apitch();
    const unsigned vb0 = (unsigned)(R0 * bpitch + C0 * 2);
    unsigned va0 = (unsigned)(R0 * apitch + C0 * 2);
    const unsigned kstep = 128u;
    const unsigned hB = (unsigned)HALF * bpitch, qB = 64u * bpitch, hA = (unsigned)HALF * apitch, qA = 64u * apitch;
    const __amdgpu_buffer_rsrc_t rA = __builtin_amdgcn_make_buffer_rsrc((void*)S.abase(), 0, -1, 0x00020000), rB = __builtin_amdgcn_make_buffer_rsrc((void*)S.bbase(), 0, -1, 0x00020000);
    const unsigned ldsw = (unsigned)wid * 1024u;
    const int aoff = lds_byte(wr * 64 + fr, F8 ? fq * 16 : fq * 8), boff = lds_byte(wc * 32 + fr, F8 ? fq * 16 : fq * 8);
    unsigned ldsA = (unsigned)(size_t)lds + (unsigned)aoff, ldsB = (unsigned)(size_t)lds + 65536u + (unsigned)boff;
    asm volatile("" : "+v"(ldsA), "+v"(ldsB), "+v"(va0));
#define G8_SA(b, h) (((b) * 2 + (h)) * HTB)
#define G8_SB(b, h) ((4 + (b) * 2 + (h)) * HTB)
#define G8_BLDS(rsrc, voff, soff, ldsoff) __builtin_amdgcn_raw_ptr_buffer_load_lds(rsrc, (LAS void*)(lds + (ldsoff) + ldsw), 16, (int)(voff), (int)(soff), 0, 0)
#define G8_STAGE_B(b, h, sb) do { const unsigned s_ = (sb) + (h) * hB; G8_BLDS(rB, vb0, s_, G8_SB(b, h)); G8_BLDS(rB, vb0, s_ + qB, G8_SB(b, h) + 8192); } while (0)
#define G8_STAGE_A(b, h, sa, VV) do { if constexpr (Sched::GATHER) { G8_BLDS(rA, VV[2 * (h)], (sa), G8_SA(b, h)); G8_BLDS(rA, VV[2 * (h) + 1], (sa), G8_SA(b, h) + 8192); } \
        else { const unsigned s_ = (sa) + (h) * hA; G8_BLDS(rA, va0, s_, G8_SA(b, h)); G8_BLDS(rA, va0, s_ + qA, G8_SA(b, h) + 8192); } } while (0)
#define G8_LD16(base, off) (*(const LAS i32x4*)(size_t)((base) + (unsigned)(off)))
#define G8_LDA(dst, b, h) do { _Pragma("unroll") for (int m = 0; m < 4; ++m) dst[m] = __builtin_shufflevector(G8_LD16(ldsA, ((b) * 2 + (h)) * HTB + m * 2048), G8_LD16(ldsA, ((b) * 2 + (h)) * HTB + m * 2048 + KSTR), 0, 1, 2, 3, 4, 5, 6, 7); } while (0)
#define G8_LDB(dst, b, h) do { _Pragma("unroll") for (int n = 0; n < 2; ++n) dst[n] = __builtin_shufflevector(G8_LD16(ldsB, ((b) * 2 + (h)) * HTB + n * 2048), G8_LD16(ldsB, ((b) * 2 + (h)) * HTB + n * 2048 + KSTR), 0, 1, 2, 3, 4, 5, 6, 7); } while (0)
#define G8_LO(x) __builtin_bit_cast(bf16x8, __builtin_shufflevector((x), (x), 0, 1, 2, 3))
#define G8_HI(x) __builtin_bit_cast(bf16x8, __builtin_shufflevector((x), (x), 4, 5, 6, 7))
#define G8_MMA(ai, bj, At, Bt) do { __builtin_amdgcn_s_setprio(1); _Pragma("unroll") for (int m = 0; m < 4; ++m) _Pragma("unroll") for (int n = 0; n < 2; ++n) { \
        if constexpr (F8) acc[ai][bj][m][n] = __builtin_amdgcn_mfma_scale_f32_16x16x128_f8f6f4(Bt[n], At[m], acc[ai][bj][m][n], 0, 0, 0, 0x7f7f7f7f, 0, 0x7f7f7f7f); \
        else { acc[ai][bj][m][n] = __builtin_amdgcn_mfma_f32_16x16x32_bf16(G8_LO(Bt[n]), G8_LO(At[m]), acc[ai][bj][m][n], 0, 0, 0); \
               acc[ai][bj][m][n] = __builtin_amdgcn_mfma_f32_16x16x32_bf16(G8_HI(Bt[n]), G8_HI(At[m]), acc[ai][bj][m][n], 0, 0, 0); } } \
        __builtin_amdgcn_s_setprio(0); } while (0)
    Unit cur, nxt; int ui = 0;
    if (!S.next(0, cur)) return;
    f32x4 acc[2][2][4][2];
#pragma unroll
    for (int a = 0; a < 2; ++a)
#pragma unroll
        for (int b = 0; b < 2; ++b)
#pragma unroll
            for (int m = 0; m < 4; ++m)
#pragma unroll
                for (int n = 0; n < 2; ++n) acc[a][b][m][n] = (f32x4){0.f, 0.f, 0.f, 0.f};
    i32x8 At[4], B0[2], B1[2];
    unsigned vA[4] = {0u, 0u, 0u, 0u};
    LAS u32x4* vnext = (LAS u32x4*)(lds + 139264 + tid * 16);
    if constexpr (Sched::GATHER) { S.aoff(cur, vA); asm volatile("" : "+v"(vA[0]), "+v"(vA[1]), "+v"(vA[2]), "+v"(vA[3])); }
    unsigned cA = cur.ao, cB = cur.bo;
    G8_STAGE_B(0, 0, cB); G8_STAGE_A(0, 0, cA, vA); G8_STAGE_B(0, 1, cB); G8_STAGE_A(0, 1, cA, vA);
    if (wr == 1) G8_BAR;
    G8_WAIT_V(4); G8_BAR;
    G8_STAGE_B(1, 0, cB + kstep); G8_STAGE_A(1, 0, cA + kstep, vA); G8_STAGE_B(1, 1, cB + kstep);
    G8_WAIT_V(6); G8_BAR;
    for (;;) {
        const bool has_next = S.next(ui + 1, nxt);
        const unsigned nA = has_next ? nxt.ao : cA, nB = has_next ? nxt.bo : cB;
        if constexpr (Sched::GATHER) { unsigned vN[4] = {vA[0], vA[1], vA[2], vA[3]};
            if (has_next) S.aoff(nxt, vN);
            *vnext = (u32x4){vN[0], vN[1], vN[2], vN[3]}; }
        if constexpr (EpiRS<Epi>::v) {
            if (wid < 4) __builtin_amdgcn_global_load_lds(E.rs + cur.pm * 256 + wid * 64 + lane, (LAS void*)(lds + LDS_RS + (ui & 1) * 1024 + wid * 256), 4, 0, 0); }
        for (int t = 0; t < nt; t += 2) {
            const bool last = (t == nt - 2);
            const unsigned a1 = cA + (unsigned)(t + 1) * kstep;
            const unsigned a2 = last ? nA : cA + (unsigned)(t + 2) * kstep, b2 = last ? nB : cB + (unsigned)(t + 2) * kstep;
            const unsigned a3 = a2 + kstep, b3 = b2 + kstep;
            G8_LDB(B0, 0, 0); G8_SCHED; G8_LDA(At, 0, 0); G8_STAGE_A(1, 1, a1, vA);
            if constexpr (Sched::GATHER) { if (last) { const u32x4 v_ = *vnext; vA[0] = v_.x; vA[1] = v_.y; vA[2] = v_.z; vA[3] = v_.w; } }
            G8_WAIT_L(8); G8_BAR; G8_WAIT_L(0); G8_MMA(0, 0, At, B0); G8_BAR; G8_SCHED;
            G8_LDB(B1, 0, 1); G8_STAGE_B(0, 0, b2);
            G8_BAR; G8_WAIT_L(0); G8_MMA(0, 1, At, B1); G8_BAR;
            G8_LDA(At, 0, 1); G8_STAGE_A(0, 0, a2, vA);
            G8_BAR; G8_WAIT_L(0); G8_MMA(1, 0, At, B0); G8_BAR; G8_SCHED;
            G8_STAGE_B(0, 1, b2);
            G8_WAIT_V(6); G8_BAR; G8_MMA(1, 1, At, B1); G8_BAR;
            G8_LDB(B0, 1, 0); G8_SCHED; G8_LDA(At, 1, 0); G8_STAGE_A(0, 1, a2, vA);
            G8_WAIT_L(8); G8_BAR; G8_WAIT_L(0); G8_MMA(0, 0, At, B0); G8_BAR; G8_SCHED;
            G8_LDB(B1, 1, 1); G8_STAGE_B(1, 0, b3);
            G8_BAR; G8_WAIT_L(0); G8_MMA(0, 1, At, B1); G8_BAR;
            G8_LDA(At, 1, 1); G8_STAGE_A(1, 0, a3, vA);
            G8_BAR; G8_WAIT_L(0); G8_MMA(1, 0, At, B0); G8_BAR; G8_SCHED;
            G8_STAGE_B(1, 1, b3);
            G8_WAIT_V(6); G8_BAR; G8_MMA(1, 1, At, B1); G8_BAR;
        }
        if constexpr (!Epi::AFTER_DRAIN) {
            if constexpr (((EPI_REP_MASK >> EpiId<Epi>::id) & 1) != 0) { const int l0_ = tid_fresh() & 63;
                if constexpr (EpiRS<Epi>::v) E(acc, cur, wr, wc, l0_ & 15, l0_ >> 4, (const LAS float*)(lds + LDS_RS + (ui & 1) * 1024));
                else if constexpr (EpiLds<Epi>::v) E(acc, cur, wr, wc, l0_ & 15, l0_ >> 4, lds); else E(acc, cur, wr, wc, l0_ & 15, l0_ >> 4);
                asm volatile("" ::: "memory");
#pragma unroll
                for (int a = 0; a < 2; ++a)
#pragma unroll
                    for (int b = 0; b < 2; ++b)
#pragma unroll
                        for (int m = 0; m < 4; ++m)
#pragma unroll
                            for (int n = 0; n < 2; ++n) asm volatile("" : "+v"(acc[a][b][m][n])); }
            const int l_ = tid_fresh() & 63;
            if constexpr (EpiRS<Epi>::v) E(acc, cur, wr, wc, l_ & 15, l_ >> 4, (const LAS float*)(lds + LDS_RS + (ui & 1) * 1024));
            else if constexpr (EpiLds<Epi>::v) E(acc, cur, wr, wc, l_ & 15, l_ >> 4, lds);
            else E(acc, cur, wr, wc, l_ & 15, l_ >> 4); }
        if (!has_next) break;
#pragma unroll
        for (int a = 0; a < 2; ++a)
#pragma unroll
            for (int b = 0; b < 2; ++b)
#pragma unroll
                for (int m = 0; m < 4; ++m)
#pragma unroll
                    for (int n = 0; n < 2; ++n) acc[a][b][m][n] = (f32x4){0.f, 0.f, 0.f, 0.f};
        cur = nxt; cA = nA; cB = nB; ++ui;
    }
    G8_WAIT_V(0);
    if (wr == 0) G8_BAR;
    G8_BAR;
    if constexpr (Epi::AFTER_DRAIN) { const int l_ = tid_fresh() & 63; E.fused(acc, cur, wr, wc, l_ & 15, l_ >> 4, lds); }
#undef G8_SA
#undef G8_SB
#undef G8_BLDS
#undef G8_STAGE_A
#undef G8_STAGE_B
#undef G8_LDA
#undef G8_LDB
#undef G8_LD16
#undef G8_LO
#undef G8_HI
#undef G8_MMA
}

struct EpiBf16 {
    static constexpr bool AFTER_DRAIN = false;
    bf16* O; int ldc;
    __device__ __forceinline__ void operator()(const f32x4 (&acc)[2][2][4][2], const Unit& u, int wr, int wc, int fr, int fq) const {
        const int row0 = u.pm * BM + wr * 64 + fr, col0 = u.pn * BM + wc * 64 + 8 * fq;
#pragma unroll
        for (int ai = 0; ai < 2; ++ai)
#pragma unroll
            for (int m = 0; m < 4; ++m) { bf16* rowp = O + (size_t)(row0 + ai * HALF + m * 16) * ldc + col0;
#pragma unroll
                for (int bj = 0; bj < 2; ++bj) { const f32x4 v0 = acc[ai][bj][m][0], v1 = acc[ai][bj][m][1];
                    u32x4 w; w.x = pk2(v0[0], v0[1]); w.y = pk2(v0[2], v0[3]); w.z = pk2(v1[0], v1[1]); w.w = pk2(v1[2], v1[3]); *(u32x4*)(rowp + bj * 32) = w; } }
    }
};
struct EpiSwiGLU {
    static constexpr bool AFTER_DRAIN = false;
    bf16* O; int ldc; const float* rs;
    __device__ __forceinline__ void operator()(const f32x4 (&acc)[2][2][4][2], const Unit& u, int wr, int wc, int fr, int fq, const LAS float* rsl) const {
        const int row0 = u.pm * BM + wr * 64 + fr, col0 = u.pn * (BM / 2) + wc * 32 + 8 * fq;
#pragma unroll
        for (int ai = 0; ai < 2; ++ai)
#pragma unroll
            for (int m = 0; m < 4; ++m) { bf16* rowp = O + (size_t)(row0 + ai * HALF + m * 16) * ldc + col0; u32x4 w; const float rr = rsl[wr * 64 + fr + ai * HALF + m * 16];
#pragma unroll
                for (int bj = 0; bj < 2; ++bj) { const f32x4 g = acc[ai][bj][m][0], up = acc[ai][bj][m][1]; const float k1 = -rr * 1.4426950408889634f, k2 = rr * rr;
                    const f32x2 a = swiglu2((f32x2){g[0], g[1]}, (f32x2){up[0], up[1]}, k1, k2), b = swiglu2((f32x2){g[2], g[3]}, (f32x2){up[2], up[3]}, k1, k2);
                    const unsigned x = pk2(a[0], a[1]), y = pk2(b[0], b[1]); if (bj == 0) { w.x = x; w.y = y; } else { w.z = x; w.w = y; } }
                *(u32x4*)rowp = w; }
    }
};
}

struct Params {
    const float* in[29];
    float* out;
    unsigned char* ws;
    int ph_lo, ph_hi;
};
enum { I_X = 0, I_NMPRE, I_NMPOST, I_NFPRE, I_NFPOST, I_WIN, I_CPE, I_CW1, I_CB1, I_CW2, I_CB2, I_CONVW, I_CONVB, I_CLNG, I_CLNB, I_WOUT, I_FWG, I_FWU, I_FWD,
       I_GWIN, I_GLNG, I_GLNB, I_GWS, I_GBS, I_GWOUT, I_MWR, I_MWG, I_MWU, I_MWD };

__device__ __forceinline__ void tr_tile(const float* src0, const float* src1, int ld, int K, bf16* dst, int k0, int n0, int mode, LAS float* scr, int lane, float f8scale = 1.f, const float* kgain = nullptr) {
    const int q = lane & 15, kr = lane >> 4;
    const int v = n0 + 4 * q;
    const float* sp = src0; int col = v; bool zero = false;
    if (mode == 1) {
        if (v < 1280) col = v;
        else if (v < 2304) { const int w = v - 1280, g32 = w >> 5, r = w & 31, ch = g32 * 16 + (r & 15); col = (r < 16) ? 1304 + ch : 1816 + ch; }
        else if (v < 2328) col = 1280 + (v - 2304);
        else zero = true;
    } else if (mode == 2) {
        const int g32 = v >> 5, r = v & 31; col = g32 * 16 + (r & 15); sp = (r < 16) ? src0 : src1;
    } else if (mode == 3 || mode == 6) {
        col = ((v >> 8) << 7) + (((v >> 5) & 3) << 5) + (((v >> 2) & 3) << 3) + (((v >> 7) & 1) << 2); sp = ((v >> 4) & 1) ? src1 : src0;
    } else if (mode == 4 || mode == 5) {
        col = (v & ~255) + (((v >> 5) & 3) << 6) + (((v >> 7) & 1) << 5) + (((v >> 2) & 3) << 3) + (((v >> 4) & 1) << 2);
    }
    f32x4 xr[16];
#pragma unroll
    for (int i = 0; i < 16; ++i) { xr[i] = (f32x4){0.f, 0.f, 0.f, 0.f}; if (!zero) xr[i] = __builtin_nontemporal_load((const f32x4*)(sp + (size_t)(k0 + kr + 4 * i) * ld + col)); }
    if (kgain) {
#pragma unroll
        for (int i = 0; i < 16; ++i) xr[i] = xr[i] * kgain[k0 + kr + 4 * i]; }
#pragma unroll
    for (int i = 0; i < 16; ++i) { LAS float* d = scr + (kr + 4 * i) * 65 + 4 * q; d[0] = xr[i][0]; d[1] = xr[i][1]; d[2] = xr[i][2]; d[3] = xr[i][3]; }
    WAVE_FENCE();
    if (mode == 3 || mode == 4) {
        const int c = lane & 3;
#pragma unroll
        for (int j = 0; j < 4; ++j) { const int n = (lane >> 2) + 16 * j; const LAS float* s = scr + (16 * c) * 65 + n;
            u32x4 o; o.x = pk4f8(s[0 * 65] * f8scale, s[1 * 65] * f8scale, s[2 * 65] * f8scale, s[3 * 65] * f8scale); o.y = pk4f8(s[4 * 65] * f8scale, s[5 * 65] * f8scale, s[6 * 65] * f8scale, s[7 * 65] * f8scale);
            o.z = pk4f8(s[8 * 65] * f8scale, s[9 * 65] * f8scale, s[10 * 65] * f8scale, s[11 * 65] * f8scale); o.w = pk4f8(s[12 * 65] * f8scale, s[13 * 65] * f8scale, s[14 * 65] * f8scale, s[15 * 65] * f8scale);
            *(u32x4*)((unsigned char*)dst + (size_t)(n0 + n) * K + k0 + 16 * c) = o; }
        WAVE_FENCE(); return; }
    const int c = lane & 7;
#pragma unroll
    for (int j = 0; j < 8; ++j) { const int n = (lane >> 3) + 8 * j; const LAS float* s = scr + (8 * c) * 65 + n;
        u32x4 o; o.x = pk2(s[0 * 65], s[1 * 65]); o.y = pk2(s[2 * 65], s[3 * 65]); o.z = pk2(s[4 * 65], s[5 * 65]); o.w = pk2(s[6 * 65], s[7 * 65]);
        *(u32x4*)(dst + (size_t)(n0 + n) * K + k0 + 8 * c) = o; }
    WAVE_FENCE();
}

template <bool BF>
__device__ __forceinline__ void row_load(const void* rowp, int lane, f32x4 (&h)[4]) {
#pragma unroll
    for (int j = 0; j < 4; ++j) {
        if (BF) { const u32x2 w = *(const u32x2*)((const bf16*)rowp + 4 * lane + 256 * j); h[j] = (f32x4){bflo(w.x), bfhi(w.x), bflo(w.y), bfhi(w.y)}; }
        else h[j] = *(const f32x4*)((const float*)rowp + 4 * lane + 256 * j); }
}
template <bool BF>
__device__ __forceinline__ void row_norm(const void* base, const bf16* mrow, const float* gpost, bf16* hout, const float* gpre, bf16* urow, int lane, f32x4 (&h)[4]) {
    row_load<BF>(base, lane, h);
    if (mrow) {
        f32x4 mv[4]; float ss = 0.f;
#pragma unroll
        for (int j = 0; j < 4; ++j) { const u32x2 w = *(const u32x2*)(mrow + 4 * lane + 256 * j); mv[j] = (f32x4){bflo(w.x), bfhi(w.x), bflo(w.y), bfhi(w.y)};
            ss += mv[j][0] * mv[j][0] + mv[j][1] * mv[j][1] + mv[j][2] * mv[j][2] + mv[j][3] * mv[j][3]; }
        const float r = rsqrtf(wave_sum(ss) * (1.f / D) + EPS);
#pragma unroll
        for (int j = 0; j < 4; ++j) { const f32x4 g = *(const f32x4*)(gpost + 4 * lane + 256 * j); h[j] = h[j] + mv[j] * r * g;
            u32x2 w; w.x = pk2(h[j][0], h[j][1]); w.y = pk2(h[j][2], h[j][3]); *(u32x2*)(hout + 4 * lane + 256 * j) = w; }
    }
    if (urow) {
        float ss = 0.f;
#pragma unroll
        for (int j = 0; j < 4; ++j) ss += h[j][0] * h[j][0] + h[j][1] * h[j][1] + h[j][2] * h[j][2] + h[j][3] * h[j][3];
        const float r = rsqrtf(wave_sum(ss) * (1.f / D) + EPS);
#pragma unroll
        for (int j = 0; j < 4; ++j) { const f32x4 g = *(const f32x4*)(gpre + 4 * lane + 256 * j); h[j] = h[j] * r * g;
            u32x2 w; w.x = pk2(h[j][0], h[j][1]); w.y = pk2(h[j][2], h[j][3]); *(u32x2*)(urow + 4 * lane + 256 * j) = w; }
    }
}

constexpr int MOE_T_GU = 16 * 112, MOE_T_D = 56 * 16, MOE_TILES = NE * (MOE_T_GU + MOE_T_D);
constexpr int MOE_N1 = 4736, MOE_N6 = 6144, MOE_N2 = 7808, MOE_TILES_LATER = MOE_N1 + MOE_N6 + MOE_N2;
constexpr int MOE_N13 = 2816;
static_assert(MOE_TILES_LATER + MOE_N13 <= MOE_TILES && MOE_N13 <= NE * MOE_T_D, "tile split");
__device__ __forceinline__ void moe_convert_tile(const Params& p, int it, LAS float* scr, int lane) {
    unsigned char* ws = p.ws;
    if (it < NE * MOE_T_GU) { const int e = it / MOE_T_GU, rr = it % MOE_T_GU;
#if MOE_F8
        tr_tile(p.in[I_MWG] + (size_t)e * D * EFF, p.in[I_MWU] + (size_t)e * D * EFF, EFF, D, (bf16*)(ws + WS_WMGU + (size_t)e * 2 * EFF * D), (rr / 112) * 64, (rr % 112) * 64, 3, scr, lane, MOE_SGU);
#else
        tr_tile(p.in[I_MWG] + (size_t)e * D * EFF, p.in[I_MWU] + (size_t)e * D * EFF, EFF, D, (bf16*)(ws + WS_WMGU) + (size_t)e * 2 * EFF * D, (rr / 112) * 64, (rr % 112) * 64, 6, scr, lane);
#endif
    } else { const int r = it - NE * MOE_T_GU, e = r / MOE_T_D, rr = r % MOE_T_D;
#if MOE_F8
        tr_tile(p.in[I_MWD] + (size_t)e * EFF * D, nullptr, D, EFFP, (bf16*)(ws + WS_WMD + (size_t)e * D * EFFP), (rr / 16) * 64, (rr % 16) * 64, 4, scr, lane, MOE_SD);
#else
        tr_tile(p.in[I_MWD] + (size_t)e * EFF * D, nullptr, D, EFF, (bf16*)(ws + WS_WMD) + (size_t)e * D * EFF, (rr / 16) * 64, (rr % 16) * 64, 0, scr, lane);
#endif
    }
}
__device__ __forceinline__ void moe_convert_range(const Params& p, LAS unsigned char* lds, int t0, int t1, int widx, int nw) {
    const int tid = tid_fresh(), lane = tid & 63, wave = tid >> 6; LAS float* scr = (LAS float*)(lds + wave * 16640);
    for (int it = t0 + widx; it < t1; it += nw) moe_convert_tile(p, it, scr, lane);
}

template <bool BF>
__device__ __forceinline__ void row_norm2(const void* baseA, const bf16* mA, bf16* houtA, bf16* uA, const void* baseB, const bf16* mB, bf16* houtB, bf16* uB,
                                          const float* gpost, const float* gpre, int lane, f32x4 (&h)[4], f32x4 (&h2)[4], float* rsA = nullptr, float* rsB = nullptr) {
    f32x4 ma[4], mb[4]; float sa = 0.f, sb = 0.f;
    row_load<BF>(baseA, lane, h); row_load<BF>(baseB, lane, h2);
#pragma unroll
    for (int j = 0; j < 4; ++j) { const u32x2 wa = *(const u32x2*)(mA + 4 * lane + 256 * j), wb = *(const u32x2*)(mB + 4 * lane + 256 * j);
        ma[j] = (f32x4){bflo(wa.x), bfhi(wa.x), bflo(wa.y), bfhi(wa.y)}; mb[j] = (f32x4){bflo(wb.x), bfhi(wb.x), bflo(wb.y), bfhi(wb.y)}; }
#pragma unroll
    for (int j = 0; j < 4; ++j) { sa += ma[j][0] * ma[j][0] + ma[j][1] * ma[j][1] + ma[j][2] * ma[j][2] + ma[j][3] * ma[j][3]; sb += mb[j][0] * mb[j][0] + mb[j][1] * mb[j][1] + mb[j][2] * mb[j][2] + mb[j][3] * mb[j][3]; }
    const float ra = rsqrtf(wave_sum(sa) * (1.f / D) + EPS), rb = rsqrtf(wave_sum(sb) * (1.f / D) + EPS);
    sa = 0.f; sb = 0.f;
#pragma unroll
    for (int j = 0; j < 4; ++j) { const f32x4 g = *(const f32x4*)(gpost + 4 * lane + 256 * j); h[j] = h[j] + ma[j] * ra * g; h2[j] = h2[j] + mb[j] * rb * g;
        u32x2 wa; wa.x = pk2(h[j][0], h[j][1]); wa.y = pk2(h[j][2], h[j][3]); *(u32x2*)(houtA + 4 * lane + 256 * j) = wa;
        u32x2 wb; wb.x = pk2(h2[j][0], h2[j][1]); wb.y = pk2(h2[j][2], h2[j][3]); *(u32x2*)(houtB + 4 * lane + 256 * j) = wb;
        sa += h[j][0] * h[j][0] + h[j][1] * h[j][1] + h[j][2] * h[j][2] + h[j][3] * h[j][3]; sb += h2[j][0] * h2[j][0] + h2[j][1] * h2[j][1] + h2[j][2] * h2[j][2] + h2[j][3] * h2[j][3]; }
    const float qa = rsqrtf(wave_sum(sa) * (1.f / D) + EPS), qb = rsqrtf(wave_sum(sb) * (1.f / D) + EPS);
    if (rsA) { if (lane == 0) { *rsA = qa; *rsB = qb; } return; }
#pragma unroll
    for (int j = 0; j < 4; ++j) { const f32x4 g = *(const f32x4*)(gpre + 4 * lane + 256 * j); h[j] = h[j] * qa * g; h2[j] = h2[j] * qb * g;
        if (uA) {
        u32x2 w; w.x = pk2(h[j][0], h[j][1]); w.y = pk2(h[j][2], h[j][3]); *(u32x2*)(uA + 4 * lane + 256 * j) = w;
        u32x2 w2; w2.x = pk2(h2[j][0], h2[j][1]); w2.y = pk2(h2[j][2], h2[j][3]); *(u32x2*)(uB + 4 * lane + 256 * j) = w2; } }
}

__device__ __forceinline__ void phase_prep(const Params& p, LAS unsigned char* lds) {
    const int tid = tid_fresh(), lane = tid & 63, wave = tid >> 6;
    const int gw = blockIdx.x * 8 + wave, NGW = gridDim.x * 8;
    LAS float* scr = (LAS float*)(lds + wave * 16640);
    unsigned char* ws = p.ws;
    constexpr int T_IN = 16 * 40, T_OUT = 16 * 16, T_GU = 16 * 88, T_DN = 44 * 16, T_GIN = 16 * 32, T_GOUT = 16 * 16, T_C1 = 2 * 32 * 4;
    constexpr int TOTAL = T_IN + T_OUT + T_GU + T_DN + T_GIN + T_GOUT + T_C1 + (MOE_TILES - MOE_TILES_LATER - MOE_N13);
    for (int it = gw; it < TOTAL; it += NGW) {
        int r = it;
        if (r < T_IN) { tr_tile(p.in[I_WIN], nullptr, IN0, D, (bf16*)(ws + WS_WIN), (r / 40) * 64, (r % 40) * 64, 1, scr, lane); continue; } r -= T_IN;
        if (r < T_OUT) { tr_tile(p.in[I_WOUT], nullptr, D, D, (bf16*)(ws + WS_WOUT), (r / 16) * 64, (r % 16) * 64, 5, scr, lane); continue; } r -= T_OUT;
#if FFN_F8
        if (r < T_GU) { tr_tile(p.in[I_FWG], p.in[I_FWU], FF, D, (bf16*)(ws + WS_WGU), (r / 88) * 64, (r % 88) * 64, 3, scr, lane, MOE_SGU); continue; } r -= T_GU;
        if (r < T_DN) { tr_tile(p.in[I_FWD], nullptr, D, FF, (bf16*)(ws + WS_WDN), (r / 16) * 64, (r % 16) * 64, 4, scr, lane, MOE_SD); continue; } r -= T_DN;
#else
        if (r < T_GU) { tr_tile(p.in[I_FWG], p.in[I_FWU], FF, D, (bf16*)(ws + WS_WGU), (r / 88) * 64, (r % 88) * 64, 6, scr, lane, 1.f, p.in[I_NFPRE]); continue; } r -= T_GU;
        if (r < T_DN) { tr_tile(p.in[I_FWD], nullptr, D, FF, (bf16*)(ws + WS_WDN), (r / 16) * 64, (r % 16) * 64, 5, scr, lane); continue; } r -= T_DN;
#endif
        if (r < T_GIN) { tr_tile(p.in[I_GWIN], nullptr, 2 * D, D, (bf16*)(ws + WS_WGIN), (r / 32) * 64, (r % 32) * 64, 5, scr, lane, 1.f, p.in[I_NMPRE] + D); continue; } r -= T_GIN;
        if (r < T_GOUT) { tr_tile(p.in[I_GWOUT], nullptr, D, D, (bf16*)(ws + WS_WGOUT), (r / 16) * 64, (r % 16) * 64, 5, scr, lane); continue; } r -= T_GOUT;
        if (r < T_C1) { const int kv = r / 128, rr = r % 128; tr_tile(p.in[I_CW1] + (size_t)kv * 2048 * 256, nullptr, 256, 2048, (bf16*)(ws + WS_WC1) + (size_t)kv * 256 * 2048, (rr / 4) * 64, (rr % 4) * 64, 0, scr, lane); continue; } r -= T_C1;
        moe_convert_tile(p, r + MOE_TILES_LATER, scr, lane);
    }
    for (int m = gw; m < NT; m += 2 * NGW) { f32x4 h[4], h2[4]; const int m2 = m + NGW; float sa = 0.f, sb = 0.f;
        row_load<false>(p.in[I_X] + (size_t)m * D, lane, h); row_load<false>(p.in[I_X] + (size_t)m2 * D, lane, h2);
#pragma unroll
        for (int j = 0; j < 4; ++j) { sa += h[j][0] * h[j][0] + h[j][1] * h[j][1] + h[j][2] * h[j][2] + h[j][3] * h[j][3]; sb += h2[j][0] * h2[j][0] + h2[j][1] * h2[j][1] + h2[j][2] * h2[j][2] + h2[j][3] * h2[j][3]; }
        const float ra = rsqrtf(wave_sum(sa) * (1.f / D) + EPS), rb = rsqrtf(wave_sum(sb) * (1.f / D) + EPS);
#pragma unroll
        for (int j = 0; j < 4; ++j) { const f32x4 g = *(const f32x4*)(p.in[I_NMPRE] + 4 * lane + 256 * j); const f32x4 a = h[j] * ra * g, b = h2[j] * rb * g;
            u32x2 w; w.x = pk2(a[0], a[1]); w.y = pk2(a[2], a[3]); *(u32x2*)((bf16*)(ws + WS_U) + (size_t)m * D + 4 * lane + 256 * j) = w;
            u32x2 w2; w2.x = pk2(b[0], b[1]); w2.y = pk2(b[2], b[3]); *(u32x2*)((bf16*)(ws + WS_U) + (size_t)m2 * D + 4 * lane + 256 * j) = w2; } }
    { const int gt = blockIdx.x * 512 + tid, NGT = gridDim.x * 512; bf16* wsb = (bf16*)(ws + WS_WSB);
      for (int i = gt; i < 8 * 128 * 128; i += NGT) { const int t = (i >> 7) & 127, s = i & 127; wsb[i] = (bf16)f2bf(s <= t ? p.in[I_GWS][i] : 0.f); } }
    if (blockIdx.x >= gridDim.x - 16) { const int b = blockIdx.x - (gridDim.x - 16), kv = b >> 3, n = (b & 7) * 32 + (tid & 31), ks = tid >> 5;
        const float* pe = p.in[I_CPE] + kv * 2048 + ks * 128; const float* w1 = p.in[I_CW1] + (size_t)kv * 2048 * 256 + (size_t)ks * 128 * 256 + n;
        float a = 0.f;
#pragma unroll 16
        for (int k = 0; k < 128; ++k) a += pe[k] * w1[(size_t)k * 256];
        __syncthreads();
        LAS float* red = (LAS float*)lds; red[tid] = a;
        __syncthreads();
        if (tid < 32) { float s = p.in[I_CB1][kv * 256 + n];
#pragma unroll
            for (int i = 0; i < 16; ++i) s += red[i * 32 + tid];
            ((float*)(ws + WS_BIAS1))[kv * 256 + n] = s; } }
    if (blockIdx.x == 1 && tid < 16) ((unsigned*)(ws + WS_CNT))[tid] = 0u;
    if (blockIdx.x == 3) { bf16* w2t = (bf16*)(ws + WS_W2T); for (int i = tid; i < 2 * 64 * 256; i += 512) { const int kv = i >> 14, n = (i >> 8) & 63, k = i & 255; w2t[i] = (bf16)f2bf(p.in[I_CW2][(size_t)kv * 256 * 64 + k * 64 + n]); } }
#if NSA_MODE >= 2
    (void)0;
#endif
}

struct EpiInProj {
    static constexpr bool AFTER_DRAIN = false;
    bf16* Q; bf16* KV; bf16* CG; float* GT;
    __device__ __forceinline__ void operator()(const f32x4 (&acc)[2][2][4][2], const g8::Unit& u, int wr, int wc, int fr, int fq) const {
        const int row0 = u.pm * 256 + wr * 64 + fr;
#pragma unroll
        for (int ai = 0; ai < 2; ++ai)
#pragma unroll
            for (int m = 0; m < 4; ++m) { const int row = row0 + ai * 128 + m * 16;
#pragma unroll
                for (int bj = 0; bj < 2; ++bj) {
                    const int cb = u.pn * 256 + bj * 128 + wc * 32 + 4 * fq;
                    if (u.pn < 2) {
#pragma unroll
                        for (int n = 0; n < 2; ++n) { const f32x4 v = acc[ai][bj][m][n] * QSCALE; u32x2 w; w.x = pk2(v[0], v[1]); w.y = pk2(v[2], v[3]); *(u32x2*)(Q + (size_t)row * 512 + cb + 16 * n) = w; }
                    } else if (u.pn < 5) {
                        const int b = row >> 12, s = row & 4095;
#pragma unroll
                        for (int n = 0; n < 2; ++n) { const int cc = cb + 16 * n - 512, j = cc >> 7, g = (cc >> 6) & 1, d = cc & 63; const f32x4 v = acc[ai][bj][m][n];
                            u32x2 w; w.x = pk2(v[0], v[1]); w.y = pk2(v[2], v[3]); *(u32x2*)(KV + ((((size_t)j * 4 + b) * 2 + g) * 4096 + s) * 64 + d) = w; }
                    } else if (u.pn < 9) {
                        const int ch = (((cb - 1280) >> 5) << 4) + 4 * fq; const f32x4 a = acc[ai][bj][m][0], bb = acc[ai][bj][m][1];
                        u32x2 w; w.x = pk2(a[0] * sigm(bb[0]), a[1] * sigm(bb[1])); w.y = pk2(a[2] * sigm(bb[2]), a[3] * sigm(bb[3])); *(u32x2*)(CG + (size_t)row * 512 + ch) = w;
                    } else {
#pragma unroll
                        for (int n = 0; n < 2; ++n) { const int cg0 = cb + 16 * n - 2304;
                            if (cg0 < 24) { const f32x4 v = acc[ai][bj][m][n]; *(f32x4*)(GT + (size_t)row * 24 + cg0) = (f32x4){sigm(v[0]), sigm(v[1]), sigm(v[2]), sigm(v[3])}; } }
                    }
                } }
    }
};

struct CmpSched {
    static constexpr bool GATHER = false;
    const bf16* A; const bf16* Bt; int pm;
    __device__ __forceinline__ int apitch() const { return 2048; }
    __device__ __forceinline__ const void* abase() const { return A; }
    __device__ __forceinline__ const void* bbase() const { return Bt; }
    __device__ __forceinline__ bool next(int i, g8::Unit& u) const { if (i > 0) return false; u.pm = pm; u.pn = 0; u.e = 0; u.ao = (unsigned)pm * 256u * 2048u; u.bo = 0u; return true; }
    __device__ __forceinline__ void aoff(const g8::Unit&, unsigned (&)[4]) const {}
};
struct EpiCmp {
    static constexpr bool AFTER_DRAIN = false;
    bf16* O; const float* bias;
    __device__ __forceinline__ void operator()(const f32x4 (&acc)[2][2][4][2], const g8::Unit& u, int wr, int wc, int fr, int fq) const {
        const int row0 = u.pm * 256 + wr * 64 + fr, col0 = wc * 32 + 4 * fq;
#pragma unroll
        for (int ai = 0; ai < 2; ++ai)
#pragma unroll
            for (int m = 0; m < 4; ++m) { bf16* rowp = O + (size_t)(row0 + ai * 128 + m * 16) * 256 + col0;
#pragma unroll
                for (int bj = 0; bj < 2; ++bj)
#pragma unroll
                    for (int n = 0; n < 2; ++n) { const f32x4 bv = *(const f32x4*)(bias + col0 + bj * 128 + n * 16); const f32x4 v = acc[ai][bj][m][n] + bv;
                        u32x2 w; w.x = pk2(gelu_tanh(v[0]), gelu_tanh(v[1])); w.y = pk2(gelu_tanh(v[2]), gelu_tanh(v[3])); *(u32x2*)(rowp + bj * 128 + n * 16) = w; } }
    }
};

__device__ __forceinline__ void phase_cmp_conv(const Params& p, LAS unsigned char* lds) {
    const int tid = tid_fresh(), lane = tid & 63, wave = tid >> 6;
    unsigned char* ws = p.ws;
    if (blockIdx.x < 16) {
        const int kv = blockIdx.x >> 3, pm = blockIdx.x & 7;
        const bf16* A = (const bf16*)(ws + WS_KV) + (size_t)kv * (4 * 2 * 4096 * 64);
        bf16* H1 = (bf16*)(ws + WS_H1C) + (size_t)kv * 2048 * 256;
        CmpSched S{A, (const bf16*)(ws + WS_WC1) + (size_t)kv * 256 * 2048, pm};
        EpiCmp E{H1, (const float*)(ws + WS_BIAS1) + kv * 256};
        g8::gemm_phase(lds, 2048, S, E);
        __threadfence(); __syncthreads();
        { const int q = lane & 31, h = lane >> 5; const bf16* w2t = (const bf16*)(ws + WS_W2T) + (size_t)kv * 64 * 256;
          const bf16* hr = H1 + (size_t)(pm * 256 + 32 * wave + q) * 256 + 8 * h;
          f32x16 a0, a1;
#pragma unroll
          for (int r = 0; r < 16; ++r) { a0[r] = 0.f; a1[r] = 0.f; }
#pragma unroll 4
          for (int ks = 0; ks < 16; ++ks) { const bf16x8 Af = *(const bf16x8*)(hr + 16 * ks);
              const bf16x8 B0 = *(const bf16x8*)(w2t + (size_t)q * 256 + 16 * ks + 8 * h), B1 = *(const bf16x8*)(w2t + (size_t)(32 + q) * 256 + 16 * ks + 8 * h);
              a0 = MFMA32(Af, B0, a0); a1 = MFMA32(Af, B1, a1); }
          bf16* O = (bf16*)(ws + (kv == 0 ? WS_KC : WS_VC)); bf16* VCT = (bf16*)(ws + WS_VCT);
          const float b20 = p.in[I_CB2][kv * 64 + q], b21 = p.in[I_CB2][kv * 64 + 32 + q];
#pragma unroll
          for (int r = 0; r < 16; ++r) { const int rl = 32 * wave + (r & 3) + 8 * (r >> 2) + 4 * h, row = pm * 256 + rl;
              const bf16 v0 = (bf16)f2bf(a0[r] + b20), v1 = (bf16)f2bf(a1[r] + b21);
              O[(size_t)row * 64 + q] = v0; O[(size_t)row * 64 + 32 + q] = v1;
              if (kv == 1) { VCT[((size_t)pm * 64 + q) * 256 + rl] = v0; VCT[((size_t)pm * 64 + 32 + q) * 256 + rl] = v1; } } }
    } else {
        const bf16* CG = (const bf16*)(ws + WS_CGLU); bf16* CAT = (bf16*)(ws + WS_CAT);
        const int gw = (blockIdx.x - 16) * 8 + wave, NGW = (gridDim.x - 16) * 8;
        { LAS bf16* ct = (LAS bf16*)lds;
          LAS float* yb = (LAS float*)(lds + 73728);
          float wg[31];
#pragma unroll
          for (int w = 0; w < 31; ++w) wg[w] = p.in[I_CONVW][w * 512 + tid];
          const float cb = p.in[I_CONVB][tid];
          const int ch0 = 8 * lane;
          const f32x4 lg0 = *(const f32x4*)(p.in[I_CLNG] + ch0), lg1 = *(const f32x4*)(p.in[I_CLNG] + ch0 + 4), lb0 = *(const f32x4*)(p.in[I_CLNB] + ch0), lb1 = *(const f32x4*)(p.in[I_CLNB] + ch0 + 4);
          for (int tile = blockIdx.x - 16; tile < NT / 16; tile += gridDim.x - 16) {
            const int tok0 = tile * 16, s0 = tok0 & 4095;
#pragma unroll
            for (int it = 0; it < 6; ++it) { const int i = tid + 512 * it; if (i < 46 * 64) { const int j = i >> 6, c8 = (i & 63) * 8; u32x4 v = (u32x4){0u, 0u, 0u, 0u};
                if (s0 - 30 + j >= 0) v = *(const u32x4*)(CG + (size_t)(tok0 - 30 + j) * 512 + c8);
                *(LAS u32x4*)(ct + j * 512 + c8) = v; } }
            __syncthreads();
            { float c[46];
#pragma unroll
              for (int j = 0; j < 46; ++j) c[j] = bf2f(ct[j * 512 + tid]);
#pragma unroll
              for (int t = 0; t < 16; ++t) { float a = cb;
#pragma unroll
                  for (int w = 0; w < 31; ++w) a += c[t + w] * wg[w];
                  yb[t * 512 + tid] = a; } }
            __syncthreads();
#pragma unroll
            for (int i = 0; i < 2; ++i) { const int t = 2 * wave + i; const f32x4 y0 = *(const LAS f32x4*)(yb + t * 512 + ch0), y1 = *(const LAS f32x4*)(yb + t * 512 + ch0 + 4);
                const float mu = wave_sum((y0[0] + y0[1]) + (y0[2] + y0[3]) + (y1[0] + y1[1]) + (y1[2] + y1[3])) * (1.f / 512.f);
                const f32x4 d0 = y0 - mu, d1 = y1 - mu;
                const float rs = rsqrtf(wave_sum((d0[0] * d0[0] + d0[1] * d0[1]) + (d0[2] * d0[2] + d0[3] * d0[3]) + (d1[0] * d1[0] + d1[1] * d1[1]) + (d1[2] * d1[2] + d1[3] * d1[3])) * (1.f / 512.f) + EPS);
                const f32x4 o0 = d0 * rs * lg0 + lb0, o1 = d1 * rs * lg1 + lb1;
                u32x4 w; w.x = pk2(silu(o0[0]), silu(o0[1])); w.y = pk2(silu(o0[2]), silu(o0[3])); w.z = pk2(silu(o1[0]), silu(o1[1])); w.w = pk2(silu(o1[2]), silu(o1[3]));
                *(u32x4*)(CAT + (size_t)(tok0 + t) * 1024 + 512 + ch0) = w; }
          } }
#if NSA_VT
        LAS bf16* sc = (LAS bf16*)(lds + wave * 8704);
        const bf16* KV = (const bf16*)(ws + WS_KV); bf16* VT = (bf16*)(ws + WS_VT); const size_t kvs = (size_t)4 * 2 * 4096 * 64;
        for (int it = gw; it < 2 * 8 * 64; it += NGW) {
            const int jj = it >> 9, bgx = (it >> 6) & 7, st = it & 63;
            const bf16* src = KV + (size_t)(3 + 2 * jj) * kvs + ((size_t)bgx * 4096 + st * 64) * 64;
            bf16* dst = VT + ((size_t)(jj * 8 + bgx) * 64) * 4096 + st * 64;
#pragma unroll
            for (int i = 0; i < 8; ++i) { const int row = (lane >> 3) + 8 * i, ch = lane & 7; const u32x4 v = *(const u32x4*)(src + row * 64 + ch * 8);
                *(LAS u32x2*)(sc + row * 68 + ch * 8) = (u32x2){v.x, v.y}; *(LAS u32x2*)(sc + row * 68 + ch * 8 + 4) = (u32x2){v.z, v.w}; }
            WAVE_FENCE();
#pragma unroll
            for (int i = 0; i < 8; ++i) { const int d = (lane >> 3) + 8 * i, c8 = (lane & 7) * 8; const LAS bf16* s = sc + c8 * 68 + d;
                u32x4 o; o.x = (unsigned)s[0] | ((unsigned)s[68] << 16); o.y = (unsigned)s[2 * 68] | ((unsigned)s[3 * 68] << 16);
                o.z = (unsigned)s[4 * 68] | ((unsigned)s[5 * 68] << 16); o.w = (unsigned)s[6 * 68] | ((unsigned)s[7 * 68] << 16);
                *(u32x4*)(dst + (size_t)d * 4096 + c8) = o; }
            WAVE_FENCE();
        }
#endif
        __syncthreads();
        moe_convert_range(p, lds, MOE_N1 + MOE_N6, MOE_TILES_LATER, gw, NGW);
    }
}

__device__ __forceinline__ float dot64(const LAS float* q, const bf16* krow) {
    float a = 0.f;
#pragma unroll
    for (int c = 0; c < 8; ++c) { const u32x4 v = *(const u32x4*)(krow + 8 * c); const f32x4 q0 = *(const LAS f32x4*)(q + 8 * c), q1 = *(const LAS f32x4*)(q + 8 * c + 4);
        a += q0[0] * bflo(v.x) + q0[1] * bfhi(v.x) + q0[2] * bflo(v.y) + q0[3] * bfhi(v.y) + q1[0] * bflo(v.z) + q1[1] * bfhi(v.z) + q1[2] * bflo(v.w) + q1[3] * bfhi(v.w); }
    return a;
}
__device__ __forceinline__ void phase_nsa_simple(const Params& p, LAS unsigned char* lds) {
    const int tid = tid_fresh(), lane = tid & 63, wave = tid >> 6;
    unsigned char* ws = p.ws;
    LAS float* qs = (LAS float*)(lds + wave * 8192);
    LAS float* pb = qs + 256;
    LAS float* ocb = pb + 1024;
    const bf16* Q = (const bf16*)(ws + WS_Q); const bf16* KV = (const bf16*)(ws + WS_KV); const float* GT = (const float*)(ws + WS_GATES);
    const bf16* KC = (const bf16*)(ws + WS_KC); const bf16* VC = (const bf16*)(ws + WS_VC); bf16* CAT = (bf16*)(ws + WS_CAT);
    const int gw = blockIdx.x * 8 + wave, NGW = gridDim.x * 8;
    for (int it = gw; it < NT * 2; it += NGW) {
        const int g = it & 1, tok = it >> 1, b = tok >> 12, t = tok & 4095, bg = b * 2 + g;
        { const u32x2 w = *(const u32x2*)(Q + (size_t)tok * 512 + g * 256 + 4 * lane); *(LAS f32x4*)(qs + 4 * lane) = (f32x4){bflo(w.x), bfhi(w.x), bflo(w.y), bfhi(w.y)}; }
        WAVE_FENCE();
        const size_t kvs = (size_t)4 * 2 * 4096 * 64;
        const bf16* kslc = KV + 2 * kvs + (size_t)bg * 4096 * 64; const bf16* vslc = KV + 3 * kvs + (size_t)bg * 4096 * 64;
        const bf16* kwin = KV + 4 * kvs + (size_t)bg * 4096 * 64; const bf16* vwin = KV + 5 * kvs + (size_t)bg * 4096 * 64;
        const bf16* kc = KC + (size_t)bg * 256 * 64; const bf16* vc = VC + (size_t)bg * 256 * 64;
        const int nvis = t >= 31 ? (t - 31) / 16 + 1 : 0;
        float imp = 0.f;
        for (int hg = 0; hg < 4; ++hg) {
            float s[4]; float mx = -1e30f;
#pragma unroll
            for (int i = 0; i < 4; ++i) { const int n = lane + 64 * i; s[i] = (n < nvis) ? dot64(qs + hg * 64, kc + (size_t)n * 64) * (1.f / 1.4426950408889634f) : -1e30f; mx = fmaxf(mx, s[i]); }
            mx = wave_max(mx); float l = 0.f;
#pragma unroll
            for (int i = 0; i < 4; ++i) { const int n = lane + 64 * i; s[i] = (n < nvis) ? __expf(s[i] - mx) : 0.f; l += s[i]; }
            l = wave_sum(l); const float il = nvis > 0 ? 1.f / l : 0.f;
#pragma unroll
            for (int i = 0; i < 4; ++i) pb[lane + 64 * i] = s[i] * il;
            WAVE_FENCE();
            { float a = 0.f;
#pragma unroll
              for (int d = -1; d < 4; ++d) { const int n = 4 * lane + d; if (n >= 0) a += pb[n]; }
              imp += a; }
            float o = 0.f;
            for (int n = 0; n < nvis; ++n) o += pb[n] * bf2f(vc[(size_t)n * 64 + lane]);
            ocb[hg * 64 + lane] = o;
            WAVE_FENCE();
        }
        const int cur = t >> 6;
        const bool valid = lane <= cur, forced = (lane == 0) || (lane == cur) || (lane == cur - 1);
        const float score = valid ? imp + (forced ? 1e6f : 0.f) : -1e9f;
        int rank = 0;
        for (int i = 0; i < 64; ++i) { const float si = __shfl(score, i); rank += (si > score || (si == score && i < lane)) ? 1 : 0; }
        const unsigned long long selmask = __ballot(rank < 16);
#if NSA_MODE >= 2
        if (lane == 0) ((unsigned long long*)(ws + WS_PROBE + 4096))[(size_t)tok * 2 + g] = selmask;
#endif
        for (int hg = 0; hg < 4; ++hg) {
            const LAS float* qh = qs + hg * 64;
            float s[16]; float mx = -1e30f; unsigned long long mm = selmask;
#pragma unroll
            for (int i = 0; i < 16; ++i) { const int jb = __builtin_ctzll(mm); mm &= mm - 1; const int pos = jb * 64 + lane;
                s[i] = (pos <= t) ? dot64(qh, kslc + (size_t)pos * 64) * (1.f / 1.4426950408889634f) : -1e30f; mx = fmaxf(mx, s[i]); }
            mx = wave_max(mx); float l = 0.f; mm = selmask;
#pragma unroll
            for (int i = 0; i < 16; ++i) { const int jb = __builtin_ctzll(mm); mm &= mm - 1; const int pos = jb * 64 + lane; s[i] = (pos <= t) ? __expf(s[i] - mx) : 0.f; l += s[i]; }
            l = wave_sum(l); const float il = 1.f / l;
#pragma unroll
            for (int i = 0; i < 16; ++i) pb[i * 64 + lane] = s[i] * il;
            WAVE_FENCE();
            float os = 0.f; mm = selmask;
            for (int i = 0; i < 16; ++i) { const int jb = __builtin_ctzll(mm); mm &= mm - 1; if (jb * 64 > t) continue;
                const bf16* vb = vslc + (size_t)jb * 64 * 64 + lane;
                for (int k = 0; k < 64; ++k) os += pb[i * 64 + k] * bf2f(vb[k * 64]); }
            WAVE_FENCE();
            float sw[8]; mx = -1e30f;
#pragma unroll
            for (int i = 0; i < 8; ++i) { const int pos = t - 511 + lane + 64 * i; sw[i] = (pos >= 0) ? dot64(qh, kwin + (size_t)pos * 64) * (1.f / 1.4426950408889634f) : -1e30f; mx = fmaxf(mx, sw[i]); }
            mx = wave_max(mx); l = 0.f;
#pragma unroll
            for (int i = 0; i < 8; ++i) { const int pos = t - 511 + lane + 64 * i; sw[i] = (pos >= 0) ? __expf(sw[i] - mx) : 0.f; l += sw[i]; }
            l = wave_sum(l); const float ilw = 1.f / l;
#pragma unroll
            for (int i = 0; i < 8; ++i) pb[i * 64 + lane] = sw[i] * ilw;
            WAVE_FENCE();
            float ow = 0.f;
            { const int p0 = t - 511; for (int k = (p0 < 0 ? -p0 : 0); k < 512; ++k) ow += pb[k] * bf2f(vwin[(size_t)(p0 + k) * 64 + lane]); }
            WAVE_FENCE();
            const float* gt = GT + (size_t)tok * 24 + g * 12 + hg * 3;
            const float o = gt[0] * ocb[hg * 64 + lane] + gt[1] * os + gt[2] * ow;
            CAT[(size_t)tok * 1024 + g * 256 + hg * 64 + lane] = (bf16)f2bf(o);
        }
        WAVE_FENCE();
    }
}


#ifndef NSA_MODE
#define NSA_MODE 1
#endif
constexpr int NSA_KB = 0, NSA_VB = 16384, NSA_IMP = 32768, NSA_IST = 66, NSA_SEL = NSA_IMP + 4 * 64 * NSA_IST * 4;
constexpr float LOG2E = 1.0f;

__device__ __forceinline__ void nsa_load(const bf16* k, const bf16* vt, int vstride, int tid, u32x4& kr, u32x4& vr) {
    kr = *(const u32x4*)(k + tid * 8);
    vr = *(const u32x4*)(vt + (size_t)(tid >> 3) * vstride + (tid & 7) * 8);
}
__device__ __forceinline__ void nsa_store(LAS unsigned char* lds, int buf, int tid, const u32x4& kr, const u32x4& vr) {
    const int row = tid >> 3, ch = tid & 7, off = buf * 8192 + row * 128 + ((ch ^ (row & 7)) << 4);
    *(LAS u32x4*)(lds + NSA_KB + off) = kr; *(LAS u32x4*)(lds + NSA_VB + off) = vr;
}
__device__ __forceinline__ void nsa_qk(const LAS unsigned char* kb, const bf16x8 (&Qf)[4], const int (&koff)[4], f32x16& S0, f32x16& S1) {
#pragma unroll
    for (int r = 0; r < 16; ++r) { S0[r] = 0.f; S1[r] = 0.f; }
#pragma unroll
    for (int ks = 0; ks < 4; ++ks) { const bf16x8 k0 = *(const LAS bf16x8*)(kb + koff[ks]), k1 = *(const LAS bf16x8*)(kb + 4096 + koff[ks]);
        S0 = MFMA32(k0, Qf[ks], S0); S1 = MFMA32(k1, Qf[ks], S1); }
}
__device__ __forceinline__ void nsa_mask(f32x16& S0, f32x16& S1, int lo, int hi) {
#pragma unroll
    for (int r = 0; r < 16; ++r) { const int c = 16 * (r >> 3) + (r & 7);
        S0[r] = (c >= lo && c <= hi) ? S0[r] : -1e30f; S1[r] = (c + 32 >= lo && c + 32 <= hi) ? S1[r] : -1e30f; }
}
__device__ __forceinline__ float nsa_rowmax(const f32x16& S0, const f32x16& S1) {
    float mx = fmaxf(S0[0], S1[0]);
#pragma unroll
    for (int r = 1; r < 16; ++r) mx = fmaxf(mx, fmaxf(S0[r], S1[r]));
    return fmaxf(mx, __shfl_xor(mx, 32));
}
__device__ __forceinline__ void nsa_pv(const LAS unsigned char* vb, const f32x16& S0, const f32x16& S1, const int (&voff)[4], f32x16 (&O)[2]) {
#pragma unroll
    for (int s = 0; s < 4; ++s) { u32x4 w;
        if (s < 2) { w.x = pk2(S0[8 * (s & 1) + 0], S0[8 * (s & 1) + 1]); w.y = pk2(S0[8 * (s & 1) + 2], S0[8 * (s & 1) + 3]); w.z = pk2(S0[8 * (s & 1) + 4], S0[8 * (s & 1) + 5]); w.w = pk2(S0[8 * (s & 1) + 6], S0[8 * (s & 1) + 7]); }
        else       { w.x = pk2(S1[8 * (s & 1) + 0], S1[8 * (s & 1) + 1]); w.y = pk2(S1[8 * (s & 1) + 2], S1[8 * (s & 1) + 3]); w.z = pk2(S1[8 * (s & 1) + 4], S1[8 * (s & 1) + 5]); w.w = pk2(S1[8 * (s & 1) + 6], S1[8 * (s & 1) + 7]); }
        const bf16x8 Pf = __builtin_bit_cast(bf16x8, w);
#pragma unroll
        for (int mt = 0; mt < 2; ++mt) { const bf16x8 Vf = *(const LAS bf16x8*)(vb + mt * 4096 + voff[s]); O[mt] = MFMA32(Vf, Pf, O[mt]); } }
}
template <bool WITH_O>
__device__ __forceinline__ void nsa_online(f32x16& S0, f32x16& S1, float& m, float& l, f32x16 (&O)[2]) {
    const float mx = nsa_rowmax(S0, S1), mn = fmaxf(m, mx), alpha = __builtin_amdgcn_exp2f((m - mn) * LOG2E), mb = mn <= -1e29f ? 0.f : mn * LOG2E;
    float rs = 0.f;
#pragma unroll
    for (int r = 0; r < 16; ++r) { S0[r] = __builtin_amdgcn_exp2f(fmaf(S0[r], LOG2E, -mb)); S1[r] = __builtin_amdgcn_exp2f(fmaf(S1[r], LOG2E, -mb)); rs += S0[r] + S1[r]; }
    l = l * alpha + rs; m = mn;
    if (WITH_O) {
#pragma unroll
        for (int r = 0; r < 16; ++r) { O[0][r] *= alpha; O[1][r] *= alpha; } }
}

__device__ __forceinline__ void phase_nsa_fast(const Params& p, LAS unsigned char* lds, bf16* CATo, const unsigned long long* sel_in, unsigned long long* sel_out) {
    const int tid = tid_fresh(), lane = tid & 63, wave = __builtin_amdgcn_readfirstlane(tid >> 6);
    const int hg = wave & 3, th = wave >> 2, q = lane & 31, h = lane >> 5;
    unsigned char* ws = p.ws;
    const bf16* Q = (const bf16*)(ws + WS_Q); const bf16* KV = (const bf16*)(ws + WS_KV); const float* GT = (const float*)(ws + WS_GATES);
    const bf16* KC = (const bf16*)(ws + WS_KC); const bf16* VCT = (const bf16*)(ws + WS_VCT); const bf16* VT = (const bf16*)(ws + WS_VT);
    const size_t kvs = (size_t)4 * 2 * 4096 * 64;
    LAS float* imp = (LAS float*)(lds + NSA_IMP);
    LAS unsigned long long* sel = (LAS unsigned long long*)(lds + NSA_SEL);
    int koff[4], voff[4];
    { const int pr = (q & ~12) | ((q & 4) << 1) | ((q & 8) >> 1);
      const int hxk = h ^ (pr & 7), hxv = h ^ (q & 7);
#pragma unroll
      for (int s = 0; s < 4; ++s) { koff[s] = pr * 128 + (((2 * s) ^ hxk) << 4); voff[s] = q * 128 + (((2 * s) ^ hxv) << 4); } }
    for (int u = blockIdx.x; u < 256; u += gridDim.x) {
        const int bg = u & 7, pair = u >> 3, b = bg >> 1, g = bg & 1;
#ifndef NSA_HALVES
#define NSA_HALVES 2
#endif
        for (int half = 0; half < NSA_HALVES; ++half) {
            const int qt = (half & 1) ? pair : 63 - pair, t0 = qt * 64, tl = 32 * th + q, t = t0 + tl, tok = b * 4096 + t;
            bf16x8 Qf[4];
#pragma unroll
            for (int ks = 0; ks < 4; ++ks) { const u32x4 w = *(const u32x4*)(Q + (size_t)tok * 512 + g * 256 + hg * 64 + 16 * ks + 8 * h); u32x4 o;
                Qf[ks] = __builtin_bit_cast(bf16x8, w); }
            const float g0 = GT[(size_t)tok * 24 + g * 12 + hg * 3 + 0], g1 = GT[(size_t)tok * 24 + g * 12 + hg * 3 + 1], g2 = GT[(size_t)tok * 24 + g * 12 + hg * 3 + 2];
            if (tid == 0) sel[64] = 0ull;
            f32x16 OA[2], O[2], S0, S1; u32x4 kr, vr;
            const int nvis = t >= 31 ? (t - 31) / 16 + 1 : 0, ntc = (4 * qt + 3 + 63) >> 6;
            const bf16* kcb = KC + (size_t)bg * 256 * 64; const bf16* vcb = VCT + (size_t)bg * 64 * 256;
            float mc = -1e30f, lc = 0.f;
            nsa_load(kcb, vcb, 256, tid, kr, vr); nsa_store(lds, 0, tid, kr, vr); __syncthreads();
            for (int ct = 0; ct < ntc; ++ct) { const int buf = ct & 1;
                if (ct + 1 < ntc) nsa_load(kcb + (size_t)(ct + 1) * 64 * 64, vcb + (ct + 1) * 64, 256, tid, kr, vr);
                nsa_qk(lds + NSA_KB + buf * 8192, Qf, koff, S0, S1); nsa_mask(S0, S1, -1000, nvis - 64 * ct - 1 - 8 * h);
                nsa_online<false>(S0, S1, mc, lc, O);
                if (ct + 1 < ntc) nsa_store(lds, buf ^ 1, tid, kr, vr);
                __syncthreads(); }
            { const float lt = lc + __shfl_xor(lc, 32), il = lt > 0.f ? 1.f / lt : 0.f, mb = mc <= -1e29f ? 0.f : mc * LOG2E;
#pragma unroll
              for (int r = 0; r < 16; ++r) { O[0][r] = 0.f; O[1][r] = 0.f; }
              float carry_prev = 0.f;
              nsa_load(kcb, vcb, 256, tid, kr, vr); nsa_store(lds, 0, tid, kr, vr); __syncthreads();
              for (int ct = 0; ct < ntc; ++ct) { const int buf = ct & 1;
                if (ct + 1 < ntc) nsa_load(kcb + (size_t)(ct + 1) * 64 * 64, vcb + (ct + 1) * 64, 256, tid, kr, vr);
                nsa_qk(lds + NSA_KB + buf * 8192, Qf, koff, S0, S1); nsa_mask(S0, S1, -1000, nvis - 64 * ct - 1 - 8 * h);
#pragma unroll
                for (int r = 0; r < 16; ++r) { S0[r] = __builtin_amdgcn_exp2f(fmaf(S0[r], LOG2E, -mb)) * il; S1[r] = __builtin_amdgcn_exp2f(fmaf(S1[r], LOG2E, -mb)) * il; }
                LAS float* row = imp + (hg * 64 + tl) * NSA_IST + 16 * ct + 2 * h;
#pragma unroll
                for (int sx = 0; sx < 4; ++sx) { const int x8 = 8 * (sx & 1);
                    float p0, p1, p2, p3, p4, p5, p6, p7;
                    if (sx < 2) { p0 = S0[x8]; p1 = S0[x8 + 1]; p2 = S0[x8 + 2]; p3 = S0[x8 + 3]; p4 = S0[x8 + 4]; p5 = S0[x8 + 5]; p6 = S0[x8 + 6]; p7 = S0[x8 + 7]; }
                    else        { p0 = S1[x8]; p1 = S1[x8 + 1]; p2 = S1[x8 + 2]; p3 = S1[x8 + 3]; p4 = S1[x8 + 4]; p5 = S1[x8 + 5]; p6 = S1[x8 + 6]; p7 = S1[x8 + 7]; }
                    const float recv = __shfl_xor(p7, 32), cin = h ? recv : carry_prev; carry_prev = recv;
                    const float a0 = (((cin + p0) + p1) + p2) + p3, a1 = (((p3 + p4) + p5) + p6) + p7;
                    *(LAS f32x2*)(row + 4 * sx) = (f32x2){a0, a1}; }
                nsa_pv(lds + NSA_VB + buf * 8192, S0, S1, voff, O);
                if (ct + 1 < ntc) nsa_store(lds, buf ^ 1, tid, kr, vr);
                __syncthreads(); }
#pragma unroll
              for (int r = 0; r < 16; ++r) { OA[0][r] = g0 * O[0][r]; OA[1][r] = g0 * O[1][r]; } }
            { unsigned long long orm = 0ull;
              for (int i = 0; i < 8; ++i) { const int tk = wave * 8 + i; unsigned long long msk;
                if (sel_in) msk = sel_in[(size_t)(b * 4096 + t0 + tk) * 2 + g];
                else { const LAS float* sl = imp + tk * NSA_IST + lane;
                    const float im = ((sl[0] + sl[64 * NSA_IST]) + sl[2 * 64 * NSA_IST]) + sl[3 * 64 * NSA_IST];
                    const bool valid = lane <= qt, forced = (lane == 0) || (lane == qt) || (lane == qt - 1);
                    const float score = valid ? im + (forced ? 1e6f : 0.f) : -1e9f; int rank = 0;
#pragma unroll
                    for (int j = 0; j < 64; ++j) { const float sj = __builtin_bit_cast(float, __builtin_amdgcn_readlane(__builtin_bit_cast(int, score), j)); rank += (sj > score || (sj == score && j < lane)) ? 1 : 0; }
                    msk = __ballot(rank < 16); }
                if (lane == 0) { sel[tk] = msk; if (sel_out) sel_out[(size_t)(b * 4096 + t0 + tk) * 2 + g] = msk; }
                orm |= msk; }
              if (lane == 0) __hip_atomic_fetch_or(sel + 64, orm, __ATOMIC_RELAXED, __HIP_MEMORY_SCOPE_WORKGROUP); }
            __syncthreads();
            const unsigned long long mysel = sel[tl];
            const unsigned long long orall = sel[64];
            const unsigned olo = __builtin_amdgcn_readfirstlane((unsigned)orall), ohi = __builtin_amdgcn_readfirstlane((unsigned)(orall >> 32));
            { unsigned long long rem = (((unsigned long long)ohi << 32) | olo) & (qt == 63 ? ~0ull : ((2ull << qt) - 1ull));
              const bf16* kb = KV + 2 * kvs + (size_t)bg * 4096 * 64; const bf16* vb = VT + (size_t)bg * 64 * 4096;
              float m = -1e30f, l = 0.f;
#pragma unroll
              for (int r = 0; r < 16; ++r) { O[0][r] = 0.f; O[1][r] = 0.f; }
              int j = __builtin_ctzll(rem); rem &= rem - 1; int buf = 0;
              nsa_load(kb + (size_t)j * 64 * 64, vb + j * 64, 4096, tid, kr, vr); nsa_store(lds, 0, tid, kr, vr); __syncthreads();
              for (;;) { const bool more = rem != 0ull; int jn = 0;
                if (more) { jn = __builtin_ctzll(rem); rem &= rem - 1; nsa_load(kb + (size_t)jn * 64 * 64, vb + jn * 64, 4096, tid, kr, vr); }
                nsa_qk(lds + NSA_KB + buf * 8192, Qf, koff, S0, S1);
                const bool rv = (mysel >> j) & 1ull;
                if (j == qt || __ballot(rv) != ~0ull) nsa_mask(S0, S1, -1000, rv ? (j == qt ? tl - 8 * h : 1000) : -2000);
                nsa_online<true>(S0, S1, m, l, O);
                nsa_pv(lds + NSA_VB + buf * 8192, S0, S1, voff, O);
                if (more) nsa_store(lds, buf ^ 1, tid, kr, vr);
                __syncthreads();
                if (!more) break; j = jn; buf ^= 1; }
              const float lt = l + __shfl_xor(l, 32), sc = g1 / lt;
#pragma unroll
              for (int r = 0; r < 16; ++r) { OA[0][r] += sc * O[0][r]; OA[1][r] += sc * O[1][r]; } }
            { const bf16* kb = KV + 4 * kvs + (size_t)bg * 4096 * 64; const bf16* vb = VT + (size_t)(8 + bg) * 64 * 4096;
              float m = -1e30f, l = 0.f;
#pragma unroll
              for (int r = 0; r < 16; ++r) { O[0][r] = 0.f; O[1][r] = 0.f; }
              const int j0 = qt > 8 ? qt - 8 : 0;
              nsa_load(kb + (size_t)j0 * 64 * 64, vb + j0 * 64, 4096, tid, kr, vr); nsa_store(lds, 0, tid, kr, vr); __syncthreads();
              for (int j = j0; j <= qt; ++j) { const int buf = (j - j0) & 1;
                if (j < qt) nsa_load(kb + (size_t)(j + 1) * 64 * 64, vb + (j + 1) * 64, 4096, tid, kr, vr);
                nsa_qk(lds + NSA_KB + buf * 8192, Qf, koff, S0, S1);
                if (j == qt || j == qt - 8) nsa_mask(S0, S1, j == qt - 8 ? tl + 1 - 8 * h : -1000, j == qt ? tl - 8 * h : 1000);
                nsa_online<true>(S0, S1, m, l, O);
                nsa_pv(lds + NSA_VB + buf * 8192, S0, S1, voff, O);
                if (j < qt) nsa_store(lds, buf ^ 1, tid, kr, vr);
                __syncthreads(); }
              const float lt = l + __shfl_xor(l, 32), sc = g2 / lt;
#pragma unroll
              for (int r = 0; r < 16; ++r) { OA[0][r] += sc * O[0][r]; OA[1][r] += sc * O[1][r]; } }
            { bf16* orow = CATo + (size_t)tok * 1024 + g * 256 + hg * 64 + 4 * h;
#pragma unroll
              for (int mt = 0; mt < 2; ++mt)
#pragma unroll
                for (int r4 = 0; r4 < 4; ++r4) { u32x2 w; w.x = pk2(OA[mt][4 * r4], OA[mt][4 * r4 + 1]); w.y = pk2(OA[mt][4 * r4 + 2], OA[mt][4 * r4 + 3]); *(u32x2*)(orow + 32 * mt + 8 * r4) = w; } }
        }
    }
}

namespace n3 {
constexpr int SLOTB = 8192, NSLOT = 3;
constexpr int L_K = 0, L_V = NSLOT * SLOTB, L_WS = 2 * NSLOT * SLOTB  , L_ACC = L_WS + 2048  ;
constexpr int ACCP = 65, L_SEL = L_ACC + 67584  , L_TL = L_SEL + 528  , L_END = L_TL + 160;
static_assert(L_END <= LDS_MISC, "NSA LDS map");
typedef short s16x4 __attribute__((ext_vector_type(4)));
typedef short v4i16_t __attribute__((ext_vector_type(4)));
typedef LAS const char* lds_cptr;
__device__ __forceinline__ int crow(int r, int hi) { return (r & 3) + 8 * (r >> 2) + 4 * hi; }
__device__ __forceinline__ void glds16(const void* gsrc, unsigned lds_dst) { unsigned keep;
    asm volatile("s_mov_b32 %0, m0\n\ts_mov_b32 m0, %2\n\ts_nop 0\n\tglobal_load_lds_dwordx4 %1, off\n\ts_mov_b32 m0, %0" : "=&s"(keep) : "v"(gsrc), "s"(lds_dst) : "memory"); }
__device__ __forceinline__ float fadd_s(float a, float b) { float r; asm("v_add_f32_e32 %0, %1, %2" : "=v"(r) : "v"(a), "v"(b)); return r; }
__device__ __forceinline__ float fsub_s(float a, float b) { float r; asm("v_sub_f32_e32 %0, %1, %2" : "=v"(r) : "v"(a), "v"(b)); return r; }
__device__ __forceinline__ void kload8(bf16x8* kf, lds_cptr kp) {
    kf[0] = *(const LAS bf16x8*)(kp);        kf[1] = *(const LAS bf16x8*)(kp + 512);  kf[2] = *(const LAS bf16x8*)(kp + 2048); kf[3] = *(const LAS bf16x8*)(kp + 2560);
    kf[4] = *(const LAS bf16x8*)(kp + 4096); kf[5] = *(const LAS bf16x8*)(kp + 4608); kf[6] = *(const LAS bf16x8*)(kp + 6144); kf[7] = *(const LAS bf16x8*)(kp + 6656); }
__device__ __forceinline__ void kload2(bf16x8* kf, lds_cptr kp, int j) { kf[2 * j] = *(const LAS bf16x8*)(kp + j * 2048); kf[2 * j + 1] = *(const LAS bf16x8*)(kp + j * 2048 + 512); }
__device__ __forceinline__ s16x4 vtr(lds_cptr p) { return __builtin_bit_cast(s16x4, __builtin_amdgcn_ds_read_tr16_b64_v4i16((LAS v4i16_t*)p)); }
#define N3_SBAR() __builtin_amdgcn_sched_barrier(0)
#define N3_WAIT_BAR(N) asm volatile("s_waitcnt vmcnt(" #N ") lgkmcnt(0)\n\ts_barrier" ::: "memory")
__device__ __forceinline__ void kmask(f32x16& p0, f32x16& p1, int lo, int hi_) {
#pragma unroll
    for (int r = 0; r < 16; ++r) { const int kv = (r & 3) + 8 * (r >> 2); if (kv < lo || kv > hi_) p0[r] = -INFINITY; if (kv + 32 < lo || kv + 32 > hi_) p1[r] = -INFINITY; }
}
__device__ __forceinline__ void prefetch0(LAS unsigned char* lds, const bf16* Kh, const bf16* Vh) {
    const int tid = tid_fresh(), lane = tid & 63; const int wid = __builtin_amdgcn_readfirstlane(tid >> 6); const unsigned lds0 = (unsigned)(size_t)lds;
    glds16(Kh + (size_t)lane * 64 + wid * 8, (unsigned)__builtin_amdgcn_readfirstlane(lds0 + L_K + wid * 1024));
    glds16(Vh + (size_t)(16 * (wid & 3) + (lane >> 2)) * 64 + (wid >> 2) * 32 + (lane & 3) * 8, (unsigned)__builtin_amdgcn_readfirstlane(lds0 + L_V + wid * 1024));
}
template <int MODE, bool PRE = false>
__device__ __forceinline__ void stream(LAS unsigned char* lds, const bf16* Qw, const bf16* Kh, const bf16* Vh, unsigned long long tmask, int NT, int qt, int tl, unsigned long long mysel, float gate) {
    constexpr int THRL = 8;
    const int tid = tid_fresh(), lane = tid & 63, r32 = lane & 31, hi = lane >> 5; const int wid = __builtin_amdgcn_readfirstlane(tid >> 6);
    const unsigned lds0 = (unsigned)(size_t)lds;
    LAS float* wsf = (LAS float*)(lds + L_WS) + wid * 64;
    LAS float* acc = (LAS float*)(lds + L_ACC) + wid * 32 * ACCP;
    const bf16* ksrc = Kh + (size_t)lane * 64 + wid * 8;
    const bf16* vsrc = Vh + (size_t)(16 * (wid & 3) + (lane >> 2)) * 64 + (wid >> 2) * 32 + (lane & 3) * 8;
    const unsigned kdst = lds0 + L_K + wid * 1024, vdst = lds0 + L_V + wid * 1024;
    unsigned long long it = tmask; int q0, q1, q2, q3 = 0;
#define N3_NEXT(Q) do { if (it != 0ull) { Q = __builtin_ctzll(it); it &= it - 1ull; } else Q = 128 | qt; } while (0)
#define N3_DMA_K(Q, slot) do { glds16(ksrc + (size_t)((Q) & 63) * 4096, (unsigned)__builtin_amdgcn_readfirstlane(kdst + (slot))); } while (0)
#define N3_DMA_V(Q, slot) do { glds16(vsrc + (size_t)((Q) & 63) * 4096, (unsigned)__builtin_amdgcn_readfirstlane(vdst + (slot))); } while (0)
    bf16x8 kf[8];
    const lds_cptr shm3 = (lds_cptr)lds; const lds_cptr kp0 = shm3 + L_K + hi * 1024 + r32 * 16; const lds_cptr vp0 = shm3 + L_V + ((lane >> 4) & 1) * 32 + (lane & 3) * 8 + (4 * hi + ((lane & 15) >> 2)) * 64;
    N3_NEXT(q0); N3_NEXT(q1); N3_NEXT(q2);
    if (!PRE) { N3_DMA_K(q0, 0); N3_DMA_V(q0, 0); }
    N3_DMA_K(q1, SLOTB);
    bf16x8 qr[4];
#pragma unroll
    for (int d0 = 0; d0 < 4; ++d0) qr[d0] = *(const bf16x8*)(Qw + (size_t)r32 * 512 + d0 * 16 + hi * 8);
    float mhat = 0.f, l_reg = 0.f; f32x16 o[2];
#pragma unroll
    for (int r = 0; r < 16; ++r) { o[0][r] = 0.f; o[1][r] = 0.f; }
    f32x16 negm;
    { float z_; asm volatile("v_mov_b32 %0, 0" : "=v"(z_));
#pragma unroll
      for (int r = 0; r < 16; ++r) negm[r] = z_; }
    asm volatile("" : "+v"(negm));
    unsigned fprev = 0xffffffffu, fnew = 0xffffffffu;
#define N3_MASK(P0, P1, Q) do { const int jt_ = (Q); const int j_ = jt_ & 63; \
        if (MODE == 1) { fnew = ((((mysel >> j_) & 1ull) != 0ull) && !(jt_ & 128)) ? 0xffffffffu : 0u; if (jt_ == qt) kmask(P0, P1, -4 * hi, tl - 4 * hi); } \
        else { if ((qt >= 8 && j_ == qt - 8) || j_ == qt || (jt_ & 128)) { int lo_ = 0, hi__ = 63; if (qt >= 8 && j_ == qt - 8) lo_ = tl + 1; if (j_ == qt) hi__ = tl; if (jt_ & 128) hi__ = -1; \
                 kmask(P0, P1, lo_ - 4 * hi, hi__ - 4 * hi); } } } while (0)
    bool resc = false;
#define N3_RESC() do { if (resc) { asm volatile("s_waitcnt lgkmcnt(0)" ::: "memory"); \
        _Pragma("unroll") for (int d_ = 0; d_ < 2; ++d_) _Pragma("unroll") for (int r = 0; r < 16; ++r) o[d_][r] *= wsf[crow(r, hi)]; } } while (0)
    f32x16 pA0, pA1, pB0, pB1;
    int sl_prev = 0, sl_cur = 0, sl_next = SLOTB;
#define N3_ROT() do { sl_prev = sl_cur; sl_cur = sl_next; sl_next = (sl_next == (NSLOT - 1) * SLOTB) ? 0 : sl_next + SLOTB; } while (0)
    N3_DMA_K(q2, 2 * SLOTB);
    N3_WAIT_BAR(3);
    { const lds_cptr kb = kp0;
#pragma unroll
      for (int d0 = 0; d0 < 4; ++d0) { const bf16x8 b0 = *(const LAS bf16x8*)(kb + d0 * 2048), b1 = *(const LAS bf16x8*)(kb + d0 * 2048 + 512);
          if (d0 == 0) { pA0 = MFMA32(b0, qr[0], negm); pA1 = MFMA32(b1, qr[0], negm); } else { pA0 = MFMA32(b0, qr[d0], pA0); pA1 = MFMA32(b1, qr[d0], pA1); } } }
    asm volatile("s_nop 15\n\ts_nop 7" : "+v"(pA0), "+v"(pA1));
    N3_MASK(pA0, pA1, q0);
    { float rm = fmaxf(pA0[0], pA1[0]);
#pragma unroll
      for (int r = 1; r < 16; ++r) rm = fmaxf(rm, fmaxf(pA0[r], pA1[r]));
      { auto rr = __builtin_amdgcn_permlane32_swap(__float_as_uint(rm), __float_as_uint(rm), false, false); rm = fmaxf(__uint_as_float(rr[0]), __uint_as_float(rr[1])); }
      if (MODE == 1) { rm = fnew ? rm : -INFINITY; fprev = fnew; }
      const float dl = rm > -3e38f ? rm : 0.f; mhat = fadd_s(mhat, dl);
#pragma unroll
      for (int r = 0; r < 16; ++r) { pA0[r] = fsub_s(pA0[r], dl); pA1[r] = fsub_s(pA1[r], dl); }
#pragma unroll
      for (int r = 0; r < 16; ++r) negm[r] = -mhat;
      asm volatile("" : "+v"(negm));
#pragma unroll
      for (int r = 0; r < 16; ++r) { pA0[r] = __builtin_amdgcn_exp2f(pA0[r]); pA1[r] = __builtin_amdgcn_exp2f(pA1[r]); } }
    N3_WAIT_BAR(0);
    N3_NEXT(q3);
    if (3 < NT) N3_DMA_K(q3, 0);
    N3_DMA_V(q1, SLOTB);
    q0 = q1; q1 = q2; q2 = q3;
    N3_ROT();
    kload8(kf, kp0 + sl_cur);
    if (3 < NT) N3_WAIT_BAR(2); else N3_WAIT_BAR(1);
    s16x4 vlo[8], vhi[8]; u32x4 pw0, pw1, pw2, pw3;
#define N3_PKW(P, B) (MODE == 1 ? (pk2(P[B], P[B + 1]) & fprev) : pk2(P[B], P[B + 1]))
#define N3_PAF(k) __builtin_bit_cast(bf16x8, pw##k)
#define N3_VFR(i) (bf16x8){vlo[i][0], vlo[i][1], vlo[i][2], vlo[i][3], vhi[i][0], vhi[i][1], vhi[i][2], vhi[i][3]}
#define N3_PIN(x) asm volatile("" : "+v"(x))
#define N3_MX3(a, b, c) __builtin_fmaxf(__builtin_fmaxf((a), (b)), (c))
#define N3_GAPA(MF, A0, A1, A2, A3, W0, W1, PW) do { MF; sacc += A0; sacc += A1; sacc += A2; sacc += A3; N3_PIN(sacc); W0; W1; N3_PIN(PW); N3_SBAR(); } while (0)
#define N3_EX(v) __builtin_amdgcn_exp2f(v)
#define N3_GAPB(MF, X, B) do { MF; X[B] = N3_EX(X[B]); X[B + 1] = N3_EX(X[B + 1]); X[B + 2] = N3_EX(X[B + 2]); X[B + 3] = N3_EX(X[B + 3]); N3_PIN(X); N3_SBAR(); } while (0)
#define N3_VRD(i) do { vlo[i] = vtr(vp_ + (((i) >> 2) * 4096 + ((i) & 3) * 1024)); vhi[i] = vtr(vp_ + (((i) >> 2) * 4096 + ((i) & 3) * 1024 + 512)); } while (0)
#define N3_KRD(G, j) do { if (G) { kload2(kf, kp0 + sl_next, j); N3_SBAR(); } } while (0)
#define N3_STEP(C0, C1, P0, P1, t, GK, GV, GL) do { N3_SBAR(); \
    const lds_cptr vp_ = vp0 + sl_prev; \
    N3_VRD(0); N3_SBAR(); float sacc = (P0[0] + P0[1]); \
    N3_GAPA(C0 = MFMA32(kf[0], qr[0], negm), P0[2], P0[3], P0[4], P0[5],     pw0[0] = N3_PKW(P0, 0), pw0[1] = N3_PKW(P0, 2), pw0); \
    N3_VRD(4); N3_SBAR(); N3_GAPA(C1 = MFMA32(kf[1], qr[0], negm), P0[6], P0[7], P0[8], P0[9],     pw0[2] = N3_PKW(P0, 4), pw0[3] = N3_PKW(P0, 6), pw0); \
    N3_VRD(1); N3_SBAR(); N3_GAPA(C0 = MFMA32(kf[2], qr[1], C0),   P0[10], P0[11], P0[12], P0[13], pw1[0] = N3_PKW(P0, 8), pw1[1] = N3_PKW(P0, 10), pw1); \
    N3_VRD(5); N3_SBAR(); N3_GAPA(C1 = MFMA32(kf[3], qr[1], C1),   P0[14], P0[15], P1[0], P1[1],   pw1[2] = N3_PKW(P0, 12), pw1[3] = N3_PKW(P0, 14), pw1); \
    N3_VRD(2); N3_SBAR(); N3_GAPA(C0 = MFMA32(kf[4], qr[2], C0),   P1[2], P1[3], P1[4], P1[5],     pw2[0] = N3_PKW(P1, 0), pw2[1] = N3_PKW(P1, 2), pw2); \
    N3_VRD(6); N3_SBAR(); N3_GAPA(C1 = MFMA32(kf[5], qr[2], C1),   P1[6], P1[7], P1[8], P1[9],     pw2[2] = N3_PKW(P1, 4), pw2[3] = N3_PKW(P1, 6), pw2); \
    N3_VRD(3); N3_SBAR(); N3_GAPA(C0 = MFMA32(kf[6], qr[3], C0),   P1[10], P1[11], P1[12], P1[13], pw3[0] = N3_PKW(P1, 8), pw3[1] = N3_PKW(P1, 10), pw3); \
    N3_VRD(7); N3_SBAR(); N3_GAPA(C1 = MFMA32(kf[7], qr[3], C1),   P1[14], P1[15], 0.f, 0.f,       pw3[2] = N3_PKW(P1, 12), pw3[3] = N3_PKW(P1, 14), pw3); \
    l_reg += (MODE == 1 ? (fprev ? sacc : 0.f) : sacc); \
    N3_NEXT(q3); if (GK) { N3_DMA_K(q3, sl_cur); } if (GV) { N3_DMA_V(q1, sl_next); } \
    N3_MASK(C0, C1, q0); q0 = q1; q1 = q2; q2 = q3; \
    { float a = N3_MX3(C0[0], C0[1], C1[0]), b = N3_MX3(C0[2], C0[3], C1[1]); a = N3_MX3(a, C1[2], C1[3]); \
      _Pragma("unroll") for (int r = 4; r < 16; r += 4) { a = N3_MX3(a, C0[r], C0[r + 1]); b = N3_MX3(b, C0[r + 2], C0[r + 3]); a = N3_MX3(a, C1[r], C1[r + 1]); b = N3_MX3(b, C1[r + 2], C1[r + 3]); } \
      float rm = __builtin_fmaxf(a, b); { auto rr = __builtin_amdgcn_permlane32_swap(__float_as_uint(rm), __float_as_uint(rm), false, false); rm = __builtin_fmaxf(__uint_as_float(rr[0]), __uint_as_float(rr[1])); } \
      if (MODE == 1) { rm = fnew ? rm : -INFINITY; fprev = fnew; } \
      resc = false; \
      if (__builtin_expect(__any(rm > (float)THRL), 0)) { const float dl = __builtin_fmaxf(rm, 0.f); mhat += dl; \
        _Pragma("unroll") for (int r = 0; r < 16; ++r) { C0[r] -= dl; C1[r] -= dl; } \
        _Pragma("unroll") for (int r = 0; r < 16; ++r) negm[r] = -mhat; asm volatile("" : "+v"(negm)); \
        const float f = __builtin_amdgcn_exp2f(-dl); l_reg *= f; if (hi == 0) wsf[r32] = f; resc = true; } } \
    N3_SBAR(); \
    N3_GAPB(o[0] = MFMA32(N3_PAF(0), N3_VFR(0), o[0]), C0, 0); \
    N3_GAPB(o[1] = MFMA32(N3_PAF(0), N3_VFR(4), o[1]), C0, 4); \
    N3_KRD(GL, 0); N3_GAPB(o[0] = MFMA32(N3_PAF(1), N3_VFR(1), o[0]), C0, 8); \
    N3_KRD(GL, 1); N3_GAPB(o[1] = MFMA32(N3_PAF(1), N3_VFR(5), o[1]), C0, 12); \
    N3_KRD(GL, 2); N3_GAPB(o[0] = MFMA32(N3_PAF(2), N3_VFR(2), o[0]), C1, 0); \
    N3_KRD(GL, 3); N3_GAPB(o[1] = MFMA32(N3_PAF(2), N3_VFR(6), o[1]), C1, 4); \
    N3_GAPB(o[0] = MFMA32(N3_PAF(3), N3_VFR(3), o[0]), C1, 8); \
    N3_GAPB(o[1] = MFMA32(N3_PAF(3), N3_VFR(7), o[1]), C1, 12); \
    } while (0)
#define N3_ENDW(tt) do { if ((tt) + 3 < NT) { N3_WAIT_BAR(2); } else if ((tt) + 2 < NT) { N3_WAIT_BAR(1); } else { N3_WAIT_BAR(0); } } while (0)
    int t = 1;
    for (; t + 5 < NT; t += 2) {
        N3_STEP(pB0, pB1, pA0, pA1, t, true, true, true);     N3_WAIT_BAR(2); N3_RESC(); N3_ROT();
        N3_STEP(pA0, pA1, pB0, pB1, t + 1, true, true, true); N3_WAIT_BAR(2); N3_RESC(); N3_ROT();
    }
    for (; t + 1 < NT; t += 2) {
        N3_STEP(pB0, pB1, pA0, pA1, t, (t + 3 < NT), (t + 1 < NT), (t + 1 < NT));     N3_ENDW(t);     N3_RESC(); N3_ROT();
        N3_STEP(pA0, pA1, pB0, pB1, t + 1, (t + 4 < NT), (t + 2 < NT), (t + 2 < NT)); N3_ENDW(t + 1); N3_RESC(); N3_ROT();
    }
    N3_STEP(pB0, pB1, pA0, pA1, NT - 1, false, false, false); N3_RESC();
    { float sacc = pB0[0] + pB0[1];
#pragma unroll
      for (int r = 2; r < 16; ++r) sacc += pB0[r];
#pragma unroll
      for (int r = 0; r < 16; ++r) sacc += pB1[r];
      l_reg += (MODE == 1 ? (fprev ? sacc : 0.f) : sacc);
      pw0 = (u32x4){N3_PKW(pB0, 0), N3_PKW(pB0, 2), N3_PKW(pB0, 4), N3_PKW(pB0, 6)}; pw1 = (u32x4){N3_PKW(pB0, 8), N3_PKW(pB0, 10), N3_PKW(pB0, 12), N3_PKW(pB0, 14)};
      pw2 = (u32x4){N3_PKW(pB1, 0), N3_PKW(pB1, 2), N3_PKW(pB1, 4), N3_PKW(pB1, 6)}; pw3 = (u32x4){N3_PKW(pB1, 8), N3_PKW(pB1, 10), N3_PKW(pB1, 12), N3_PKW(pB1, 14)};
      N3_SBAR();
      const lds_cptr vp_ = vp0 + sl_cur;
#pragma unroll
      for (int i = 0; i < 8; ++i) N3_VRD(i);
      asm volatile("s_waitcnt lgkmcnt(0)" ::: "memory"); N3_SBAR();
      o[0] = MFMA32(N3_PAF(0), N3_VFR(0), o[0]); o[0] = MFMA32(N3_PAF(1), N3_VFR(1), o[0]); o[0] = MFMA32(N3_PAF(2), N3_VFR(2), o[0]); o[0] = MFMA32(N3_PAF(3), N3_VFR(3), o[0]);
      o[1] = MFMA32(N3_PAF(0), N3_VFR(4), o[1]); o[1] = MFMA32(N3_PAF(1), N3_VFR(5), o[1]); o[1] = MFMA32(N3_PAF(2), N3_VFR(6), o[1]); o[1] = MFMA32(N3_PAF(3), N3_VFR(7), o[1]); }
    { auto rr = __builtin_amdgcn_permlane32_swap(__float_as_uint(l_reg), __float_as_uint(l_reg), false, false); l_reg = __uint_as_float(rr[0]) + __uint_as_float(rr[1]); }
    if (hi == 0) wsf[32 + r32] = gate / l_reg;
    asm volatile("s_waitcnt lgkmcnt(0)" ::: "memory");
#pragma unroll
    for (int r = 0; r < 16; ++r) { const int row = crow(r, hi); const float f = wsf[32 + row];
#pragma unroll
        for (int d0 = 0; d0 < 2; ++d0) { LAS float* a = acc + row * ACCP + d0 * 32 + r32; *a = *a + o[d0][r] * f; } }
    asm volatile("s_waitcnt lgkmcnt(0)\n\ts_barrier" ::: "memory");
#undef N3_NEXT
#undef N3_DMA_K
#undef N3_DMA_V
#undef N3_MASK
#undef N3_RESC
#undef N3_ROT
#undef N3_PKW
#undef N3_PAF
#undef N3_VFR
#undef N3_PIN
#undef N3_MX3
#undef N3_GAPA
#undef N3_EX
#undef N3_GAPB
#undef N3_VRD
#undef N3_KRD
#undef N3_STEP
#undef N3_ENDW
}
}

__device__ __forceinline__ void phase_nsa3(const Params& p, LAS unsigned char* lds, bf16* CATo, const unsigned long long* sel_in, unsigned long long* sel_out) {
    unsigned char* ws = p.ws;
    const bf16* Q = (const bf16*)(ws + WS_Q); const bf16* KV = (const bf16*)(ws + WS_KV); const float* GT = (const float*)(ws + WS_GATES);
    const bf16* KC = (const bf16*)(ws + WS_KC); const bf16* VCT = (const bf16*)(ws + WS_VCT);
    const size_t kvs = (size_t)4 * 2 * 4096 * 64;
    LAS float* imp = (LAS float*)(lds + n3::L_ACC);
    LAS unsigned long long* sel = (LAS unsigned long long*)(lds + n3::L_SEL);
    for (int u = blockIdx.x; u < 256; u += gridDim.x) {
        const int bg = u & 7, pair = u >> 3, b = bg >> 1, g = bg & 1;
        for (int half = 0; half < NSA_HALVES; ++half) {
            const int tid = tid_fresh(), lane = tid & 63, wave = __builtin_amdgcn_readfirstlane(tid >> 6);
            const int hg = wave & 3, th = wave >> 2, q = lane & 31, h = lane >> 5;
            int koff[4], voff[4];
            { const int pr = (q & ~12) | ((q & 4) << 1) | ((q & 8) >> 1); const int hxk = h ^ (pr & 7), hxv = h ^ (q & 7);
#pragma unroll
              for (int s = 0; s < 4; ++s) { koff[s] = pr * 128 + (((2 * s) ^ hxk) << 4); voff[s] = q * 128 + (((2 * s) ^ hxv) << 4); } }
            const int qt = (half & 1) ? pair : 63 - pair, t0 = qt * 64, tl = 32 * th + q, t = t0 + tl, tok = b * 4096 + t;
            bf16x8 Qf[4];
#pragma unroll
            for (int ks = 0; ks < 4; ++ks) Qf[ks] = *(const bf16x8*)(Q + (size_t)tok * 512 + g * 256 + hg * 64 + 16 * ks + 8 * h);
            const float g0 = GT[(size_t)tok * 24 + g * 12 + hg * 3 + 0], g1 = GT[(size_t)tok * 24 + g * 12 + hg * 3 + 1], g2 = GT[(size_t)tok * 24 + g * 12 + hg * 3 + 2];
            if (tid == 0) sel[64] = 0ull;
            f32x16 O[2], S0, S1; u32x4 kr, vr;
            const int nvis = t >= 31 ? (t - 31) / 16 + 1 : 0, ntc = (4 * qt + 3 + 63) >> 6;
            const bf16* kcb = KC + (size_t)bg * 256 * 64; const bf16* vcb = VCT + (size_t)bg * 64 * 256;
            float mc = -1e30f, lc = 0.f;
            nsa_load(kcb, vcb, 256, tid, kr, vr); nsa_store(lds, 0, tid, kr, vr); __syncthreads();
            for (int ct = 0; ct < ntc; ++ct) { const int buf = ct & 1;
                if (ct + 1 < ntc) nsa_load(kcb + (size_t)(ct + 1) * 64 * 64, vcb + (ct + 1) * 64, 256, tid, kr, vr);
                else nsa_load(kcb, vcb, 256, tid, kr, vr);
                nsa_qk(lds + NSA_KB + buf * 8192, Qf, koff, S0, S1); nsa_mask(S0, S1, -1000, nvis - 64 * ct - 1 - 8 * h);
                nsa_online<false>(S0, S1, mc, lc, O);
                nsa_store(lds, buf ^ 1, tid, kr, vr);
                __syncthreads(); }
            { const float lt = lc + __shfl_xor(lc, 32), il = lt > 0.f ? 1.f / lt : 0.f, mb = mc <= -1e29f ? 0.f : mc;
#pragma unroll
              for (int r = 0; r < 16; ++r) { O[0][r] = 0.f; O[1][r] = 0.f; }
              float carry_prev = 0.f;
              for (int ct = 0; ct < ntc; ++ct) { const int buf = (ntc + ct) & 1;
                if (ct + 1 < ntc) nsa_load(kcb + (size_t)(ct + 1) * 64 * 64, vcb + (ct + 1) * 64, 256, tid, kr, vr);
                nsa_qk(lds + NSA_KB + buf * 8192, Qf, koff, S0, S1); nsa_mask(S0, S1, -1000, nvis - 64 * ct - 1 - 8 * h);
#pragma unroll
                for (int r = 0; r < 16; ++r) { S0[r] = __builtin_amdgcn_exp2f(S0[r] - mb) * il; S1[r] = __builtin_amdgcn_exp2f(S1[r] - mb) * il; }
                LAS float* row = imp + (hg * 64 + tl) * NSA_IST + 16 * ct + 2 * h;
#pragma unroll
                for (int sx = 0; sx < 4; ++sx) { const int x8 = 8 * (sx & 1);
                    float p0, p1, p2, p3, p4, p5, p6, p7;
                    if (sx < 2) { p0 = S0[x8]; p1 = S0[x8 + 1]; p2 = S0[x8 + 2]; p3 = S0[x8 + 3]; p4 = S0[x8 + 4]; p5 = S0[x8 + 5]; p6 = S0[x8 + 6]; p7 = S0[x8 + 7]; }
                    else        { p0 = S1[x8]; p1 = S1[x8 + 1]; p2 = S1[x8 + 2]; p3 = S1[x8 + 3]; p4 = S1[x8 + 4]; p5 = S1[x8 + 5]; p6 = S1[x8 + 6]; p7 = S1[x8 + 7]; }
                    const float recv = __shfl_xor(p7, 32), cin = h ? recv : carry_prev; carry_prev = recv;
                    const float a0 = (((cin + p0) + p1) + p2) + p3, a1 = (((p3 + p4) + p5) + p6) + p7;
                    *(LAS f32x2*)(row + 4 * sx) = (f32x2){a0, a1}; }
                nsa_pv(lds + NSA_VB + buf * 8192, S0, S1, voff, O);
                if (ct + 1 < ntc) nsa_store(lds, buf ^ 1, tid, kr, vr);
                __syncthreads(); } }
            n3::prefetch0(lds, KV + 2 * kvs + (size_t)bg * 4096 * 64, KV + 3 * kvs + (size_t)bg * 4096 * 64);
            { unsigned long long orm = 0ull;
              for (int i = 0; i < 8; ++i) { const int tk = wave * 8 + i; unsigned long long msk;
                if (sel_in) msk = sel_in[(size_t)(b * 4096 + t0 + tk) * 2 + g];
                else { const LAS float* sl = imp + tk * NSA_IST + lane;
                    const float im = ((sl[0] + sl[64 * NSA_IST]) + sl[2 * 64 * NSA_IST]) + sl[3 * 64 * NSA_IST];
                    const bool valid = lane <= qt, forced = (lane == 0) || (lane == qt) || (lane == qt - 1);
                    const float score = valid ? im + (forced ? 1e6f : 0.f) : -1e9f;
                    const unsigned key = valid ? __float_as_uint(score) + 1u : 0u; unsigned pre = 0u;
#pragma unroll
                    for (int bit = 30; bit >= 0; --bit) { const unsigned cand = pre | (1u << bit); if (__builtin_popcountll(__ballot(key >= cand)) >= 16) pre = cand; }
                    const unsigned long long gt = __ballot(key > pre), eq = __ballot(key == pre); const int need = 16 - __builtin_popcountll(gt);
                    const int below = __builtin_amdgcn_mbcnt_hi((unsigned)(eq >> 32), __builtin_amdgcn_mbcnt_lo((unsigned)eq, 0u));
                    msk = __ballot(key > pre || (key == pre && below < need)); }
                if (lane == 0) { sel[tk] = msk; if (sel_out) sel_out[(size_t)(b * 4096 + t0 + tk) * 2 + g] = msk; }
                orm |= msk; }
              if (lane == 0) __hip_atomic_fetch_or(sel + 64, orm, __ATOMIC_RELAXED, __HIP_MEMORY_SCOPE_WORKGROUP); }
            __syncthreads();
            const unsigned long long mysel = sel[tl];
            unsigned long long oms, omw;
            { const unsigned long long o_ = sel[64] & (qt == 63 ? ~0ull : ((2ull << qt) - 1ull));
              oms = ((unsigned long long)(unsigned)__builtin_amdgcn_readfirstlane((int)(o_ >> 32)) << 32) | (unsigned)__builtin_amdgcn_readfirstlane((int)o_);
              const int jlo = qt > 8 ? qt - 8 : 0; omw = (qt == 63 ? ~0ull : ((2ull << qt) - 1ull)) & ~((1ull << jlo) - 1ull); }
            __syncthreads();
            { LAS float* acc = (LAS float*)(lds + n3::L_ACC) + wave * 32 * n3::ACCP + q * n3::ACCP + 4 * h;
#pragma unroll
              for (int mt = 0; mt < 2; ++mt)
#pragma unroll
                for (int r = 0; r < 16; ++r) acc[32 * mt + (r & 3) + 8 * (r >> 2)] = g0 * O[mt][r]; }
            const int NTs = (__builtin_popcountll(oms) + 1) & ~1, NTw = qt == 0 ? 2 : ((__builtin_popcountll(omw) + 1) & ~1);
            const bf16* Qw = Q + (size_t)(b * 4096 + t0 + 32 * th) * 512 + g * 256 + hg * 64;
#if N3_PROBE & 1
            n3::stream<1>(lds, Qw, KV + 2 * kvs + (size_t)bg * 4096 * 64, KV + 3 * kvs + (size_t)bg * 4096 * 64, oms, NTs, qt, tl, mysel, 0.f);
#endif
            n3::stream<1, (N3_PROBE & 1) == 0>(lds, Qw, KV + 2 * kvs + (size_t)bg * 4096 * 64, KV + 3 * kvs + (size_t)bg * 4096 * 64, oms, NTs, qt, tl, mysel, g1);
#if N3_PROBE & 2
            n3::stream<2>(lds, Qw, KV + 4 * kvs + (size_t)bg * 4096 * 64, KV + 5 * kvs + (size_t)bg * 4096 * 64, omw, NTw, qt, tl, mysel, 0.f);
#endif
            n3::stream<2>(lds, Qw, KV + 4 * kvs + (size_t)bg * 4096 * 64, KV + 5 * kvs + (size_t)bg * 4096 * 64, omw, NTw, qt, tl, mysel, g2);
            { const LAS float* accw = (const LAS float*)(lds + n3::L_ACC) + wave * 32 * n3::ACCP;
#pragma unroll
              for (int i = 0; i < 4; ++i) { const int row = i * 8 + (lane >> 3), ch = lane & 7; const LAS float* a = accw + row * n3::ACCP + ch * 8;
                  u32x4 w; w.x = pk2(a[0], a[1]); w.y = pk2(a[2], a[3]); w.z = pk2(a[4], a[5]); w.w = pk2(a[6], a[7]);
                  *(u32x4*)(CATo + (size_t)(b * 4096 + t0 + 32 * th + row) * 1024 + g * 256 + hg * 64 + ch * 8) = w; } }
            __syncthreads();
        }
    }
}
#if NSA_MODE >= 2
__device__ __forceinline__ void phase_probe_cmp(const Params& p) {
    const int gt = blockIdx.x * 512 + threadIdx.x, NGT = gridDim.x * 512; float num = 0.f, den = 0.f;
#if NSA_MODE == 2
    const bf16* A = (const bf16*)(p.ws + WS_CAT); const bf16* B = (const bf16*)(p.ws + WS_M);
    for (int i = gt; i < NT * 512; i += NGT) { const size_t o = (size_t)(i >> 9) * 1024 + (i & 511); const float a = bf2f(A[o]), b = bf2f(B[o]); num += (a - b) * (a - b); den += a * a; }
#else
    const unsigned long long* A = (const unsigned long long*)(p.ws + WS_PROBE + 4096); const unsigned long long* B = A + NT * 2;
    for (int i = gt; i < NT * 2; i += NGT) { num += (A[i] != B[i]) ? 1.f : 0.f; den += 1.f; }
#endif
    num = wave_sum(num); den = wave_sum(den);
    __shared__ float red[16];
    if ((threadIdx.x & 63) == 0) { red[(threadIdx.x >> 6) * 2] = num; red[(threadIdx.x >> 6) * 2 + 1] = den; }
    __syncthreads();
    if (threadIdx.x == 0) { float a = 0.f, b = 0.f; for (int i = 0; i < 8; ++i) { a += red[2 * i]; b += red[2 * i + 1]; } float* slot = (float*)(p.ws + WS_PACC) + 2 * blockIdx.x; slot[0] = a; slot[1] = b; }
}
#endif


struct EpiRmsRes {
    static constexpr bool AFTER_DRAIN = true;
    const float* base; float* hout; bf16* U; const float* gpost; const float* gpre; float* slots; unsigned* cnts; int ex;
    __device__ __forceinline__ void operator()(const f32x4 (&)[2][2][4][2], const g8::Unit&, int, int, int, int) const {}
    __device__ __forceinline__ float row_scale(const f32x4 (&v)[2][2][4][2], const g8::Unit& u, int wr, int wc, int fr, int fq, LAS unsigned char* lds, int bank, int ai, int m) const { return 0.f; }
    __device__ __forceinline__ void exchange(const f32x4 (&v)[2][2][4][2], const g8::Unit& u, int wr, int wc, int fr, int fq, LAS unsigned char* lds, int bank) const {
        LAS float* P = (LAS float*)lds; LAS float* S = (LAS float*)(lds + 4096);
        const int tid = tid_fresh();
#pragma unroll
        for (int ai = 0; ai < 2; ++ai)
#pragma unroll
            for (int m = 0; m < 4; ++m) { float s = 0.f;
#pragma unroll
                for (int bj = 0; bj < 2; ++bj)
#pragma unroll
                    for (int n = 0; n < 2; ++n) { const f32x4 x = v[ai][bj][m][n]; s += (x[0] * x[0] + x[1] * x[1]) + (x[2] * x[2] + x[3] * x[3]); }
                s += __shfl_xor(s, 16); s += __shfl_xor(s, 32);
                if (fq == 0) P[(ai * 128 + wr * 64 + m * 16 + fr) * 4 + wc] = s; }
        __syncthreads();
        float* slot = slots + ((size_t)(bank * 64 + u.pm) * 256) * 4; unsigned* cnt = cnts + (size_t)(bank * 64 + u.pm) * 64;
        if (tid < 256) { const float t = (P[tid * 4 + 0] + P[tid * 4 + 1]) + (P[tid * 4 + 2] + P[tid * 4 + 3]);
            __hip_atomic_store(slot + tid * 4 + u.pn, t, __ATOMIC_RELAXED, __HIP_MEMORY_SCOPE_AGENT);
            asm volatile("s_waitcnt vmcnt(0)" ::: "memory");
            if ((tid & 63) == 0) __hip_atomic_fetch_add(cnt, 1u, __ATOMIC_RELAXED, __HIP_MEMORY_SCOPE_AGENT); }
        if (tid < 64) { unsigned sp = 0;
            while ((unsigned)__builtin_amdgcn_readfirstlane(__hip_atomic_load(cnt, __ATOMIC_RELAXED, __HIP_MEMORY_SCOPE_AGENT)) < 16u) { __builtin_amdgcn_s_sleep(1); if (++sp > (1u << 22)) break; }
            __builtin_amdgcn_fence(__ATOMIC_ACQUIRE, "agent");
            asm volatile("s_waitcnt vmcnt(0)" ::: "memory"); }
        __syncthreads();
        if (tid < 256) { const float a = __hip_atomic_load(slot + tid * 4 + 0, __ATOMIC_RELAXED, __HIP_MEMORY_SCOPE_AGENT), b = __hip_atomic_load(slot + tid * 4 + 1, __ATOMIC_RELAXED, __HIP_MEMORY_SCOPE_AGENT),
                        c = __hip_atomic_load(slot + tid * 4 + 2, __ATOMIC_RELAXED, __HIP_MEMORY_SCOPE_AGENT), d = __hip_atomic_load(slot + tid * 4 + 3, __ATOMIC_RELAXED, __HIP_MEMORY_SCOPE_AGENT);
            S[tid] = rsqrtf(((a + b) + (c + d)) * (1.f / 1024.f) + EPS); }
        __syncthreads();
    }
    __device__ __forceinline__ void fused(f32x4 (&acc)[2][2][4][2], const g8::Unit& u, int wr, int wc, int fr, int fq, LAS unsigned char* lds) const {
        const LAS float* S = (const LAS float*)(lds + 4096);
        const int col0 = u.pn * 256 + wc * 32 + 4 * fq;
        exchange(acc, u, wr, wc, fr, fq, lds, ex);
#pragma unroll
        for (int ai = 0; ai < 2; ++ai)
#pragma unroll
            for (int m = 0; m < 4; ++m) { const int rl = ai * 128 + wr * 64 + m * 16 + fr; const float r = S[rl]; const size_t off = (size_t)(u.pm * 256 + rl) * 1024 + col0;
#pragma unroll
                for (int bj = 0; bj < 2; ++bj)
#pragma unroll
                    for (int n = 0; n < 2; ++n) { const f32x4 g = *(const f32x4*)(gpost + col0 + bj * 128 + n * 16), bs = *(const f32x4*)(base + off + bj * 128 + n * 16);
                        const f32x4 h = bs + acc[ai][bj][m][n] * r * g; acc[ai][bj][m][n] = h; *(f32x4*)(hout + off + bj * 128 + n * 16) = h; }
                asm volatile("" ::: "memory"); }
        exchange(acc, u, wr, wc, fr, fq, lds, ex + 1);
#pragma unroll
        for (int ai = 0; ai < 2; ++ai)
#pragma unroll
            for (int m = 0; m < 4; ++m) { const int rl = ai * 128 + wr * 64 + m * 16 + fr; const float r = S[rl]; const size_t off = (size_t)(u.pm * 256 + rl) * 1024 + col0;
#pragma unroll
                for (int bj = 0; bj < 2; ++bj)
#pragma unroll
                    for (int n = 0; n < 2; ++n) { const f32x4 g = *(const f32x4*)(gpre + col0 + bj * 128 + n * 16); const f32x4 o = acc[ai][bj][m][n] * r * g;
                        u32x2 w; w.x = pk2(o[0], o[1]); w.y = pk2(o[2], o[3]); *(u32x2*)(U + off + bj * 128 + n * 16) = w; }
                asm volatile("" ::: "memory"); }
    }
};

template <bool BF>
struct EpiRmsRes2 {
    static constexpr bool AFTER_DRAIN = true;
    const void* base; bf16* H; float* rs; const float* gpost; float* slots; unsigned* cnts; int ex;
    __device__ __forceinline__ void operator()(const f32x4 (&)[2][2][4][2], const g8::Unit&, int, int, int, int) const {}
    __device__ __forceinline__ void fused(f32x4 (&acc)[2][2][4][2], const g8::Unit& u, int wr, int wc, int fr, int fq, LAS unsigned char* lds) const {
        const LAS float* S = (const LAS float*)(lds + 4096);
        const EpiRmsRes X{nullptr, nullptr, nullptr, nullptr, nullptr, slots, cnts, ex};
        const int col0 = u.pn * 256 + wc * 64 + 8 * fq;
        X.exchange(acc, u, wr, wc, fr, fq, lds, ex);
#pragma unroll
        for (int ai = 0; ai < 2; ++ai)
#pragma unroll
            for (int m = 0; m < 4; ++m) { const int rl = ai * 128 + wr * 64 + m * 16 + fr; const float r = S[rl]; const size_t off = (size_t)(u.pm * 256 + rl) * 1024 + col0;
#pragma unroll
                for (int bj = 0; bj < 2; ++bj) { const f32x4 g0 = *(const f32x4*)(gpost + col0 + bj * 32), g1 = *(const f32x4*)(gpost + col0 + bj * 32 + 4); f32x4 b0, b1;
                    if (BF) { const u32x4 w = *(const u32x4*)((const bf16*)base + off + bj * 32); b0 = (f32x4){bflo(w.x), bfhi(w.x), bflo(w.y), bfhi(w.y)}; b1 = (f32x4){bflo(w.z), bfhi(w.z), bflo(w.w), bfhi(w.w)}; }
                    else { b0 = *(const f32x4*)((const float*)base + off + bj * 32); b1 = *(const f32x4*)((const float*)base + off + bj * 32 + 4); }
                    const f32x4 h0 = b0 + acc[ai][bj][m][0] * r * g0, h1 = b1 + acc[ai][bj][m][1] * r * g1; acc[ai][bj][m][0] = h0; acc[ai][bj][m][1] = h1;
                    u32x4 o; o.x = pk2(h0[0], h0[1]); o.y = pk2(h0[2], h0[3]); o.z = pk2(h1[0], h1[1]); o.w = pk2(h1[2], h1[3]); *(u32x4*)(H + off + bj * 32) = o; }
                asm volatile("" ::: "memory"); }
        X.exchange(acc, u, wr, wc, fr, fq, lds, ex + 1);
        if (u.pn == 0) { const int tid = tid_fresh(); if (tid < 256) rs[u.pm * 256 + tid] = S[tid]; }
    }
};

template <bool BF>
__device__ __forceinline__ void phase_norm(const Params& p, const void* base, const float* gpost, const float* gpre, unsigned char* u8, float* rs = nullptr) {
    const int tid_ = tid_fresh(), lane = tid_ & 63, wave = tid_ >> 6; const int gw = blockIdx.x * 8 + wave, NGW = gridDim.x * 8;
    const bf16* M = (const bf16*)(p.ws + WS_M); bf16* U = (bf16*)(p.ws + WS_U); bf16* H = (bf16*)(p.ws + WS_H);
    constexpr int ES = BF ? 2 : 4;
    for (int m = gw; m < NT; m += 2 * NGW) { f32x4 h[4], h2[4]; const int m2 = m + NGW;
        row_norm2<BF>((const char*)base + (size_t)m * D * ES, M + (size_t)m * D, H + (size_t)m * D, U + (size_t)m * D, (const char*)base + (size_t)m2 * D * ES, M + (size_t)m2 * D, H + (size_t)m2 * D, U + (size_t)m2 * D, gpost, gpre, lane, h, h2, rs ? rs + m : nullptr, rs ? rs + m2 : nullptr);
        if (u8) {
#pragma unroll
            for (int j = 0; j < 4; ++j) { *(unsigned*)(u8 + (size_t)m * D + 4 * lane + 256 * j) = pk4f8(h[j][0], h[j][1], h[j][2], h[j][3]); *(unsigned*)(u8 + (size_t)m2 * D + 4 * lane + 256 * j) = pk4f8(h2[j][0], h2[j][1], h2[j][2], h2[j][3]); } } }
}

struct EpiGmlpIn {
    static constexpr bool AFTER_DRAIN = false;
    bf16* Z; f32x2* ST; const float* rs;
    __device__ __forceinline__ void operator()(const f32x4 (&acc)[2][2][4][2], const g8::Unit& u, int wr, int wc, int fr, int fq, const LAS float* rsl) const {
        const int row0 = u.pm * 256 + wr * 64 + fr, col0 = u.pn * 256 + wc * 64 + 8 * fq;
#pragma unroll
        for (int ai = 0; ai < 2; ++ai)
#pragma unroll
            for (int m = 0; m < 4; ++m) { const int row = row0 + ai * 128 + m * 16; bf16* rowp = Z + (size_t)row * 2048 + col0; float s = 0.f, q = 0.f; const float rr = rsl[row - u.pm * 256];
#pragma unroll
                for (int bj = 0; bj < 2; ++bj) { u32x4 w;
#pragma unroll
                    for (int n = 0; n < 2; ++n) { const f32x4 v = acc[ai][bj][m][n]; const f32x2 y0 = gelu_tanh2((f32x2){v[0], v[1]} * rr), y1 = gelu_tanh2((f32x2){v[2], v[3]} * rr), q2 = y0 * y0 + y1 * y1, s2 = y0 + y1;
                        const float a = y0[0], b = y0[1], c = y1[0], d = y1[1];
                        s += s2[0] + s2[1]; q += q2[0] + q2[1];
                        if (n == 0) { w.x = pk2(a, b); w.y = pk2(c, d); } else { w.z = pk2(a, b); w.w = pk2(c, d); } }
                    *(u32x4*)(rowp + bj * 32) = w; }
                if (u.pn >= 4) { s += __shfl_xor(s, 16); s += __shfl_xor(s, 32); q += __shfl_xor(q, 16); q += __shfl_xor(q, 32);
                    if (fq == 0) ST[(size_t)row * 16 + (u.pn - 4) * 4 + wc] = (f32x2){s, q}; } }
    }
};
__device__ __forceinline__ void phase_gmlp_sgu(const Params& p, LAS unsigned char* lds) {
    const int tid = tid_fresh(); unsigned char* ws = p.ws;
    LAS float* zt = (LAS float*)lds;
    LAS float* mu = zt + 128 * 128; LAS float* rs = mu + 128;
    const bf16* Z = (const bf16*)(ws + WS_Z); const f32x2* ST = (const f32x2*)(ws + WS_STATS); const bf16* WSB = (const bf16*)(ws + WS_WSB); bf16* O = (bf16*)(ws + WS_CAT);
    const float* lng = p.in[I_GLNG]; const float* lnb = p.in[I_GLNB]; const float* bs = p.in[I_GBS];
    for (int unit = blockIdx.x; unit < 4 * 32 * 8; unit += gridDim.x) {
        const int g = unit & 7, bc = unit >> 3, row0 = bc * 128;
        __syncthreads();
        if (tid < 128) { float s = 0.f, q = 0.f; const f32x2* st = ST + (size_t)(row0 + tid) * 16;
            for (int i = 0; i < 16; ++i) { s += st[i].x; q += st[i].y; }
            const float m = s * (1.f / 1024.f); mu[tid] = m; rs[tid] = rsqrtf(fmaxf(q * (1.f / 1024.f) - m * m, 0.f) + EPS); }
        __syncthreads();
        for (int i = tid; i < 128 * 16; i += 512) { const int s = i >> 4, c8 = (i & 15) * 8; const u32x4 v = *(const u32x4*)(Z + (size_t)(row0 + s) * 2048 + 1024 + g * 128 + c8);
            const float m = mu[s], r = rs[s]; const float* gg = lng + g * 128 + c8; const float* bb = lnb + g * 128 + c8; LAS float* d = zt + s * 128 + c8;
            d[0] = (bflo(v.x) - m) * r * gg[0] + bb[0]; d[1] = (bfhi(v.x) - m) * r * gg[1] + bb[1]; d[2] = (bflo(v.y) - m) * r * gg[2] + bb[2]; d[3] = (bfhi(v.y) - m) * r * gg[3] + bb[3];
            d[4] = (bflo(v.z) - m) * r * gg[4] + bb[4]; d[5] = (bfhi(v.z) - m) * r * gg[5] + bb[5]; d[6] = (bflo(v.w) - m) * r * gg[6] + bb[6]; d[7] = (bfhi(v.w) - m) * r * gg[7] + bb[7]; }
        __syncthreads();
        const int d = tid & 127;
        for (int i = 0; i < 32; ++i) { const int t = (tid >> 7) + 4 * i; const bf16* wr = WSB + ((size_t)g * 128 + t) * 128; float a = bs[g * 128 + t];
            for (int s = 0; s <= t; ++s) a += bf2f(wr[s]) * zt[s * 128 + d];
            const size_t row = (size_t)(row0 + t); const float z1 = bf2f(Z[row * 2048 + g * 128 + d]);
            O[row * 1024 + g * 128 + d] = (bf16)f2bf(z1 * a); }
    }
}


__device__ __forceinline__ void phase_gmlp_sgu_fast(const Params& p, LAS unsigned char* lds) {
    const int tid = tid_fresh(), lane = tid & 63, wave = __builtin_amdgcn_readfirstlane(tid >> 6); unsigned char* ws = p.ws;
    LAS unsigned char* zt = lds;
    LAS float* mu = (LAS float*)(lds + 32768); LAS float* rs = mu + 128;
    LAS float* mx = (LAS float*)(lds + 40960);
    const bf16* Z = (const bf16*)(ws + WS_Z); const f32x2* ST = (const f32x2*)(ws + WS_STATS); const bf16* WSB = (const bf16*)(ws + WS_WSB); bf16* O = (bf16*)(ws + WS_CAT);
    const float* bs = p.in[I_GBS];
    const int q = lane & 31, h = lane >> 5, tt = wave & 3, dp = wave >> 2;
    const int c8 = (tid & 15) * 8;
    const int NU = 4 * 32 * 8;
#define SGU_MAP(unit_, g_, row0_) do { const int ui_ = gridDim.x == 256 ? (int)(blockIdx.x >> 3) + 32 * ((unit_) >> 8) : (unit_); g_ = ui_ & 7; \
        row0_ = (gridDim.x == 256 ? 16 * (int)(blockIdx.x & 7) + (ui_ >> 3) : (unit_) >> 3) * 128; } while (0)
    u32x4 z2n[4], z1n[4]; f32x4 stn[2];
#define SGU_LOAD(unit_) do { int g_, r0_; SGU_MAP(unit_, g_, r0_); \
        { const f32x4* sp_ = (const f32x4*)(ST + (size_t)(r0_ + (tid >> 2)) * 16 + (tid & 3) * 4); stn[0] = sp_[0]; stn[1] = sp_[1]; } \
        _Pragma("unroll") for (int it = 0; it < 4; ++it) { const size_t row_ = (size_t)(r0_ + (tid >> 4) + 32 * it); \
            z2n[it] = *(const u32x4*)(Z + row_ * 2048 + 1024 + g_ * 128 + c8); z1n[it] = *(const u32x4*)(Z + row_ * 2048 + g_ * 128 + c8); } } while (0)
    int unit = blockIdx.x; if (unit >= NU) return;
    SGU_LOAD(unit);
    int gprev = -1; bf16x8 Wf[8]; f32x4 ga, gb, ba, bb;
    for (; unit < NU; unit += gridDim.x) {
        int g, row0; SGU_MAP(unit, g, row0);
        u32x4 z2c[4], z1c[4]; const f32x4 st0 = stn[0], st1 = stn[1];
#pragma unroll
        for (int it = 0; it < 4; ++it) { z2c[it] = z2n[it]; z1c[it] = z1n[it]; }
        if (unit + (int)gridDim.x < NU) SGU_LOAD(unit + (int)gridDim.x);
        if (g != gprev) { gprev = g;
            ga = *(const f32x4*)(p.in[I_GLNG] + g * 128 + c8); gb = *(const f32x4*)(p.in[I_GLNG] + g * 128 + c8 + 4);
            ba = *(const f32x4*)(p.in[I_GLNB] + g * 128 + c8); bb = *(const f32x4*)(p.in[I_GLNB] + g * 128 + c8 + 4);
#pragma unroll
            for (int ks = 0; ks < 8; ++ks) Wf[ks] = *(const bf16x8*)(WSB + ((size_t)g * 128 + 32 * tt + q) * 128 + 16 * ks + 8 * h); }
        __syncthreads();
        { float s = (st0[0] + st0[2]) + (st1[0] + st1[2]), qq = (st0[1] + st0[3]) + (st1[1] + st1[3]);
          s += __shfl_xor(s, 1); qq += __shfl_xor(qq, 1); s += __shfl_xor(s, 2); qq += __shfl_xor(qq, 2);
          if ((tid & 3) == 0) { const float m = s * (1.f / 1024.f); mu[tid >> 2] = m; rs[tid >> 2] = rsqrtf(fmaxf(qq * (1.f / 1024.f) - m * m, 0.f) + EPS); } }
        __syncthreads();
#pragma unroll
        for (int it = 0; it < 4; ++it) { const int s = (tid >> 4) + 32 * it; const u32x4 v = z2c[it];
            const float m = mu[s], r = rs[s];
            float y[8]; y[0] = (bflo(v.x) - m) * r * ga[0] + ba[0]; y[1] = (bfhi(v.x) - m) * r * ga[1] + ba[1]; y[2] = (bflo(v.y) - m) * r * ga[2] + ba[2]; y[3] = (bfhi(v.y) - m) * r * ga[3] + ba[3];
            y[4] = (bflo(v.z) - m) * r * gb[0] + bb[0]; y[5] = (bfhi(v.z) - m) * r * gb[1] + bb[1]; y[6] = (bflo(v.w) - m) * r * gb[2] + bb[2]; y[7] = (bfhi(v.w) - m) * r * gb[3] + bb[3];
#pragma unroll
            for (int e = 0; e < 8; ++e) { const int d = c8 + e; *(LAS bf16*)(zt + d * 256 + ((((s >> 3) ^ (d ^ (d >> 3))) & 15) << 4) + (s & 7) * 2) = (bf16)f2bf(y[e]); } }
        __syncthreads();
#pragma unroll
        for (int di = 0; di < 2; ++di) { const int d = 64 * dp + 32 * di + q; f32x16 acc;
#pragma unroll
            for (int r = 0; r < 16; ++r) acc[r] = 0.f;
            const LAS unsigned char* zr = zt + d * 256; const int sw = (d ^ (d >> 3)) & 15;
#pragma unroll
            for (int ks = 0; ks < 8; ++ks) if (ks <= 2 * tt + 1) { const bf16x8 Zf = *(const LAS bf16x8*)(zr + (((2 * ks + h) ^ sw) << 4)); acc = MFMA32(Wf[ks], Zf, acc); }
#pragma unroll
            for (int r = 0; r < 16; ++r) { const int t = 32 * tt + (r & 3) + 8 * (r >> 2) + 4 * h; mx[t * 128 + d] = acc[r] + bs[g * 128 + t]; } }
        __syncthreads();
#pragma unroll
        for (int it = 0; it < 4; ++it) { const int t = (tid >> 4) + 32 * it; const size_t row = (size_t)(row0 + t);
            const u32x4 zv = z1c[it]; const f32x4 m0 = *(const LAS f32x4*)(mx + t * 128 + c8), m1 = *(const LAS f32x4*)(mx + t * 128 + c8 + 4);
            u32x4 o; o.x = pk2(bflo(zv.x) * m0[0], bfhi(zv.x) * m0[1]); o.y = pk2(bflo(zv.y) * m0[2], bfhi(zv.y) * m0[3]); o.z = pk2(bflo(zv.z) * m1[0], bfhi(zv.z) * m1[1]); o.w = pk2(bflo(zv.w) * m1[2], bfhi(zv.w) * m1[3]);
            *(u32x4*)(O + row * 1024 + g * 128 + c8) = o; }
    }
#undef SGU_LOAD
#undef SGU_MAP
}

__device__ __forceinline__ void moe_tables(const Params& p, LAS unsigned char* lds) {
    LAS int* tb = (LAS int*)(lds + LDS_MISC);
    __syncthreads();
    if (threadIdx.x == 0) { const unsigned* cnt = (const unsigned*)(p.ws + WS_CNT); int acc = 0;
        for (int e = 0; e < 8; ++e) { const int c = (int)__hip_atomic_load(cnt + e, __ATOMIC_RELAXED, __HIP_MEMORY_SCOPE_AGENT); tb[e] = c; tb[8 + e] = acc; acc += (c + 255) >> 8; }
        tb[16] = acc; }
    __syncthreads();
}
template <bool GATHER_>
struct MoeSched {
    static constexpr bool GATHER = GATHER_;
    const char* A; const char* Wt; const int* list; LAS int* tb; int apitch_, bpitch, nN, G, c; size_t wstride;
    int nM; unsigned long long tp8;
    __device__ __forceinline__ void init() { nM = __builtin_amdgcn_readfirstlane(tb[16]); unsigned lo = 0u, hi = 0u;
#pragma unroll
        for (int x = 1; x < 4; ++x) lo |= ((unsigned)__builtin_amdgcn_readfirstlane(tb[8 + x]) & 0xffu) << (8 * x);
#pragma unroll
        for (int x = 4; x < 8; ++x) hi |= ((unsigned)__builtin_amdgcn_readfirstlane(tb[8 + x]) & 0xffu) << (8 * (x - 4));
        tp8 = ((unsigned long long)hi << 32) | lo; }
    __device__ __forceinline__ int apitch() const { return apitch_; }
    __device__ __forceinline__ const void* abase() const { return A; }
    __device__ __forceinline__ const void* bbase() const { return Wt; }
    __device__ __forceinline__ bool next(int i, g8::Unit& u) const {
        if (!g8::tile_order(i * G + c, nM, nN, u.pm, u.pn)) return false;
        int e = 0;
#pragma unroll
        for (int x = 1; x < 8; ++x) e += (u.pm >= (int)((tp8 >> (8 * x)) & 0xffull)) ? 1 : 0;
        u.e = e; u.bo = (unsigned)e * (unsigned)wstride + (unsigned)u.pn * 256u * (unsigned)bpitch;
        u.ao = GATHER ? 0u : (unsigned)u.pm * 256u * (unsigned)apitch_; return true;
    }
    __device__ __forceinline__ void aoff(const g8::Unit& u, unsigned (&v)[4]) const {
        int R0, C0; g8::stage_rc(tid_fresh() * 16, R0, C0);
        const int cnt = __builtin_amdgcn_readfirstlane(tb[u.e]), l0 = (u.pm - (int)((tp8 >> (8 * u.e)) & 0xffull)) * 256;
#pragma unroll
        for (int x = 0; x < 4; ++x) { const int lr = l0 + 64 * x + R0; const int tok = lr < cnt ? list[u.e * 16384 + lr] : 0; v[x] = (unsigned)(tok * apitch_ + C0 * 2); }
    }
};
struct EpiSwiGLU8 {
    static constexpr bool AFTER_DRAIN = false;
    unsigned char* O; int ldc; float sc;
    __device__ __forceinline__ void operator()(const f32x4 (&acc)[2][2][4][2], const g8::Unit& u, int wr, int wc, int fr, int fq, LAS unsigned char* lds) const {
        const int row0 = u.pm * 256 + wr * 64 + fr, col0 = u.pn * 128 + wc * 32 + 8 * fq; const float k1 = -sc * 1.4426950408889634f, k2 = sc * sc;
#pragma unroll
        for (int ai = 0; ai < 2; ++ai)
#pragma unroll
            for (int m = 0; m < 4; ++m) { u32x2 w;
#pragma unroll
                for (int bj = 0; bj < 2; ++bj) { const f32x4 g = acc[ai][bj][m][0], up = acc[ai][bj][m][1]; unsigned x = 0u;
                    { const f32x2 a = swiglu2((f32x2){g[0], g[1]}, (f32x2){up[0], up[1]}, k1, k2); x = __builtin_amdgcn_cvt_pk_fp8_f32(clamp8(a[0]), clamp8(a[1]), x, false); }
                    { const f32x2 b = swiglu2((f32x2){g[2], g[3]}, (f32x2){up[2], up[3]}, k1, k2); x = __builtin_amdgcn_cvt_pk_fp8_f32(clamp8(b[0]), clamp8(b[1]), x, true); }
                    if (bj == 0) w.x = x; else w.y = x; }
                *(u32x2*)(O + (size_t)(row0 + ai * 128 + m * 16) * ldc + col0) = w;
                asm volatile("" ::: "memory"); }
    }
};
struct EpiBf16S {
    static constexpr bool AFTER_DRAIN = false;
    bf16* O; int ldc; float sc;
    __device__ __forceinline__ void operator()(const f32x4 (&acc)[2][2][4][2], const g8::Unit& u, int wr, int wc, int fr, int fq) const {
        const int row0 = u.pm * 256 + wr * 64 + fr, col0 = u.pn * 256 + wc * 64 + 8 * fq;
#pragma unroll
        for (int ai = 0; ai < 2; ++ai)
#pragma unroll
            for (int m = 0; m < 4; ++m) { bf16* rowp = O + (size_t)(row0 + ai * 128 + m * 16) * ldc + col0;
#pragma unroll
                for (int bj = 0; bj < 2; ++bj) { const f32x4 v0 = acc[ai][bj][m][0] * sc, v1 = acc[ai][bj][m][1] * sc;
                    u32x4 w; w.x = pk2(v0[0], v0[1]); w.y = pk2(v0[2], v0[3]); w.z = pk2(v1[0], v1[1]); w.w = pk2(v1[2], v1[3]); *(u32x4*)(rowp + bj * 32) = w; } }
    }
};

__device__ __forceinline__ void phase_norm_router(const Params& p, LAS unsigned char* lds) {
    const int tid = tid_fresh(), lane = tid & 63, wave = tid >> 6; unsigned char* ws = p.ws;
    LAS int* lc = (LAS int*)(lds + LDS_MISC + 256);
    LAS int* rec = lc + 16;
    const bf16* M = (const bf16*)(ws + WS_M); bf16* U = (bf16*)(ws + WS_U);
    const float* wrt = p.in[I_MWR];
    int* list = (int*)(ws + WS_LIST); int* toke = (int*)(ws + WS_TOKE); float* tokw = (float*)(ws + WS_TOKW); unsigned* gcnt = (unsigned*)(ws + WS_CNT);
    for (int r0 = (gridDim.x == 256 ? (int)((blockIdx.x & 7) * 2048 + (blockIdx.x >> 3) * 64) : (int)blockIdx.x * 64); r0 < NT; r0 += gridDim.x * 64) {
        __syncthreads();
        if (tid < 16) lc[tid] = 0;
        LAS unsigned char* wl = lds + 65536;
#pragma unroll
        for (int kk = 0; kk < 2; ++kk) { const int k = tid + 512 * kk, l_ = (k & 255) >> 2, jx = (k >> 8) * 4 + (k & 3); const f32x4 a = *(const f32x4*)(wrt + (size_t)k * 8), b = *(const f32x4*)(wrt + (size_t)k * 8 + 4);
            *(LAS f32x4*)(wl + (jx * 64 + l_) * 48) = a; *(LAS f32x4*)(wl + (jx * 64 + l_) * 48 + 16) = b; }
        __syncthreads();
#if FUSE_NORM
        u32x2 nA[4], nB[4]; float nra, nrb;
#define RT_LOAD(i_) do { const int a_ = r0 + wave * 8 + (i_), b_ = a_ + 4; const bf16* H_ = (const bf16*)(ws + WS_H); \
            _Pragma("unroll") for (int j = 0; j < 4; ++j) { nA[j] = *(const u32x2*)(H_ + (size_t)a_ * D + 4 * lane + 256 * j); nB[j] = *(const u32x2*)(H_ + (size_t)b_ * D + 4 * lane + 256 * j); } \
            nra = ((const float*)(ws + WS_RS))[a_]; nrb = ((const float*)(ws + WS_RS))[b_]; } while (0)
        RT_LOAD(0);
#endif
        for (int i = 0; i < 4; ++i) { const int lrA = wave * 8 + i, lrB = lrA + 4, mA = r0 + lrA, mB = r0 + lrB; f32x4 h[4], h2[4];
            bf16* H = (bf16*)(ws + WS_H);
#if FUSE_NORM
            { const float ra = nra, rb = nrb; const float* gp = p.in[I_NFPRE] + D;
#pragma unroll
              for (int j = 0; j < 4; ++j) { h[j] = (f32x4){bflo(nA[j].x), bfhi(nA[j].x), bflo(nA[j].y), bfhi(nA[j].y)}; h2[j] = (f32x4){bflo(nB[j].x), bfhi(nB[j].x), bflo(nB[j].y), bfhi(nB[j].y)}; }
              if (i + 1 < 4) RT_LOAD(i + 1);
#pragma unroll
              for (int j = 0; j < 4; ++j) { const f32x4 g = *(const f32x4*)(gp + 4 * lane + 256 * j); h[j] = h[j] * ra * g; h2[j] = h2[j] * rb * g; } }
#else
            row_norm2<true>(H + (size_t)mA * D, M + (size_t)mA * D, H + (size_t)mA * D, MOE_F8 ? nullptr : U + (size_t)mA * D, H + (size_t)mB * D, M + (size_t)mB * D, H + (size_t)mB * D, MOE_F8 ? nullptr : U + (size_t)mB * D, p.in[I_NMPOST] + D, p.in[I_NFPRE] + D, lane, h, h2);
#endif
#if MOE_F8
            if (gridDim.x == 256) {
#pragma unroll
                for (int j = 0; j < 4; ++j) { *(LAS unsigned*)(lds + lrA * 1024 + 4 * lane + 256 * j) = pk4f8(h[j][0], h[j][1], h[j][2], h[j][3]); *(LAS unsigned*)(lds + lrB * 1024 + 4 * lane + 256 * j) = pk4f8(h2[j][0], h2[j][1], h2[j][2], h2[j][3]); }
            } else {
#pragma unroll
            for (int j = 0; j < 4; ++j) { *(unsigned*)(ws + WS_U8 + (size_t)mA * D + 4 * lane + 256 * j) = pk4f8(h[j][0], h[j][1], h[j][2], h[j][3]); *(unsigned*)(ws + WS_U8 + (size_t)mB * D + 4 * lane + 256 * j) = pk4f8(h2[j][0], h2[j][1], h2[j][2], h2[j][3]); } }
#endif
            float lg[8], lh[8];
#pragma unroll
            for (int e = 0; e < 8; ++e) { lg[e] = 0.f; lh[e] = 0.f; }
#pragma unroll
            for (int j = 0; j < 4; ++j)
#pragma unroll
                for (int x = 0; x < 4; ++x) { const f32x4 wa = *(const LAS f32x4*)(wl + ((j * 4 + x) * 64 + lane) * 48), wb = *(const LAS f32x4*)(wl + ((j * 4 + x) * 64 + lane) * 48 + 16); const float hv = h[j][x], hw = h2[j][x];
                    lg[0] += hv * wa[0]; lg[1] += hv * wa[1]; lg[2] += hv * wa[2]; lg[3] += hv * wa[3]; lg[4] += hv * wb[0]; lg[5] += hv * wb[1]; lg[6] += hv * wb[2]; lg[7] += hv * wb[3];
                    lh[0] += hw * wa[0]; lh[1] += hw * wa[1]; lh[2] += hw * wa[2]; lh[3] += hw * wa[3]; lh[4] += hw * wb[0]; lh[5] += hw * wb[1]; lh[6] += hw * wb[2]; lh[7] += hw * wb[3]; }
            float w1;
            { const bool b5 = (lane & 32) != 0, b4 = (lane & 16) != 0, b3 = (lane & 8) != 0, b2 = (lane & 4) != 0; float w8[8], w4[4], w2[2];
#pragma unroll
              for (int e = 0; e < 8; ++e) { const float snd = b5 ? lg[e] : lh[e], kp = b5 ? lh[e] : lg[e]; w8[e] = kp + __shfl_xor(snd, 32); }
#pragma unroll
              for (int e = 0; e < 4; ++e) { const float snd = b4 ? w8[e] : w8[e + 4], kp = b4 ? w8[e + 4] : w8[e]; w4[e] = kp + __shfl_xor(snd, 16); }
#pragma unroll
              for (int e = 0; e < 2; ++e) { const float snd = b3 ? w4[e] : w4[e + 2], kp = b3 ? w4[e + 2] : w4[e]; w2[e] = kp + __shfl_xor(snd, 8); }
              { const float snd = b2 ? w2[0] : w2[1], kp = b2 ? w2[1] : w2[0]; w1 = kp + __shfl_xor(snd, 4); }
              w1 += __shfl_xor(w1, 2); w1 += __shfl_xor(w1, 1); }
#pragma unroll
            for (int rr = 0; rr < 2; ++rr) { const int lr = rr ? lrB : lrA, m = rr ? mB : mA;
                float l8[8];
#pragma unroll
                for (int e = 0; e < 8; ++e) l8[e] = __builtin_bit_cast(float, __builtin_amdgcn_readlane(__builtin_bit_cast(int, w1), 32 * rr + 16 * (e >> 2) + 8 * ((e >> 1) & 1) + 4 * (e & 1)));
                int e0 = 0; float v0 = l8[0];
#pragma unroll
                for (int e = 1; e < 8; ++e) if (l8[e] > v0) { v0 = l8[e]; e0 = e; }
                int e1 = e0 == 0 ? 1 : 0; float v1 = -3.4e38f;
#pragma unroll
                for (int e = 0; e < 8; ++e) if (e != e0 && l8[e] > v1) { v1 = l8[e]; e1 = e; }
                if (lane == 0) { const float x = __expf(v1 - v0), w0 = 1.f / (1.f + x), w1 = x / (1.f + x);
                    const int p0 = __hip_atomic_fetch_add(lc + e0, 1, __ATOMIC_RELAXED, __HIP_MEMORY_SCOPE_WORKGROUP), p1 = __hip_atomic_fetch_add(lc + e1, 1, __ATOMIC_RELAXED, __HIP_MEMORY_SCOPE_WORKGROUP);
                    rec[lr * 4 + 0] = e0; rec[lr * 4 + 1] = e1; rec[lr * 4 + 2] = p0; rec[lr * 4 + 3] = p1; tokw[m * 2] = w0; tokw[m * 2 + 1] = w1; } }
        }
        __syncthreads();
        if (tid < 8) lc[8 + tid] = (int)atomicAdd(gcnt + tid, (unsigned)lc[tid]);
        __syncthreads();
        if (tid < 128) { const int lr = tid >> 1, k = tid & 1, e = rec[lr * 4 + k], pos = lc[8 + e] + rec[lr * 4 + 2 + k], m = r0 + lr;
            list[e * 16384 + pos] = m; toke[m * 2 + k] = (e << 16) | pos; }
    }
}

__device__ __forceinline__ void phase_moe_gather(const Params& p, LAS unsigned char* lds) {
    const int tid_ = tid_fresh(), lane = tid_ & 63, wave = tid_ >> 6; const int gw = blockIdx.x * 8 + wave, NGW = gridDim.x * 8; unsigned char* ws = p.ws;
    LAS int* tb = (LAS int*)(lds + LDS_MISC); const int* list = (const int*)(ws + WS_LIST);
    if (gridDim.x == 256) {
        const LAS int* lc = (const LAS int*)(lds + LDS_MISC + 256); const LAS int* rec = lc + 16;
        for (int idx = wave; idx < 128; idx += 8) { const int lr = idx >> 1, k = idx & 1, e = rec[lr * 4 + k], pos = lc[8 + e] + rec[lr * 4 + 2 + k];
            const u32x4 v = *(const LAS u32x4*)(lds + lr * 1024 + 16 * lane);
            *(u32x4*)(ws + WS_XG8 + ((size_t)tb[8 + e] * 256 + pos) * D + 16 * lane) = v; }
        return; }
    for (int e = 0; e < NE; ++e) { const int cnt = tb[e]; const size_t base = (size_t)tb[8 + e] * 256;
        for (int r = gw; r < cnt; r += 2 * NGW) { const int r2 = r + NGW; const int t0 = list[e * 16384 + r], t1 = r2 < cnt ? list[e * 16384 + r2] : t0;
            const u32x4 a = *(const u32x4*)(ws + WS_U8 + (size_t)t0 * D + 16 * lane), b = *(const u32x4*)(ws + WS_U8 + (size_t)t1 * D + 16 * lane);
            *(u32x4*)(ws + WS_XG8 + (base + r) * D + 16 * lane) = a; if (r2 < cnt) *(u32x4*)(ws + WS_XG8 + (base + r2) * D + 16 * lane) = b; } }
}
__device__ __forceinline__ void phase_final(const Params& p, LAS unsigned char* lds) {
    const int tid_ = tid_fresh(), lane = tid_ & 63, wave = tid_ >> 6; const int gw = blockIdx.x * 8 + wave, NGW = gridDim.x * 8; unsigned char* ws = p.ws;
    LAS int* tb = (LAS int*)(lds + LDS_MISC);
    const bf16* Y = (const bf16*)(ws + WS_Y); const int* toke = (const int*)(ws + WS_TOKE); const float* tokw = (const float*)(ws + WS_TOKW); const float* g = p.in[I_NFPOST] + D;
    const f32x4 gg0 = *(const f32x4*)(g + 4 * lane), gg1 = *(const f32x4*)(g + 4 * lane + 256), gg2 = *(const f32x4*)(g + 4 * lane + 512), gg3 = *(const f32x4*)(g + 4 * lane + 768);
    for (int mm = gw; mm < NT; mm += 2 * NGW) {
        int c0[2], c1[2]; float w0[2], w1[2]; size_t s0[2], s1[2];
#pragma unroll
        for (int z = 0; z < 2; ++z) { const int m = mm + z * NGW; c0[z] = toke[m * 2]; c1[z] = toke[m * 2 + 1]; w0[z] = tokw[m * 2]; w1[z] = tokw[m * 2 + 1]; }
#pragma unroll
        for (int z = 0; z < 2; ++z) { s0[z] = (size_t)tb[8 + (c0[z] >> 16)] * 256 + (c0[z] & 0xffff); s1[z] = (size_t)tb[8 + (c1[z] >> 16)] * 256 + (c1[z] & 0xffff); }
        f32x4 f[2][4]; u32x2 hw[2][4]; float ss[2] = {0.f, 0.f};
#pragma unroll
        for (int z = 0; z < 2; ++z)
#pragma unroll
            for (int j = 0; j < 4; ++j) { const u32x2 a = *(const u32x2*)(Y + s0[z] * D + 4 * lane + 256 * j), b = *(const u32x2*)(Y + s1[z] * D + 4 * lane + 256 * j);
                hw[z][j] = *(const u32x2*)((const bf16*)(ws + WS_H) + (size_t)(mm + z * NGW) * D + 4 * lane + 256 * j);
                f[z][j] = (f32x4){bflo(a.x), bfhi(a.x), bflo(a.y), bfhi(a.y)} * w0[z] + (f32x4){bflo(b.x), bfhi(b.x), bflo(b.y), bfhi(b.y)} * w1[z];
                ss[z] += f[z][j][0] * f[z][j][0] + f[z][j][1] * f[z][j][1] + f[z][j][2] * f[z][j][2] + f[z][j][3] * f[z][j][3]; }
#pragma unroll
        for (int z = 0; z < 2; ++z) { const float r = rsqrtf(wave_sum(ss[z]) * (1.f / D) + EPS);
#pragma unroll
            for (int j = 0; j < 4; ++j) { float* o = p.out + (size_t)(mm + z * NGW) * D + 4 * lane + 256 * j; const f32x4 gg = j == 0 ? gg0 : j == 1 ? gg1 : j == 2 ? gg2 : gg3;
                f32x4 res = (f32x4){bflo(hw[z][j].x), bfhi(hw[z][j].x), bflo(hw[z][j].y), bfhi(hw[z][j].y)} + f[z][j] * r * gg;
#if NSA_MODE >= 2
                { const float* pa = (const float*)(ws + WS_PACC); float a = 0.f, bq = 0.f; for (int i = 0; i < (int)gridDim.x; ++i) { a += pa[2 * i]; bq += pa[2 * i + 1]; } const float dd = a / bq; res = res * (1.f + sqrtf(fminf(PROBE_GAIN * dd, 4.f))); }
#endif
                *(f32x4*)o = res; } }
    }
}

constexpr int N_PHASES = 17;
template <> struct g8::EpiLds<EpiSwiGLU8> { static constexpr bool v = true; };
template <> struct g8::EpiRS<g8::EpiSwiGLU> { static constexpr bool v = true; };
template <> struct g8::EpiRS<EpiGmlpIn> { static constexpr bool v = true; };
template <> struct g8::EpiId<EpiInProj> { static constexpr int id = 0; };
template <> struct g8::EpiId<g8::EpiBf16> { static constexpr int id = 1; };
template <> struct g8::EpiId<g8::EpiSwiGLU> { static constexpr int id = 2; };
template <> struct g8::EpiId<EpiGmlpIn> { static constexpr int id = 3; };
template <> struct g8::EpiId<EpiSwiGLU8> { static constexpr int id = 4; };
template <> struct g8::EpiId<EpiBf16S> { static constexpr int id = 5; };
__global__ void __launch_bounds__(512, 2) mega(Params p) {
    extern __shared__ __attribute__((aligned(16))) unsigned char lds_raw[];
    LAS unsigned char* lds = (LAS unsigned char*)lds_raw;
    cg::grid_group grid = cg::this_grid();
    unsigned char* ws = p.ws;
    const int G = gridDim.x, c = blockIdx.x;
    const int lo = p.ph_lo, hi = p.ph_hi;
#define IN(k) (lo <= (k) && (k) < hi)
#ifndef REPEAT_MASK
#define REPEAT_MASK 0
#endif
#define REP(k) for (int rep_ = 0; rep_ < 1 + ((REPEAT_MASK >> (k)) & 1); ++rep_)
    volatile LAS unsigned* bst = (volatile LAS unsigned*)(lds + LDS_MISC + 2048);
    if (threadIdx.x < 2) bst[threadIdx.x] = 0u;
    __syncthreads();
    const XcdBarrier xbar = xcd_barrier_post((unsigned*)(ws + WS_BAR), bst);
    if (lo > 0) grid.sync();
#ifdef BAR_PROBE
#define SEAM(k) do { if (IN(k) && IN((k) + 1)) { xcd_barrier(xbar); xcd_barrier(xbar); xcd_barrier(xbar); } } while (0)
#else
#define SEAM(k) do { if (IN(k) && IN((k) + 1)) xcd_barrier(xbar); } while (0)
#endif
    bf16* U = (bf16*)(ws + WS_U); bf16* Mb = (bf16*)(ws + WS_M);

    if (IN(0)) REP(0) phase_prep(p, lds);
    SEAM(0);
    if (IN(1)) REP(1) {
        g8::StaticSched S{U, ws + WS_WIN, 2 * D, 2 * D, NT / 256, IN0P / 256, G, c};
        EpiInProj E{(bf16*)(ws + WS_Q), (bf16*)(ws + WS_KV), (bf16*)(ws + WS_CGLU), (float*)(ws + WS_GATES)};
        g8::gemm_phase(lds, D, S, E);
        if (2 * c >= G) moe_convert_range(p, lds, 0, MOE_N1, (c - G / 2) * 8 + (tid_fresh() >> 6), (G - G / 2) * 8);
    }
    SEAM(1);
    if (IN(2)) REP(2) phase_cmp_conv(p, lds);
    SEAM(2);
#if NSA_MODE == 0
    if (IN(3)) REP(3) phase_nsa_simple(p, lds);
#elif NSA_MODE == 1
    if (IN(3)) REP(3) NSA_FN(p, lds, (bf16*)(ws + WS_CAT), nullptr, nullptr);
#elif NSA_MODE == 4
    if (IN(3)) { bf16* cz = (bf16*)(ws + WS_CAT); for (int i = blockIdx.x * 512 + threadIdx.x; i < NT * 64; i += gridDim.x * 512) *(u32x4*)(cz + (size_t)(i >> 6) * 1024 + (i & 63) * 8) = (u32x4){0u, 0u, 0u, 0u}; }
#else
    if (IN(3)) REP(3) { phase_nsa_simple(p, lds); grid.sync();
        NSA_FN(p, lds, (bf16*)(ws + WS_M), NSA_MODE == 2 ? (const unsigned long long*)(ws + WS_PROBE + 4096) : nullptr, (unsigned long long*)(ws + WS_PROBE + 4096) + NT * 2);
        grid.sync(); phase_probe_cmp(p); }
#endif
    SEAM(3);

    if (IN(4)) REP(4) {
        g8::StaticSched S{ws + WS_CAT, ws + WS_WOUT, 2 * D, 2 * D, NT / 256, D / 256, G, c};
#if FUSE_NORM
        EpiRmsRes2<false> E{p.in[I_X], (bf16*)(ws + WS_H), (float*)(ws + WS_RS), p.in[I_NMPOST], (float*)(ws + WS_XSLOT), (unsigned*)(ws + WS_XCNT), 0};
#else
        g8::EpiBf16 E{Mb, D};
#endif
        g8::gemm_phase(lds, D, S, E);
    }
#if !FUSE_NORM
    SEAM(4);
    if (IN(5)) REP(5) phase_norm<false>(p, p.in[I_X], p.in[I_NMPOST], p.in[I_NFPRE], FFN_F8 ? ws + WS_U8 : nullptr, FFN_F8 ? nullptr : (float*)(ws + WS_RS));
#endif
    SEAM(5);
    if (IN(6)) REP(6) {
#if FFN_F8
        g8::StaticSched S{ws + WS_U8, ws + WS_WGU, D, D, NT / 256, 2 * FF / 256, G, c};
        EpiSwiGLU8 E{ws + WS_FACT, FF, 1.f / MOE_SGU};
        g8::gemm_phase<true>(lds, D, S, E);
#else
        g8::StaticSched S{ws + WS_H, ws + WS_WGU, 2 * D, 2 * D, NT / 256, 2 * FF / 256, G, c};
        g8::EpiSwiGLU E{(bf16*)(ws + WS_FACT), FF, (const float*)(ws + WS_RS)};
        g8::gemm_phase(lds, D, S, E);
#endif
        if (2 * c >= G) moe_convert_range(p, lds, MOE_N1, MOE_N1 + MOE_N6, (c - G / 2) * 8 + (tid_fresh() >> 6), (G - G / 2) * 8);
    }
    SEAM(6);
    if (IN(7)) REP(7) {
#if FFN_F8
        g8::StaticSched S{ws + WS_FACT, ws + WS_WDN, FF, FF, NT / 256, D / 256, G, c};
        EpiBf16S E{Mb, D, 1.f / MOE_SD};
        g8::gemm_phase<true>(lds, FF, S, E);
#else
        g8::StaticSched S{ws + WS_FACT, ws + WS_WDN, 2 * FF, 2 * FF, NT / 256, D / 256, G, c};
#if FUSE_NORM
        EpiRmsRes2<true> E{ws + WS_H, (bf16*)(ws + WS_H), (float*)(ws + WS_RS), p.in[I_NFPOST], (float*)(ws + WS_XSLOT), (unsigned*)(ws + WS_XCNT), 2};
#else
        g8::EpiBf16 E{Mb, D};
#endif
        g8::gemm_phase(lds, FF, S, E);
#endif
    }
#if !FUSE_NORM || FFN_F8
    SEAM(7);
    if (IN(8)) REP(8) phase_norm<true>(p, ws + WS_H, p.in[I_NFPOST], p.in[I_NMPRE] + D, nullptr, (float*)(ws + WS_RS));
#endif
    SEAM(8);
    if (IN(9)) REP(9) {
        g8::StaticSched S{ws + WS_H, ws + WS_WGIN, 2 * D, 2 * D, NT / 256, 2 * D / 256, G, c};
        EpiGmlpIn E{(bf16*)(ws + WS_Z), (f32x2*)(ws + WS_STATS), (const float*)(ws + WS_RS)};
        g8::gemm_phase(lds, D, S, E);
    }
    SEAM(9);
#ifdef SGU_SIMPLE
    if (IN(10)) REP(10) phase_gmlp_sgu(p, lds);
#else
    if (IN(10)) REP(10) phase_gmlp_sgu_fast(p, lds);
#endif
    SEAM(10);
    if (IN(11)) REP(11) {
        g8::StaticSched S{ws + WS_CAT, ws + WS_WGOUT, 2 * D, 2 * D, NT / 256, D / 256, G, c};
#if FUSE_NORM
        EpiRmsRes2<true> E{ws + WS_H, (bf16*)(ws + WS_H), (float*)(ws + WS_RS), p.in[I_NMPOST] + D, (float*)(ws + WS_XSLOT), (unsigned*)(ws + WS_XCNT), 4};
#else
        g8::EpiBf16 E{Mb, D};
#endif
        g8::gemm_phase(lds, D, S, E);
    }
    SEAM(11);
    if (IN(12)) REP(12) phase_norm_router(p, lds);
    SEAM(12);
    if (IN(13)) { moe_tables(p, lds); phase_moe_gather(p, lds); }
    SEAM(13);
    if (IN(14)) REP(14) {
        if (!IN(13)) moe_tables(p, lds);
#if MOE_F8
        MoeSched<false> S{(const char*)(ws + WS_XG8), (const char*)(ws + WS_WMGU), nullptr, (LAS int*)(lds + LDS_MISC), D, D, 2 * EFF / 256, G, c, (size_t)2 * EFF * D}; S.init();
        EpiSwiGLU8 E{ws + WS_MACT, EFFP, 1.f / MOE_SGU};
#ifdef MOE_UP_PROBE
        g8::gemm_phase<true>(lds, D, S, E);
#endif
        g8::gemm_phase<true>(lds, D, S, E);
        { const int units = S.nM * S.nN, rounds = (units + G - 1) / G, first_idle = units - (rounds - 1) * G;
          const int nidle = G - first_idle;
          if (nidle > 0) { if (c >= first_idle) moe_convert_range(p, lds, MOE_TILES - MOE_N13, MOE_TILES, (c - first_idle) * 8 + (tid_fresh() >> 6), nidle * 8); }
          else moe_convert_range(p, lds, MOE_TILES - MOE_N13, MOE_TILES, c * 8 + (tid_fresh() >> 6), G * 8); }
#else
        MoeSched<true> S{(const char*)U, (const char*)(ws + WS_WMGU), (const int*)(ws + WS_LIST), (LAS int*)(lds + LDS_MISC), 2 * D, 2 * D, 2 * EFF / 256, G, c, (size_t)2 * EFF * D * 2}; S.init();
        g8::EpiSwiGLU E{(bf16*)(ws + WS_MACT), EFF};
        g8::gemm_phase(lds, D, S, E);
#endif
    }
    SEAM(14);
    if (IN(15)) REP(15) {
        if (!IN(13)) moe_tables(p, lds);
#if MOE_F8
        MoeSched<false> S{(const char*)(ws + WS_MACT), (const char*)(ws + WS_WMD), nullptr, (LAS int*)(lds + LDS_MISC), EFFP, EFFP, D / 256, G, c, (size_t)D * EFFP}; S.init();
        EpiBf16S E{(bf16*)(ws + WS_Y), D, 1.f / MOE_SD};
        g8::gemm_phase<true>(lds, EFF, S, E, EFFP);
#else
        MoeSched<false> S{(const char*)(ws + WS_MACT), (const char*)(ws + WS_WMD), nullptr, (LAS int*)(lds + LDS_MISC), 2 * EFF, 2 * EFF, D / 256, G, c, (size_t)D * EFF * 2}; S.init();
        g8::EpiBf16 E{(bf16*)(ws + WS_Y), D};
        g8::gemm_phase(lds, EFF, S, E);
#endif
    }
    SEAM(15);
    if (IN(16)) REP(16) { if (!IN(13)) moe_tables(p, lds); phase_final(p, lds); }
#undef IN
#undef SEAM
}

extern "C" void kernel_launch(void* const* d_in, const int* in_sizes, int n_in, void* d_out, int out_size, void* d_ws, size_t ws_size, hipStream_t stream) {
    static int grid = 0;
    if (grid == 0) {
        if (n_in != 29 || out_size != NT * D || ws_size < WS_END) { fprintf(stderr, "kernel_launch: unexpected shapes: n_in %d out %d ws %zu (need %zu)\n", n_in, out_size, ws_size, (size_t)WS_END); grid = -1; return; }
        int dev = 0, cus = 0, per_cu = 0;
        hipGetDevice(&dev); hipDeviceGetAttribute(&cus, hipDeviceAttributeMultiprocessorCount, dev);
        hipFuncSetAttribute((const void*)mega, hipFuncAttributeMaxDynamicSharedMemorySize, LDS_BYTES);
        hipOccupancyMaxActiveBlocksPerMultiprocessor(&per_cu, (const void*)mega, 512, LDS_BYTES);
        if (per_cu < 1) { fprintf(stderr, "kernel_launch: occupancy query says %d blocks per CU\n", per_cu); per_cu = 1; }
        grid = cus * 1;
        fprintf(stderr, "kernel_launch: cus %d per_cu %d grid %d ws %zu\n", cus, per_cu, grid, ws_size);
    }
    if (grid < 0) return;
    if (hipMemsetAsync((char*)d_ws + WS_BAR, 0, 16384 + 98304, stream) != hipSuccess) { fprintf(stderr, "kernel_launch: memset failed\n"); return; }
    Params p{};
    for (int i = 0; i < 29; ++i) p.in[i] = (const float*)d_in[i];
    p.out = (float*)d_out; p.ws = (unsigned char*)d_ws; p.ph_lo = 0; p.ph_hi = N_PHASES;
    void* args[] = {&p};
    hipError_t e = hipLaunchCooperativeKernel((const void*)mega, dim3(grid), dim3(512), args, LDS_BYTES, stream);
    if (e != hipSuccess) fprintf(stderr, "cooperative launch failed: %s (grid %d)\n", hipGetErrorString(e), grid);
}
```

```cpp
#include <hip/hip_runtime.h>
#include <hip/hip_cooperative_groups.h>
#include <cstdio>
#include <cstdint>
namespace cg = cooperative_groups;

#ifndef NSA_MODE
#define NSA_MODE 1
#endif
#ifndef NSA_FN
#define NSA_FN phase_nsa3
#endif
#ifndef N3_PROBE
#define N3_PROBE 0
#endif
#ifndef NSA_VT
#define NSA_VT 0
#endif
#ifndef FUSE_NORM
#define FUSE_NORM 1
#endif
#ifndef P2_NCV
#define P2_NCV 128
#endif
#ifndef PROBE_GAIN
#define PROBE_GAIN 100.f
#endif
#define LAS __attribute__((address_space(3)))
typedef unsigned short bf16;
typedef short bf16x8 __attribute__((ext_vector_type(8)));
typedef float f32x4 __attribute__((ext_vector_type(4)));
typedef float f32x2 __attribute__((ext_vector_type(2)));
typedef unsigned u32x4 __attribute__((ext_vector_type(4)));
typedef unsigned u32x2 __attribute__((ext_vector_type(2)));
typedef float f32x16 __attribute__((ext_vector_type(16)));
typedef int i32x4 __attribute__((ext_vector_type(4)));
typedef int i32x8 __attribute__((ext_vector_type(8)));
#define MFMA32(a, b, c) __builtin_amdgcn_mfma_f32_32x32x16_bf16((a), (b), (c), 0, 0, 0)

constexpr int NT = 16384, D = 1024, SEQ = 4096, NB = 4;
constexpr int IN0 = 2328, IN0P = 2560;
constexpr int FF = 2816, EFF = 3584, NE = 8;
constexpr int EFFP = 3712;
constexpr int MOE_ROWS = 2 * NT + NE * 256;
constexpr float EPS = 1e-6f;
constexpr float QSCALE = 0.125f * 1.4426950408889634f;

constexpr size_t MiB = 1u << 20;
#ifndef FFN_F8
#define FFN_F8 0
#endif
#ifndef MOE_F8
#define MOE_F8 1
#endif
#if MOE_F8
constexpr size_t WS_WMGU = 0;
constexpr size_t WS_WMD = 56 * MiB;
constexpr size_t WS_Y = 85 * MiB;
constexpr size_t WS_U8 = 152 * MiB;
constexpr size_t WS_XG8 = 292 * MiB;
#else
constexpr size_t WS_WMGU = 0;
constexpr size_t WS_Y = 0;
constexpr size_t WS_WMD = 112 * MiB;
#endif
constexpr float MOE_SGU = 32.f, MOE_SD = 64.f;
constexpr size_t WS_C = 168 * MiB;
constexpr size_t WS_MACT = WS_C;
constexpr size_t WS_WIN = WS_C + 0 * MiB;
constexpr size_t WS_WOUT = WS_C + 5 * MiB;
constexpr size_t WS_WGU = WS_C + 7 * MiB;
constexpr size_t WS_WDN = WS_C + 18 * MiB;
constexpr size_t WS_WGIN = WS_C + 24 * MiB;
constexpr size_t WS_WGOUT = WS_C + 28 * MiB;
constexpr size_t WS_WC1 = WS_C + 30 * MiB;
constexpr size_t WS_WSB = WS_C + 32 * MiB;
constexpr size_t WS_KC = WS_WSB + 256 * 1024;
constexpr size_t WS_VC = WS_KC + 256 * 1024;
constexpr size_t WS_VCT = WS_VC + 256 * 1024;
constexpr size_t WS_BIAS1 = WS_C + 39 * MiB;
constexpr size_t WS_W2T = WS_BIAS1 + 2048;
constexpr size_t WS_PROBE = WS_BIAS1 + 4096 + 65536;
constexpr size_t WS_H1C = WS_C + 33 * MiB;
constexpr size_t WS_GATES = WS_C + 35 * MiB;
constexpr size_t WS_STATS = WS_C + 37 * MiB;
constexpr size_t WS_Q = WS_C + 40 * MiB;
constexpr size_t WS_KV = WS_C + 56 * MiB;
constexpr size_t WS_VT = WS_C + 80 * MiB;
constexpr size_t WS_CGLU = WS_C + 88 * MiB;
constexpr size_t WS_CAT = WS_C + 104 * MiB;
constexpr size_t WS_M = WS_C + 136 * MiB;
constexpr size_t WS_FACT = WS_C + 40 * MiB;
constexpr size_t WS_Z = WS_C + 40 * MiB;
constexpr size_t WS_H = WS_C + 200 * MiB;
constexpr size_t WS_U = 406 * MiB;
constexpr size_t WS_E = 438 * MiB;
constexpr size_t WS_CNT = WS_E;
constexpr size_t WS_LIST = WS_E + 4096;
constexpr size_t WS_TOKE = WS_LIST + 8 * 16384 * 4;
constexpr size_t WS_TOKW = WS_TOKE + 16384 * 8;
constexpr size_t WS_RS = WS_E + 832 * 1024;
constexpr size_t WS_BAR = 439 * MiB + 512 * 1024;
constexpr size_t WS_PACC = 439 * MiB;
constexpr size_t WS_XCNT = WS_BAR + 16384;
constexpr size_t WS_XSLOT = 406 * MiB;
constexpr size_t WS_END = 441 * MiB;

constexpr int LDS_BYTES = 163840;
constexpr int LDS_XB = 147456;
constexpr int LDS_MISC = 135168;

__device__ __forceinline__ unsigned f2bf(float f) { unsigned u = __float_as_uint(f); return (u + 0x7fffu + ((u >> 16) & 1u)) >> 16; }
typedef __bf16 bf16x2_t __attribute__((ext_vector_type(2)));
__device__ __forceinline__ unsigned pk2(float lo, float hi) { return __builtin_bit_cast(unsigned, __builtin_convertvector((f32x2){lo, hi}, bf16x2_t)); }
__device__ __forceinline__ float bflo(unsigned w) { return __uint_as_float(w << 16); }
__device__ __forceinline__ float bfhi(unsigned w) { return __uint_as_float(w & 0xffff0000u); }
__device__ __forceinline__ float bf2f(bf16 b) { return __uint_as_float((unsigned)b << 16); }
__device__ __forceinline__ float wave_sum(float v) {
#pragma unroll
    for (int o = 1; o < 64; o <<= 1) v += __shfl_xor(v, o);
    return v;
}
__device__ __forceinline__ float wave_max(float v) {
#pragma unroll
    for (int o = 1; o < 64; o <<= 1) v = fmaxf(v, __shfl_xor(v, o));
    return v;
}
__device__ __forceinline__ float sigm(float x) { return __builtin_amdgcn_rcpf(1.f + __expf(-x)); }
__device__ __forceinline__ float silu(float x) { return x * sigm(x); }
__device__ __forceinline__ float gelu_tanh(float x) { constexpr float C1 = -2.f * 0.7978845608028654f * 1.4426950408889634f, C2 = 0.044715f * C1;
    const float t = x * __builtin_fmaf(x * x, C2, C1); return x * __builtin_amdgcn_rcpf(1.f + __builtin_amdgcn_exp2f(t)); }
__device__ __forceinline__ f32x2 swiglu2(f32x2 g, f32x2 u, float k1, float k2) { f32x2 t = g * k1; t = (f32x2){__builtin_amdgcn_exp2f(t[0]), __builtin_amdgcn_exp2f(t[1])} + 1.f;
    t = (f32x2){__builtin_amdgcn_rcpf(t[0]), __builtin_amdgcn_rcpf(t[1])}; return ((g * u) * t) * k2; }
__device__ __forceinline__ f32x2 gelu_tanh2(f32x2 x) { constexpr float C1 = -2.f * 0.7978845608028654f * 1.4426950408889634f, C2 = 0.044715f * C1;
    f32x2 t = x * ((x * x) * C2 + C1); t = (f32x2){__builtin_amdgcn_exp2f(t[0]), __builtin_amdgcn_exp2f(t[1])} + 1.f; return x * (f32x2){__builtin_amdgcn_rcpf(t[0]), __builtin_amdgcn_rcpf(t[1])}; }
#define WAVE_FENCE() asm volatile("s_waitcnt lgkmcnt(0)" ::: "memory")
__device__ __forceinline__ int tid_fresh() { int t = threadIdx.x; asm volatile("" : "+v"(t)); return t; }
__device__ __forceinline__ float clamp8(float x) { float r; asm("v_med3_f32 %0, %1, %2, -%2" : "=v"(r) : "v"(x), "s"(448.f)); return r; }
__device__ __forceinline__ unsigned pk4f8(float a, float b, float c, float d) { unsigned r = 0u; r = __builtin_amdgcn_cvt_pk_fp8_f32(clamp8(a), clamp8(b), r, false); r = __builtin_amdgcn_cvt_pk_fp8_f32(clamp8(c), clamp8(d), r, true); return r; }


#define XB_TMO      128
#define XB_XCNT(j)  (256  + 64 * (j))
#define XB_XSUB(j)  (1280 + 64 * (j))
#define XB_XGEN(j)  (2304 + 64 * (j))
#define XB_TOP      3328
#define XB_TOPGEN   3392
#define XCD_BAR_WORDS 3456
#define XB_SPIN_CAP (1u << 22)
__device__ __forceinline__ unsigned xb_ld(unsigned* p)              { return __hip_atomic_load(p, __ATOMIC_RELAXED, __HIP_MEMORY_SCOPE_AGENT); }
__device__ __forceinline__ unsigned xb_add(unsigned* p, unsigned v) { return __hip_atomic_fetch_add(p, v, __ATOMIC_RELAXED, __HIP_MEMORY_SCOPE_AGENT); }
__device__ __forceinline__ unsigned xb_xcc_id() { return (unsigned)__builtin_amdgcn_s_getreg((3 << 11) | 20) & 0xFu; }
#define XB_SPIN(cond, bar) do { unsigned _sp = 0; while (cond) { __builtin_amdgcn_s_sleep(1); \
    if ((++_sp & 255u) == 0u) { if (xb_ld(&(bar)[XB_TMO])) break; if (_sp > XB_SPIN_CAP) { atomicAdd(&(bar)[XB_TMO], 1u); break; } } } } while (0)
struct XcdBarrier { unsigned* bar; unsigned x; volatile LAS unsigned* st; };
__device__ __forceinline__ XcdBarrier xcd_barrier_post(unsigned* bar, volatile LAS unsigned* st) {
    XcdBarrier b; b.bar = bar; b.x = xb_xcc_id(); b.st = st;
    if (threadIdx.x == 0) (void)xb_add(&bar[XB_XCNT(b.x)], 1u);
    return b;
}
__device__ __forceinline__ void xcd_barrier_complete(unsigned* bar, unsigned x, unsigned& nloc, unsigned& nx) {
    const unsigned G = gridDim.x * gridDim.y * gridDim.z;
    unsigned sum, cnt, mine, sp = 0u;
    for (;;) {
        sum = 0u; cnt = 0u; mine = 0u;
#pragma unroll
        for (unsigned j = 0; j < 16; ++j) { const unsigned c = xb_ld(&bar[XB_XCNT(j)]); sum += c; cnt += (c > 0u) ? 1u : 0u; mine = (j == x) ? c : mine; }
        if (sum == G) break;
        __builtin_amdgcn_s_sleep(1);
        if ((++sp & 255u) == 0u) { if (xb_ld(&bar[XB_TMO])) break; if (sp > XB_SPIN_CAP) { atomicAdd(&bar[XB_TMO], 1u); break; } }
    }
    nloc = mine > 0u ? mine : 1u; nx = cnt > 0u ? cnt : 1u;
}
__device__ __forceinline__ void xcd_barrier(const XcdBarrier& b) {
    asm volatile("s_waitcnt vmcnt(0)" ::: "memory");
    __syncthreads();
    if (threadIdx.x == 0) {
        unsigned* bar = b.bar;
        __builtin_amdgcn_s_waitcnt(0);
        unsigned nloc = b.st[0], nx = b.st[1];
        if (nloc == 0u) { xcd_barrier_complete(bar, b.x, nloc, nx); b.st[0] = nloc; b.st[1] = nx; }
        const unsigned old = xb_add(&bar[XB_XSUB(b.x)], 1u);
        const unsigned gen = old / nloc;
        if (old + 1u == (gen + 1u) * nloc) {
            __builtin_amdgcn_fence(__ATOMIC_RELEASE, "agent");
            asm volatile("s_waitcnt vmcnt(0)" ::: "memory");
            const unsigned og = xb_add(&bar[XB_TOP], 1u);
            const unsigned tg = og / nx;
            if (og + 1u == (tg + 1u) * nx) xb_add(&bar[XB_TOPGEN], 1u);
            else XB_SPIN(xb_ld(&bar[XB_TOPGEN]) == tg, bar);
            __builtin_amdgcn_fence(__ATOMIC_ACQUIRE, "agent");
            xb_add(&bar[XB_XGEN(b.x)], 1u);
            asm volatile("s_waitcnt vmcnt(0)" ::: "memory");
        } else {
            XB_SPIN(xb_ld(&bar[XB_XGEN(b.x)]) == gen, bar);
            __builtin_amdgcn_fence(__ATOMIC_ACQUIRE, "agent");
            asm volatile("s_waitcnt vmcnt(0)" ::: "memory");
        }
    }
    __syncthreads();
}

namespace g8 {
constexpr int BM = 256, BK = 64, HALF = 128, HTB = HALF * BK * 2, STAGE_BYTES = 8 * HTB, NXCD = 8, WGM = 8;
__host__ __device__ __forceinline__ int lds_byte(int r, int c) { const int st = (r >> 4) * 2 + (c >> 5), rr = r & 15, cc = c & 31, ob = rr * 64 + cc * 2; return st * 1024 + (ob ^ (((ob >> 9) & 1) << 5)); }
__host__ __device__ __forceinline__ void stage_rc(int b, int& R, int& C) { const int st = b / 1024, sb = b % 1024, swz = sb ^ (((sb >> 9) & 1) << 5); R = (st >> 1) * 16 + swz / 64; C = (st & 1) * 32 + (swz % 64) / 2; }

struct Unit { int pm, pn, e; unsigned ao, bo; };

__device__ __forceinline__ bool tile_order(int L, int nM, int nN, int& pm, int& pn) {
    const int nwg = nM * nN; if (L >= nwg) return false;
    int wgid = L; { const int q = nwg / NXCD, r = nwg % NXCD, xcd = wgid % NXCD, off = wgid / NXCD; wgid = (xcd < r ? xcd * (q + 1) : r * (q + 1) + (xcd - r) * q) + off; }
    const int nig = WGM * nN, gid = wgid / nig, fm = gid * WGM, gsz = (nM - fm) < WGM ? (nM - fm) : WGM;
    pm = fm + ((wgid % nig) % gsz); pn = (wgid % nig) / gsz; return true;
}
struct StaticSched {
    static constexpr bool GATHER = false;
    const void* A; const void* Bt; int apitch_, bpitch, nM, nN, G, c;
    __device__ __forceinline__ int apitch() const { return apitch_; }
    __device__ __forceinline__ const void* abase() const { return A; }
    __device__ __forceinline__ const void* bbase() const { return Bt; }
    __device__ __forceinline__ bool next(int i, Unit& u) const {
        if (!tile_order(i * G + c, nM, nN, u.pm, u.pn)) return false;
        u.e = 0; u.ao = (unsigned)u.pm * BM * (unsigned)apitch_; u.bo = (unsigned)u.pn * BM * (unsigned)bpitch; return true;
    }
    __device__ __forceinline__ void aoff(const Unit&, unsigned (&)[4]) const {}
};

#ifndef EPI_REP_MASK
#define EPI_REP_MASK 0
#endif
template <class E> struct EpiId { static constexpr int id = 31; };
template <class E> struct EpiLds { static constexpr bool v = false; };
template <class S> struct SchedVarK { static constexpr bool v = false; };
template <class E> struct EpiRS { static constexpr bool v = false; };
constexpr int LDS_RS = 132096;
#define G8_WAIT_V(n) asm volatile("s_waitcnt vmcnt(" #n ")" ::: "memory")
#define G8_WAIT_L(n) asm volatile("s_waitcnt lgkmcnt(" #n ")" ::: "memory")
#define G8_BAR __builtin_amdgcn_s_barrier()
#define G8_SCHED __builtin_amdgcn_sched_barrier(0)

template <bool F8 = false, class Epi, class Sched>
__device__ __forceinline__ void gemm_phase(LAS unsigned char* lds, const int K, const Sched& S, const Epi& E, const int bpitch_bytes = 0) {
    const int tid = tid_fresh(), wid = __builtin_amdgcn_readfirstlane(tid >> 6), lane = tid & 63, wr = wid >> 2, wc = wid & 3, fr = lane & 15, fq = lane >> 4;
    constexpr int ES = F8 ? 1 : 2, KSTR = F8 ? 16 : 1024;
    int nt = K * ES / 128;
    int R0, C0; stage_rc(tid * 16, R0, C0);
    const int bpitch = bpitch_bytes ? bpitch_bytes : K * ES, apitch = S.apitch();
    const unsigned vb0 = (unsigned)(R0 * bpitch + C0 * 2);
    unsigned va0 = (unsigned)(R0 * apitch + C0 * 2);
    const unsigned kstep = 128u;
    const unsigned hB = (unsigned)HALF * bpitch, qB = 64u * bpitch, hA = (unsigned)HALF * apitch, qA = 64u * apitch;
    const __amdgpu_buffer_rsrc_t rA = __builtin_amdgcn_make_buffer_rsrc((void*)S.abase(), 0, -1, 0x00020000), rB = __builtin_amdgcn_make_buffer_rsrc((void*)S.bbase(), 0, -1, 0x00020000);
    const unsigned ldsw = (unsigned)wid * 1024u;
    const int aoff = lds_byte(wr * 64 + fr, F8 ? fq * 16 : fq * 8), boff = lds_byte(wc * 32 + fr, F8 ? fq * 16 : fq * 8);
    unsigned ldsA = (unsigned)(size_t)lds + (unsigned)aoff, ldsB = (unsigned)(size_t)lds + 65536u + (unsigned)boff;
    asm volatile("" : "+v"(ldsA), "+v"(ldsB), "+v"(va0));
#define G8_SA(b, h) (((b) * 2 + (h)) * HTB)
#define G8_SB(b, h) ((4 + (b) * 2 + (h)) * HTB)
#define G8_BLDS(rsrc, voff, soff, ldsoff) __builtin_amdgcn_raw_ptr_buffer_load_lds(rsrc, (LAS void*)(lds + (ldsoff) + ldsw), 16, (int)(voff), (int)(soff), 0, 0)
#define G8_STAGE_B(b, h, sb) do { const unsigned s_ = (sb) + (h) * hB; G8_BLDS(rB, vb0, s_, G8_SB(b, h)); G8_BLDS(rB, vb0, s_ + qB, G8_SB(b, h) + 8192); } while (0)
#define G8_STAGE_A(b, h, sa, VV) do { if constexpr (Sched::GATHER) { G8_BLDS(rA, VV[2 * (h)], (sa), G8_SA(b, h)); G8_BLDS(rA, VV[2 * (h) + 1], (sa), G8_SA(b, h) + 8192); } \
        else { const unsigned s_ = (sa) + (h) * hA; G8_BLDS(rA, va0, s_, G8_SA(b, h)); G8_BLDS(rA, va0, s_ + qA, G8_SA(b, h) + 8192); } } while (0)
#define G8_LD16(base, off) (*(const LAS i32x4*)(size_t)((base) + (unsigned)(off)))
#define G8_LDA(dst, b, h) do { _Pragma("unroll") for (int m = 0; m < 4; ++m) dst[m] = __builtin_shufflevector(G8_LD16(ldsA, ((b) * 2 + (h)) * HTB + m * 2048), G8_LD16(ldsA, ((b) * 2 + (h)) * HTB + m * 2048 + KSTR), 0, 1, 2, 3, 4, 5, 6, 7); } while (0)
#define G8_LDB(dst, b, h) do { _Pragma("unroll") for (int n = 0; n < 2; ++n) dst[n] = __builtin_shufflevector(G8_LD16(ldsB, ((b) * 2 + (h)) * HTB + n * 2048), G8_LD16(ldsB, ((b) * 2 + (h)) * HTB + n * 2048 + KSTR), 0, 1, 2, 3, 4, 5, 6, 7); } while (0)
#define G8_LO(x) __builtin_bit_cast(bf16x8, __builtin_shufflevector((x), (x), 0, 1, 2, 3))
#define G8_HI(x) __builtin_bit_cast(bf16x8, __builtin_shufflevector((x), (x), 4, 5, 6, 7))
#define G8_MMA(ai, bj, At, Bt) do { __builtin_amdgcn_s_setprio(1); _Pragma("unroll") for (int m = 0; m < 4; ++m) _Pragma("unroll") for (int n = 0; n < 2; ++n) { \
        if constexpr (F8) acc[ai][bj][m][n] = __builtin_amdgcn_mfma_scale_f32_16x16x128_f8f6f4(Bt[n], At[m], acc[ai][bj][m][n], 0, 0, 0, 0x7f7f7f7f, 0, 0x7f7f7f7f); \
        else { acc[ai][bj][m][n] = __builtin_amdgcn_mfma_f32_16x16x32_bf16(G8_LO(Bt[n]), G8_LO(At[m]), acc[ai][bj][m][n], 0, 0, 0); \
               acc[ai][bj][m][n] = __builtin_amdgcn_mfma_f32_16x16x32_bf16(G8_HI(Bt[n]), G8_HI(At[m]), acc[ai][bj][m][n], 0, 0, 0); } } \
        __builtin_amdgcn_s_setprio(0); } while (0)
    Unit cur, nxt; int ui = 0;
    if (!S.next(0, cur)) return;
    f32x4 acc[2][2][4][2];
#pragma unroll
    for (int a = 0; a < 2; ++a)
#pragma unroll
        for (int b = 0; b < 2; ++b)
#pragma unroll
            for (int m = 0; m < 4; ++m)
#pragma unroll
                for (int n = 0; n < 2; ++n) acc[a][b][m][n] = (f32x4){0.f, 0.f, 0.f, 0.f};
    i32x8 At[4], B0[2], B1[2];
    unsigned vA[4] = {0u, 0u, 0u, 0u};
    LAS u32x4* vnext = (LAS u32x4*)(lds + 139264 + tid * 16);
    if constexpr (Sched::GATHER) { S.aoff(cur, vA); asm volatile("" : "+v"(vA[0]), "+v"(vA[1]), "+v"(vA[2]), "+v"(vA[3])); }
    unsigned cA = cur.ao, cB = cur.bo;
    G8_STAGE_B(0, 0, cB); G8_STAGE_A(0, 0, cA, vA); G8_STAGE_B(0, 1, cB); G8_STAGE_A(0, 1, cA, vA);
    if (wr == 1) G8_BAR;
    G8_WAIT_V(4); G8_BAR;
    G8_STAGE_B(1, 0, cB + kstep); G8_STAGE_A(1, 0, cA + kstep, vA); G8_STAGE_B(1, 1, cB + kstep);
    G8_WAIT_V(6); G8_BAR;
    for (;;) {
        const bool has_next = S.next(ui + 1, nxt);
        const unsigned nA = has_next ? nxt.ao : cA, nB = has_next ? nxt.bo : cB;
        if constexpr (Sched::GATHER) { unsigned vN[4] = {vA[0], vA[1], vA[2], vA[3]};
            if (has_next) S.aoff(nxt, vN);
            *vnext = (u32x4){vN[0], vN[1], vN[2], vN[3]}; }
        if constexpr (EpiRS<Epi>::v) {
            if (wid < 4) __builtin_amdgcn_global_load_lds(E.rs + cur.pm * 256 + wid * 64 + lane, (LAS void*)(lds + LDS_RS + (ui & 1) * 1024 + wid * 256), 4, 0, 0); }
        for (int t = 0; t < nt; t += 2) {
            const bool last = (t == nt - 2);
            const unsigned a1 = cA + (unsigned)(t + 1) * kstep;
            const unsigned a2 = last ? nA : cA + (unsigned)(t + 2) * kstep, b2 = last ? nB : cB + (unsigned)(t + 2) * kstep;
            const unsigned a3 = a2 + kstep, b3 = b2 + kstep;
            G8_LDB(B0, 0, 0); G8_SCHED; G8_LDA(At, 0, 0); G8_STAGE_A(1, 1, a1, vA);
            if constexpr (Sched::GATHER) { if (last) { const u32x4 v_ = *vnext; vA[0] = v_.x; vA[1] = v_.y; vA[2] = v_.z; vA[3] = v_.w; } }
            G8_WAIT_L(8); G8_BAR; G8_WAIT_L(0); G8_MMA(0, 0, At, B0); G8_BAR; G8_SCHED;
            G8_LDB(B1, 0, 1); G8_STAGE_B(0, 0, b2);
            G8_BAR; G8_WAIT_L(0); G8_MMA(0, 1, At, B1); G8_BAR;
            G8_LDA(At, 0, 1); G8_STAGE_A(0, 0, a2, vA);
            G8_BAR; G8_WAIT_L(0); G8_MMA(1, 0, At, B0); G8_BAR; G8_SCHED;
            G8_STAGE_B(0, 1, b2);
            G8_WAIT_V(6); G8_BAR; G8_MMA(1, 1, At, B1); G8_BAR;
            G8_LDB(B0, 1, 0); G8_SCHED; G8_LDA(At, 1, 0); G8_STAGE_A(0, 1, a2, vA);
            G8_WAIT_L(8); G8_BAR; G8_WAIT_L(0); G8_MMA(0, 0, At, B0); G8_BAR; G8_SCHED;
            G8_LDB(B1, 1, 1); G8_STAGE_B(1, 0, b3);
            G8_BAR; G8_WAIT_L(0); G8_MMA(0, 1, At, B1); G8_BAR;
            G8_LDA(At, 1, 1); G8_STAGE_A(1, 0, a3, vA);
            G8_BAR; G8_WAIT_L(0); G8_MMA(1, 0, At, B0); G8_BAR; G8_SCHED;
            G8_STAGE_B(1, 1, b3);
            G8_WAIT_V(6); G8_BAR; G8_MMA(1, 1, At, B1); G8_BAR;
        }
        if constexpr (!Epi::AFTER_DRAIN) {
            if constexpr (((EPI_REP_MASK >> EpiId<Epi>::id) & 1) != 0) { const int l0_ = tid_fresh() & 63;
                if constexpr (EpiRS<Epi>::v) E(acc, cur, wr, wc, l0_ & 15, l0_ >> 4, (const LAS float*)(lds + LDS_RS + (ui & 1) * 1024));
                else if constexpr (EpiLds<Epi>::v) E(acc, cur, wr, wc, l0_ & 15, l0_ >> 4, lds); else E(acc, cur, wr, wc, l0_ & 15, l0_ >> 4);
                asm volatile("" ::: "memory");
#pragma unroll
                for (int a = 0; a < 2; ++a)
#pragma unroll
                    for (int b = 0; b < 2; ++b)
#pragma unroll
                        for (int m = 0; m < 4; ++m)
#pragma unroll
                            for (int n = 0; n < 2; ++n) asm volatile("" : "+v"(acc[a][b][m][n])); }
            const int l_ = tid_fresh() & 63;
            if constexpr (EpiRS<Epi>::v) E(acc, cur, wr, wc, l_ & 15, l_ >> 4, (const LAS float*)(lds + LDS_RS + (ui & 1) * 1024));
            else if constexpr (EpiLds<Epi>::v) E(acc, cur, wr, wc, l_ & 15, l_ >> 4, lds);
            else E(acc, cur, wr, wc, l_ & 15, l_ >> 4); }
        if (!has_next) break;
#pragma unroll
        for (int a = 0; a < 2; ++a)
#pragma unroll
            for (int b = 0; b < 2; ++b)
#pragma unroll
                for (int m = 0; m < 4; ++m)
#pragma unroll
                    for (int n = 0; n < 2; ++n) acc[a][b][m][n] = (f32x4){0.f, 0.f, 0.f, 0.f};
        cur = nxt; cA = nA; cB = nB; ++ui;
        if constexpr (SchedVarK<Sched>::v) nt = S.nt(cur);
    }
    G8_WAIT_V(0);
    if (wr == 0) G8_BAR;
    G8_BAR;
    if constexpr (Epi::AFTER_DRAIN) { const int l_ = tid_fresh() & 63; E.fused(acc, cur, wr, wc, l_ & 15, l_ >> 4, lds); }
#undef G8_SA
#undef G8_SB
#undef G8_BLDS
#undef G8_STAGE_A
#undef G8_STAGE_B
#undef G8_LDA
#undef G8_LDB
#undef G8_LD16
#undef G8_LO
#undef G8_HI
#undef G8_MMA
}

struct EpiBf16 {
    static constexpr bool AFTER_DRAIN = false;
    bf16* O; int ldc;
    __device__ __forceinline__ void operator()(const f32x4 (&acc)[2][2][4][2], const Unit& u, int wr, int wc, int fr, int fq) const {
        const int row0 = u.pm * BM + wr * 64 + fr, col0 = u.pn * BM + wc * 64 + 8 * fq;
#pragma unroll
        for (int ai = 0; ai < 2; ++ai)
#pragma unroll
            for (int m = 0; m < 4; ++m) { bf16* rowp = O + (size_t)(row0 + ai * HALF + m * 16) * ldc + col0;
#pragma unroll
                for (int bj = 0; bj < 2; ++bj) { const f32x4 v0 = acc[ai][bj][m][0], v1 = acc[ai][bj][m][1];
                    u32x4 w; w.x = pk2(v0[0], v0[1]); w.y = pk2(v0[2], v0[3]); w.z = pk2(v1[0], v1[1]); w.w = pk2(v1[2], v1[3]); *(u32x4*)(rowp + bj * 32) = w; } }
    }
};
struct EpiSwiGLU {
    static constexpr bool AFTER_DRAIN = false;
    bf16* O; int ldc; const float* rs;
    __device__ __forceinline__ void operator()(const f32x4 (&acc)[2][2][4][2], const Unit& u, int wr, int wc, int fr, int fq, const LAS float* rsl) const {
        const int row0 = u.pm * BM + wr * 64 + fr, col0 = u.pn * (BM / 2) + wc * 32 + 8 * fq;
#pragma unroll
        for (int ai = 0; ai < 2; ++ai)
#pragma unroll
            for (int m = 0; m < 4; ++m) { bf16* rowp = O + (size_t)(row0 + ai * HALF + m * 16) * ldc + col0; u32x4 w; const float rr = rsl[wr * 64 + fr + ai * HALF + m * 16];
#pragma unroll
                for (int bj = 0; bj < 2; ++bj) { const f32x4 g = acc[ai][bj][m][0], up = acc[ai][bj][m][1]; const float k1 = -rr * 1.4426950408889634f, k2 = rr * rr;
                    const f32x2 a = swiglu2((f32x2){g[0], g[1]}, (f32x2){up[0], up[1]}, k1, k2), b = swiglu2((f32x2){g[2], g[3]}, (f32x2){up[2], up[3]}, k1, k2);
                    const unsigned x = pk2(a[0], a[1]), y = pk2(b[0], b[1]); if (bj == 0) { w.x = x; w.y = y; } else { w.z = x; w.w = y; } }
                *(u32x4*)rowp = w; }
    }
};
}

struct Params {
    const float* in[29];
    float* out;
    unsigned char* ws;
    int ph_lo, ph_hi;
};
enum { I_X = 0, I_NMPRE, I_NMPOST, I_NFPRE, I_NFPOST, I_WIN, I_CPE, I_CW1, I_CB1, I_CW2, I_CB2, I_CONVW, I_CONVB, I_CLNG, I_CLNB, I_WOUT, I_FWG, I_FWU, I_FWD,
       I_GWIN, I_GLNG, I_GLNB, I_GWS, I_GBS, I_GWOUT, I_MWR, I_MWG, I_MWU, I_MWD };

struct TrArgs { const float* src0; const float* src1; int ld, K; bf16* dst; int k0, n0, mode; float f8scale; const float* kgain; };
__device__ __forceinline__ void tr_issue(const TrArgs& A_, int lane, f32x4 (&xr)[16]) {
    const float* src0 = A_.src0; const float* src1 = A_.src1; const int ld = A_.ld, k0 = A_.k0, n0 = A_.n0, mode = A_.mode;

    const int q = lane & 15, kr = lane >> 4;
    const int v = n0 + 4 * q;
    const float* sp = src0; int col = v; bool zero = false;
    if (mode == 1) {
        if (v < 1280) col = v;
        else if (v < 2304) { const int w = v - 1280, g32 = w >> 5, r = w & 31, ch = g32 * 16 + (r & 15); col = (r < 16) ? 1304 + ch : 1816 + ch; }
        else if (v < 2328) col = 1280 + (v - 2304);
        else zero = true;
    } else if (mode == 2) {
        const int g32 = v >> 5, r = v & 31; col = g32 * 16 + (r & 15); sp = (r < 16) ? src0 : src1;
    } else if (mode == 3 || mode == 6) {
        col = ((v >> 8) << 7) + (((v >> 5) & 3) << 5) + (((v >> 2) & 3) << 3) + (((v >> 7) & 1) << 2); sp = ((v >> 4) & 1) ? src1 : src0;
    } else if (mode == 4 || mode == 5) {
        col = (v & ~255) + (((v >> 5) & 3) << 6) + (((v >> 7) & 1) << 5) + (((v >> 2) & 3) << 3) + (((v >> 4) & 1) << 2);
    }
#pragma unroll
    for (int i = 0; i < 16; ++i) { xr[i] = (f32x4){0.f, 0.f, 0.f, 0.f}; if (!zero) xr[i] = __builtin_nontemporal_load((const f32x4*)(sp + (size_t)(k0 + kr + 4 * i) * ld + col)); }
}
__device__ __forceinline__ void tr_finish(const TrArgs& A_, LAS float* scr, int lane, f32x4 (&xr)[16]) {
    const int K = A_.K, k0 = A_.k0, n0 = A_.n0, mode = A_.mode; bf16* dst = A_.dst; const float f8scale = A_.f8scale; const float* kgain = A_.kgain;
    const int q = lane & 15, kr = lane >> 4;
    if (kgain) {
#pragma unroll
        for (int i = 0; i < 16; ++i) xr[i] = xr[i] * kgain[k0 + kr + 4 * i]; }
#pragma unroll
    for (int i = 0; i < 16; ++i) { LAS float* d = scr + (kr + 4 * i) * 65 + 4 * q; d[0] = xr[i][0]; d[1] = xr[i][1]; d[2] = xr[i][2]; d[3] = xr[i][3]; }
    WAVE_FENCE();
    if (mode == 3 || mode == 4) {
        const int c = lane & 3;
#pragma unroll
        for (int j = 0; j < 4; ++j) { const int n = (lane >> 2) + 16 * j; const LAS float* s = scr + (16 * c) * 65 + n;
            u32x4 o; o.x = pk4f8(s[0 * 65] * f8scale, s[1 * 65] * f8scale, s[2 * 65] * f8scale, s[3 * 65] * f8scale); o.y = pk4f8(s[4 * 65] * f8scale, s[5 * 65] * f8scale, s[6 * 65] * f8scale, s[7 * 65] * f8scale);
            o.z = pk4f8(s[8 * 65] * f8scale, s[9 * 65] * f8scale, s[10 * 65] * f8scale, s[11 * 65] * f8scale); o.w = pk4f8(s[12 * 65] * f8scale, s[13 * 65] * f8scale, s[14 * 65] * f8scale, s[15 * 65] * f8scale);
            *(u32x4*)((unsigned char*)dst + (size_t)(n0 + n) * K + k0 + 16 * c) = o; }
        WAVE_FENCE(); return; }
    const int c = lane & 7;
#pragma unroll
    for (int j = 0; j < 8; ++j) { const int n = (lane >> 3) + 8 * j; const LAS float* s = scr + (8 * c) * 65 + n;
        u32x4 o; o.x = pk2(s[0 * 65], s[1 * 65]); o.y = pk2(s[2 * 65], s[3 * 65]); o.z = pk2(s[4 * 65], s[5 * 65]); o.w = pk2(s[6 * 65], s[7 * 65]);
        *(u32x4*)(dst + (size_t)(n0 + n) * K + k0 + 8 * c) = o; }
    WAVE_FENCE();
}
__device__ __forceinline__ void tr_tile(const float* src0, const float* src1, int ld, int K, bf16* dst, int k0, int n0, int mode, LAS float* scr, int lane, float f8scale = 1.f, const float* kgain = nullptr) {
    const TrArgs A_{src0, src1, ld, K, dst, k0, n0, mode, f8scale, kgain}; f32x4 xr[16]; tr_issue(A_, lane, xr); tr_finish(A_, scr, lane, xr);
}

template <bool BF>
__device__ __forceinline__ void row_load(const void* rowp, int lane, f32x4 (&h)[4]) {
#pragma unroll
    for (int j = 0; j < 4; ++j) {
        if (BF) { const u32x2 w = *(const u32x2*)((const bf16*)rowp + 4 * lane + 256 * j); h[j] = (f32x4){bflo(w.x), bfhi(w.x), bflo(w.y), bfhi(w.y)}; }
        else h[j] = *(const f32x4*)((const float*)rowp + 4 * lane + 256 * j); }
}
template <bool BF>
__device__ __forceinline__ void row_norm(const void* base, const bf16* mrow, const float* gpost, bf16* hout, const float* gpre, bf16* urow, int lane, f32x4 (&h)[4]) {
    row_load<BF>(base, lane, h);
    if (mrow) {
        f32x4 mv[4]; float ss = 0.f;
#pragma unroll
        for (int j = 0; j < 4; ++j) { const u32x2 w = *(const u32x2*)(mrow + 4 * lane + 256 * j); mv[j] = (f32x4){bflo(w.x), bfhi(w.x), bflo(w.y), bfhi(w.y)};
            ss += mv[j][0] * mv[j][0] + mv[j][1] * mv[j][1] + mv[j][2] * mv[j][2] + mv[j][3] * mv[j][3]; }
        const float r = rsqrtf(wave_sum(ss) * (1.f / D) + EPS);
#pragma unroll
        for (int j = 0; j < 4; ++j) { const f32x4 g = *(const f32x4*)(gpost + 4 * lane + 256 * j); h[j] = h[j] + mv[j] * r * g;
            u32x2 w; w.x = pk2(h[j][0], h[j][1]); w.y = pk2(h[j][2], h[j][3]); *(u32x2*)(hout + 4 * lane + 256 * j) = w; }
    }
    if (urow) {
        float ss = 0.f;
#pragma unroll
        for (int j = 0; j < 4; ++j) ss += h[j][0] * h[j][0] + h[j][1] * h[j][1] + h[j][2] * h[j][2] + h[j][3] * h[j][3];
        const float r = rsqrtf(wave_sum(ss) * (1.f / D) + EPS);
#pragma unroll
        for (int j = 0; j < 4; ++j) { const f32x4 g = *(const f32x4*)(gpre + 4 * lane + 256 * j); h[j] = h[j] * r * g;
            u32x2 w; w.x = pk2(h[j][0], h[j][1]); w.y = pk2(h[j][2], h[j][3]); *(u32x2*)(urow + 4 * lane + 256 * j) = w; }
    }
}

constexpr int MOE_T_GU = 16 * 112, MOE_T_D = 56 * 16, MOE_TILES = NE * (MOE_T_GU + MOE_T_D);
constexpr int MOE_N1 = 3712, MOE_N6 = 5120, MOE_N2 = 9856, MOE_TILES_LATER = MOE_N1 + MOE_N6 + MOE_N2;
constexpr int MOE_N13 = 2816;
static_assert(MOE_TILES_LATER + MOE_N13 <= MOE_TILES && MOE_N13 <= NE * MOE_T_D, "tile split");
__device__ __forceinline__ TrArgs moe_tile_args(const Params& p, int it) {
    unsigned char* ws = p.ws;
    if (it < NE * MOE_T_GU) { const int e = it / MOE_T_GU, rr = it % MOE_T_GU;
#if MOE_F8
        return TrArgs{p.in[I_MWG] + (size_t)e * D * EFF, p.in[I_MWU] + (size_t)e * D * EFF, EFF, D, (bf16*)(ws + WS_WMGU + (size_t)e * 2 * EFF * D), (rr / 112) * 64, (rr % 112) * 64, 3, MOE_SGU, nullptr};
#else
        return TrArgs{p.in[I_MWG] + (size_t)e * D * EFF, p.in[I_MWU] + (size_t)e * D * EFF, EFF, D, (bf16*)(ws + WS_WMGU) + (size_t)e * 2 * EFF * D, (rr / 112) * 64, (rr % 112) * 64, 6, 1.f, nullptr};
#endif
    } else { const int r = it - NE * MOE_T_GU, e = r / MOE_T_D, rr = r % MOE_T_D;
#if MOE_F8
        return TrArgs{p.in[I_MWD] + (size_t)e * EFF * D, nullptr, D, EFFP, (bf16*)(ws + WS_WMD + (size_t)e * D * EFFP), (rr / 16) * 64, (rr % 16) * 64, 4, MOE_SD, nullptr};
#else
        return TrArgs{p.in[I_MWD] + (size_t)e * EFF * D, nullptr, D, EFF, (bf16*)(ws + WS_WMD) + (size_t)e * D * EFF, (rr / 16) * 64, (rr % 16) * 64, 0, 1.f, nullptr};
#endif
    }
}
__device__ __forceinline__ void moe_convert_tile(const Params& p, int it, LAS float* scr, int lane) { const TrArgs A_ = moe_tile_args(p, it); f32x4 xr[16]; tr_issue(A_, lane, xr); tr_finish(A_, scr, lane, xr); }
__device__ __forceinline__ void moe_convert_range(const Params& p, LAS unsigned char* lds, int t0, int t1, int widx, int nw) {
    const int tid = tid_fresh(), lane = tid & 63, wave = tid >> 6; LAS float* scr = (LAS float*)(lds + wave * 16640);
    int it = t0 + widx; if (it >= t1) return;
    TrArgs a = moe_tile_args(p, it), b = a; f32x4 xa[16], xb[16]; tr_issue(a, lane, xa);
    for (;;) {
        { const int nx = it + nw; const bool hn = nx < t1; if (hn) { b = moe_tile_args(p, nx); tr_issue(b, lane, xb); }
          asm volatile("" ::: "memory"); tr_finish(a, scr, lane, xa); if (!hn) break; it = nx; }
        { const int nx = it + nw; const bool hn = nx < t1; if (hn) { a = moe_tile_args(p, nx); tr_issue(a, lane, xa); }
          asm volatile("" ::: "memory"); tr_finish(b, scr, lane, xb); if (!hn) break; it = nx; }
    }
}

template <bool BF>
__device__ __forceinline__ void row_norm2(const void* baseA, const bf16* mA, bf16* houtA, bf16* uA, const void* baseB, const bf16* mB, bf16* houtB, bf16* uB,
                                          const float* gpost, const float* gpre, int lane, f32x4 (&h)[4], f32x4 (&h2)[4], float* rsA = nullptr, float* rsB = nullptr) {
    f32x4 ma[4], mb[4]; float sa = 0.f, sb = 0.f;
    row_load<BF>(baseA, lane, h); row_load<BF>(baseB, lane, h2);
#pragma unroll
    for (int j = 0; j < 4; ++j) { const u32x2 wa = *(const u32x2*)(mA + 4 * lane + 256 * j), wb = *(const u32x2*)(mB + 4 * lane + 256 * j);
        ma[j] = (f32x4){bflo(wa.x), bfhi(wa.x), bflo(wa.y), bfhi(wa.y)}; mb[j] = (f32x4){bflo(wb.x), bfhi(wb.x), bflo(wb.y), bfhi(wb.y)}; }
#pragma unroll
    for (int j = 0; j < 4; ++j) { sa += ma[j][0] * ma[j][0] + ma[j][1] * ma[j][1] + ma[j][2] * ma[j][2] + ma[j][3] * ma[j][3]; sb += mb[j][0] * mb[j][0] + mb[j][1] * mb[j][1] + mb[j][2] * mb[j][2] + mb[j][3] * mb[j][3]; }
    const float ra = rsqrtf(wave_sum(sa) * (1.f / D) + EPS), rb = rsqrtf(wave_sum(sb) * (1.f / D) + EPS);
    sa = 0.f; sb = 0.f;
#pragma unroll
    for (int j = 0; j < 4; ++j) { const f32x4 g = *(const f32x4*)(gpost + 4 * lane + 256 * j); h[j] = h[j] + ma[j] * ra * g; h2[j] = h2[j] + mb[j] * rb * g;
        u32x2 wa; wa.x = pk2(h[j][0], h[j][1]); wa.y = pk2(h[j][2], h[j][3]); *(u32x2*)(houtA + 4 * lane + 256 * j) = wa;
        u32x2 wb; wb.x = pk2(h2[j][0], h2[j][1]); wb.y = pk2(h2[j][2], h2[j][3]); *(u32x2*)(houtB + 4 * lane + 256 * j) = wb;
        sa += h[j][0] * h[j][0] + h[j][1] * h[j][1] + h[j][2] * h[j][2] + h[j][3] * h[j][3]; sb += h2[j][0] * h2[j][0] + h2[j][1] * h2[j][1] + h2[j][2] * h2[j][2] + h2[j][3] * h2[j][3]; }
    const float qa = rsqrtf(wave_sum(sa) * (1.f / D) + EPS), qb = rsqrtf(wave_sum(sb) * (1.f / D) + EPS);
    if (rsA) { if (lane == 0) { *rsA = qa; *rsB = qb; } return; }
#pragma unroll
    for (int j = 0; j < 4; ++j) { const f32x4 g = *(const f32x4*)(gpre + 4 * lane + 256 * j); h[j] = h[j] * qa * g; h2[j] = h2[j] * qb * g;
        if (uA) {
        u32x2 w; w.x = pk2(h[j][0], h[j][1]); w.y = pk2(h[j][2], h[j][3]); *(u32x2*)(uA + 4 * lane + 256 * j) = w;
        u32x2 w2; w2.x = pk2(h2[j][0], h2[j][1]); w2.y = pk2(h2[j][2], h2[j][3]); *(u32x2*)(uB + 4 * lane + 256 * j) = w2; } }
}

__device__ __forceinline__ void phase_prep(const Params& p, LAS unsigned char* lds) {
    const int tid = tid_fresh(), lane = tid & 63, wave = tid >> 6;
    const int gw = blockIdx.x * 8 + wave, NGW = gridDim.x * 8;
    LAS float* scr = (LAS float*)(lds + wave * 16640);
    unsigned char* ws = p.ws;
    constexpr int T_IN = 16 * 40, T_OUT = 16 * 16, T_GU = 16 * 88, T_DN = 44 * 16, T_GIN = 16 * 32, T_GOUT = 16 * 16, T_C1 = 2 * 32 * 4;
    constexpr int TOTAL = T_IN + T_OUT + T_GU + T_DN + T_GIN + T_GOUT + T_C1 + (MOE_TILES - MOE_TILES_LATER - MOE_N13);
    for (int it = gw; it < TOTAL; it += NGW) {
        int r = it;
        if (r < T_IN) { tr_tile(p.in[I_WIN], nullptr, IN0, D, (bf16*)(ws + WS_WIN), (r / 40) * 64, (r % 40) * 64, 1, scr, lane); continue; } r -= T_IN;
        if (r < T_OUT) { tr_tile(p.in[I_WOUT], nullptr, D, D, (bf16*)(ws + WS_WOUT), (r / 16) * 64, (r % 16) * 64, 5, scr, lane); continue; } r -= T_OUT;
#if FFN_F8
        if (r < T_GU) { tr_tile(p.in[I_FWG], p.in[I_FWU], FF, D, (bf16*)(ws + WS_WGU), (r / 88) * 64, (r % 88) * 64, 3, scr, lane, MOE_SGU); continue; } r -= T_GU;
        if (r < T_DN) { tr_tile(p.in[I_FWD], nullptr, D, FF, (bf16*)(ws + WS_WDN), (r / 16) * 64, (r % 16) * 64, 4, scr, lane, MOE_SD); continue; } r -= T_DN;
#else
        if (r < T_GU) { tr_tile(p.in[I_FWG], p.in[I_FWU], FF, D, (bf16*)(ws + WS_WGU), (r / 88) * 64, (r % 88) * 64, 6, scr, lane, 1.f, p.in[I_NFPRE]); continue; } r -= T_GU;
        if (r < T_DN) { tr_tile(p.in[I_FWD], nullptr, D, FF, (bf16*)(ws + WS_WDN), (r / 16) * 64, (r % 16) * 64, 5, scr, lane); continue; } r -= T_DN;
#endif
        if (r < T_GIN) { tr_tile(p.in[I_GWIN], nullptr, 2 * D, D, (bf16*)(ws + WS_WGIN), (r / 32) * 64, (r % 32) * 64, 5, scr, lane, 1.f, p.in[I_NMPRE] + D); continue; } r -= T_GIN;
        if (r < T_GOUT) { tr_tile(p.in[I_GWOUT], nullptr, D, D, (bf16*)(ws + WS_WGOUT), (r / 16) * 64, (r % 16) * 64, 5, scr, lane); continue; } r -= T_GOUT;
        if (r < T_C1) { const int kv = r / 128, rr = r % 128; tr_tile(p.in[I_CW1] + (size_t)kv * 2048 * 256, nullptr, 256, 2048, (bf16*)(ws + WS_WC1) + (size_t)kv * 256 * 2048, (rr / 4) * 64, (rr % 4) * 64, 0, scr, lane); continue; } r -= T_C1;
        moe_convert_tile(p, r + MOE_TILES_LATER, scr, lane);
    }
    for (int m = gw; m < NT; m += 2 * NGW) { f32x4 h[4], h2[4]; const int m2 = m + NGW; float sa = 0.f, sb = 0.f;
        row_load<false>(p.in[I_X] + (size_t)m * D, lane, h); row_load<false>(p.in[I_X] + (size_t)m2 * D, lane, h2);
#pragma unroll
        for (int j = 0; j < 4; ++j) { sa += h[j][0] * h[j][0] + h[j][1] * h[j][1] + h[j][2] * h[j][2] + h[j][3] * h[j][3]; sb += h2[j][0] * h2[j][0] + h2[j][1] * h2[j][1] + h2[j][2] * h2[j][2] + h2[j][3] * h2[j][3]; }
        const float ra = rsqrtf(wave_sum(sa) * (1.f / D) + EPS), rb = rsqrtf(wave_sum(sb) * (1.f / D) + EPS);
#pragma unroll
        for (int j = 0; j < 4; ++j) { const f32x4 g = *(const f32x4*)(p.in[I_NMPRE] + 4 * lane + 256 * j); const f32x4 a = h[j] * ra * g, b = h2[j] * rb * g;
            u32x2 w; w.x = pk2(a[0], a[1]); w.y = pk2(a[2], a[3]); *(u32x2*)((bf16*)(ws + WS_U) + (size_t)m * D + 4 * lane + 256 * j) = w;
            u32x2 w2; w2.x = pk2(b[0], b[1]); w2.y = pk2(b[2], b[3]); *(u32x2*)((bf16*)(ws + WS_U) + (size_t)m2 * D + 4 * lane + 256 * j) = w2; } }
    { const int gt = blockIdx.x * 512 + tid, NGT = gridDim.x * 512; bf16* wsb = (bf16*)(ws + WS_WSB);
      for (int i = gt; i < 8 * 128 * 128; i += NGT) { const int t = (i >> 7) & 127, s = i & 127; wsb[i] = (bf16)f2bf(s <= t ? p.in[I_GWS][i] : 0.f); } }
    for (int b = blockIdx.x; b < 256; b += gridDim.x) { const int kv = b >> 7, n0 = (b & 127) * 2; float a0 = 0.f, a1 = 0.f;
#pragma unroll
        for (int j = 0; j < 4; ++j) { const int k = tid * 4 + j; const float pe = p.in[I_CPE][kv * 2048 + k]; const f32x2 w = *(const f32x2*)(p.in[I_CW1] + (size_t)kv * 2048 * 256 + (size_t)k * 256 + n0); a0 += pe * w.x; a1 += pe * w.y; }
        a0 = wave_sum(a0); a1 = wave_sum(a1);
        __syncthreads();
        LAS float* red = (LAS float*)lds; if (lane == 0) { red[wave * 2] = a0; red[wave * 2 + 1] = a1; }
        __syncthreads();
        if (tid < 2) { float s = p.in[I_CB1][kv * 256 + n0 + tid];
#pragma unroll
            for (int i = 0; i < 8; ++i) s += red[i * 2 + tid];
            ((float*)(ws + WS_BIAS1))[kv * 256 + n0 + tid] = s; } }
    if (blockIdx.x == 1 && tid < 16) ((unsigned*)(ws + WS_CNT))[tid] = 0u;
    { bf16* w2t = (bf16*)(ws + WS_W2T);
      for (int i = blockIdx.x * 512 + tid; i < 2 * 64 * 256; i += gridDim.x * 512) { const int kv = i >> 14, n = (i >> 8) & 63, k = i & 255; w2t[i] = (bf16)f2bf(p.in[I_CW2][(size_t)kv * 256 * 64 + k * 64 + n]); } }
#if NSA_MODE >= 2
    (void)0;
#endif
}

struct EpiInProj {
    static constexpr bool AFTER_DRAIN = false;
    bf16* Q; bf16* KV; bf16* CG; float* GT;
    __device__ __forceinline__ void operator()(const f32x4 (&acc)[2][2][4][2], const g8::Unit& u, int wr, int wc, int fr, int fq) const {
        const int row0 = u.pm * 256 + wr * 64 + fr;
#pragma unroll
        for (int ai = 0; ai < 2; ++ai)
#pragma unroll
            for (int m = 0; m < 4; ++m) { const int row = row0 + ai * 128 + m * 16;
#pragma unroll
                for (int bj = 0; bj < 2; ++bj) {
                    const int cb = u.pn * 256 + bj * 128 + wc * 32 + 4 * fq;
                    if (u.pn < 2) {
#pragma unroll
                        for (int n = 0; n < 2; ++n) { const f32x4 v = acc[ai][bj][m][n] * QSCALE; u32x2 w; w.x = pk2(v[0], v[1]); w.y = pk2(v[2], v[3]); *(u32x2*)(Q + (size_t)row * 512 + cb + 16 * n) = w; }
                    } else if (u.pn < 5) {
                        const int b = row >> 12, s = row & 4095;
#pragma unroll
                        for (int n = 0; n < 2; ++n) { const int cc = cb + 16 * n - 512, j = cc >> 7, g = (cc >> 6) & 1, d = cc & 63; const f32x4 v = acc[ai][bj][m][n];
                            u32x2 w; w.x = pk2(v[0], v[1]); w.y = pk2(v[2], v[3]); *(u32x2*)(KV + ((((size_t)j * 4 + b) * 2 + g) * 4096 + s) * 64 + d) = w; }
                    } else if (u.pn < 9) {
                        const int ch = (((cb - 1280) >> 5) << 4) + 4 * fq; const f32x4 a = acc[ai][bj][m][0], bb = acc[ai][bj][m][1];
                        u32x2 w; w.x = pk2(a[0] * sigm(bb[0]), a[1] * sigm(bb[1])); w.y = pk2(a[2] * sigm(bb[2]), a[3] * sigm(bb[3])); *(u32x2*)(CG + (size_t)row * 512 + ch) = w;
                    } else {
#pragma unroll
                        for (int n = 0; n < 2; ++n) { const int cg0 = cb + 16 * n - 2304;
                            if (cg0 < 24) { const f32x4 v = acc[ai][bj][m][n]; *(f32x4*)(GT + (size_t)row * 24 + cg0) = (f32x4){sigm(v[0]), sigm(v[1]), sigm(v[2]), sigm(v[3])}; } }
                    }
                } }
    }
};

struct CmpSched {
    static constexpr bool GATHER = false;
    const bf16* A; const bf16* Bt; int pm;
    __device__ __forceinline__ int apitch() const { return 2048; }
    __device__ __forceinline__ const void* abase() const { return A; }
    __device__ __forceinline__ const void* bbase() const { return Bt; }
    __device__ __forceinline__ bool next(int i, g8::Unit& u) const { if (i > 0) return false; u.pm = pm; u.pn = 0; u.e = 0; u.ao = (unsigned)pm * 256u * 2048u; u.bo = 0u; return true; }
    __device__ __forceinline__ void aoff(const g8::Unit&, unsigned (&)[4]) const {}
};
struct EpiCmp {
    static constexpr bool AFTER_DRAIN = false;
    bf16* O; const float* bias;
    __device__ __forceinline__ void operator()(const f32x4 (&acc)[2][2][4][2], const g8::Unit& u, int wr, int wc, int fr, int fq) const {
        const int row0 = u.pm * 256 + wr * 64 + fr, col0 = wc * 32 + 4 * fq;
#pragma unroll
        for (int ai = 0; ai < 2; ++ai)
#pragma unroll
            for (int m = 0; m < 4; ++m) { bf16* rowp = O + (size_t)(row0 + ai * 128 + m * 16) * 256 + col0;
#pragma unroll
                for (int bj = 0; bj < 2; ++bj)
#pragma unroll
                    for (int n = 0; n < 2; ++n) { const f32x4 bv = *(const f32x4*)(bias + col0 + bj * 128 + n * 16); const f32x4 v = acc[ai][bj][m][n] + bv;
                        u32x2 w; w.x = pk2(gelu_tanh(v[0]), gelu_tanh(v[1])); w.y = pk2(gelu_tanh(v[2]), gelu_tanh(v[3])); *(u32x2*)(rowp + bj * 128 + n * 16) = w; } }
    }
};

__device__ __forceinline__ void phase_cmp_conv(const Params& p, LAS unsigned char* lds) {
    const int tid = tid_fresh(), lane = tid & 63, wave = tid >> 6;
    unsigned char* ws = p.ws;
    if (blockIdx.x < 16) {
        const int kv = blockIdx.x >> 3, pm = blockIdx.x & 7;
        const bf16* A = (const bf16*)(ws + WS_KV) + (size_t)kv * (4 * 2 * 4096 * 64);
        bf16* H1 = (bf16*)(ws + WS_H1C) + (size_t)kv * 2048 * 256;
        CmpSched S{A, (const bf16*)(ws + WS_WC1) + (size_t)kv * 256 * 2048, pm};
        EpiCmp E{H1, (const float*)(ws + WS_BIAS1) + kv * 256};
        g8::gemm_phase(lds, 2048, S, E);
        __threadfence(); __syncthreads();
        { const int q = lane & 31, h = lane >> 5; const bf16* w2t = (const bf16*)(ws + WS_W2T) + (size_t)kv * 64 * 256;
          const bf16* hr = H1 + (size_t)(pm * 256 + 32 * wave + q) * 256 + 8 * h;
          f32x16 a0, a1;
#pragma unroll
          for (int r = 0; r < 16; ++r) { a0[r] = 0.f; a1[r] = 0.f; }
          bf16x8 Af[16], B0[16], B1[16];
#pragma unroll
          for (int ks = 0; ks < 16; ++ks) { Af[ks] = *(const bf16x8*)(hr + 16 * ks); B0[ks] = *(const bf16x8*)(w2t + (size_t)q * 256 + 16 * ks + 8 * h); B1[ks] = *(const bf16x8*)(w2t + (size_t)(32 + q) * 256 + 16 * ks + 8 * h); }
#pragma unroll
          for (int ks = 0; ks < 16; ++ks) { a0 = MFMA32(Af[ks], B0[ks], a0); a1 = MFMA32(Af[ks], B1[ks], a1); }
          bf16* O = (bf16*)(ws + (kv == 0 ? WS_KC : WS_VC)); bf16* VCT = (bf16*)(ws + WS_VCT);
          const float b20 = p.in[I_CB2][kv * 64 + q], b21 = p.in[I_CB2][kv * 64 + 32 + q];
#pragma unroll
          for (int r = 0; r < 16; ++r) { const int rl = 32 * wave + (r & 3) + 8 * (r >> 2) + 4 * h, row = pm * 256 + rl;
              const bf16 v0 = (bf16)f2bf(a0[r] + b20), v1 = (bf16)f2bf(a1[r] + b21);
              O[(size_t)row * 64 + q] = v0; O[(size_t)row * 64 + 32 + q] = v1; }
          if (kv == 1) {
#pragma unroll
              for (int g = 0; g < 4; ++g) { const int rl0 = 32 * wave + 8 * g + 4 * h;
                  u32x2 w0, w1; w0.x = pk2(a0[4 * g] + b20, a0[4 * g + 1] + b20); w0.y = pk2(a0[4 * g + 2] + b20, a0[4 * g + 3] + b20);
                  w1.x = pk2(a1[4 * g] + b21, a1[4 * g + 1] + b21); w1.y = pk2(a1[4 * g + 2] + b21, a1[4 * g + 3] + b21);
                  *(u32x2*)(VCT + ((size_t)pm * 64 + q) * 256 + rl0) = w0; *(u32x2*)(VCT + ((size_t)pm * 64 + 32 + q) * 256 + rl0) = w1; } } }
    } else {
        const bf16* CG = (const bf16*)(ws + WS_CGLU); bf16* CAT = (bf16*)(ws + WS_CAT);
        const bool cv = (int)blockIdx.x - 16 < P2_NCV;
        const int gw = ((int)blockIdx.x - 16 - P2_NCV) * 8 + wave, NGW = ((int)gridDim.x - 16 - P2_NCV) * 8;
        if (cv)
        { LAS bf16* ct = (LAS bf16*)lds;
          LAS float* yb = (LAS float*)(lds + 73728);
          float wg[31];
#pragma unroll
          for (int w = 0; w < 31; ++w) wg[w] = p.in[I_CONVW][w * 512 + tid];
          const float cb = p.in[I_CONVB][tid];
          const int ch0 = 8 * lane;
          const f32x4 lg0 = *(const f32x4*)(p.in[I_CLNG] + ch0), lg1 = *(const f32x4*)(p.in[I_CLNG] + ch0 + 4), lb0 = *(const f32x4*)(p.in[I_CLNB] + ch0), lb1 = *(const f32x4*)(p.in[I_CLNB] + ch0 + 4);
          for (int tile = blockIdx.x - 16; tile < NT / 16; tile += P2_NCV) {
            const int tok0 = tile * 16, s0 = tok0 & 4095;
#pragma unroll
            for (int it = 0; it < 6; ++it) { const int i = tid + 512 * it; if (i < 46 * 64) { const int j = i >> 6, c8 = (i & 63) * 8; u32x4 v = (u32x4){0u, 0u, 0u, 0u};
                if (s0 - 30 + j >= 0) v = *(const u32x4*)(CG + (size_t)(tok0 - 30 + j) * 512 + c8);
                *(LAS u32x4*)(ct + j * 512 + c8) = v; } }
            __syncthreads();
            { float c[46];
#pragma unroll
              for (int j = 0; j < 46; ++j) c[j] = bf2f(ct[j * 512 + tid]);
#pragma unroll
              for (int t = 0; t < 16; ++t) { float a = cb;
#pragma unroll
                  for (int w = 0; w < 31; ++w) a += c[t + w] * wg[w];
                  yb[t * 512 + tid] = a; } }
            __syncthreads();
#pragma unroll
            for (int i = 0; i < 2; ++i) { const int t = 2 * wave + i; const f32x4 y0 = *(const LAS f32x4*)(yb + t * 512 + ch0), y1 = *(const LAS f32x4*)(yb + t * 512 + ch0 + 4);
                const float mu = wave_sum((y0[0] + y0[1]) + (y0[2] + y0[3]) + (y1[0] + y1[1]) + (y1[2] + y1[3])) * (1.f / 512.f);
                const f32x4 d0 = y0 - mu, d1 = y1 - mu;
                const float rs = rsqrtf(wave_sum((d0[0] * d0[0] + d0[1] * d0[1]) + (d0[2] * d0[2] + d0[3] * d0[3]) + (d1[0] * d1[0] + d1[1] * d1[1]) + (d1[2] * d1[2] + d1[3] * d1[3])) * (1.f / 512.f) + EPS);
                const f32x4 o0 = d0 * rs * lg0 + lb0, o1 = d1 * rs * lg1 + lb1;
                u32x4 w; w.x = pk2(silu(o0[0]), silu(o0[1])); w.y = pk2(silu(o0[2]), silu(o0[3])); w.z = pk2(silu(o1[0]), silu(o1[1])); w.w = pk2(silu(o1[2]), silu(o1[3]));
                *(u32x4*)(CAT + (size_t)(tok0 + t) * 1024 + 512 + ch0) = w; }
          } }
#if NSA_VT
        LAS bf16* sc = (LAS bf16*)(lds + wave * 8704);
        const bf16* KV = (const bf16*)(ws + WS_KV); bf16* VT = (bf16*)(ws + WS_VT); const size_t kvs = (size_t)4 * 2 * 4096 * 64;
        for (int it = gw; it < 2 * 8 * 64; it += NGW) {
            const int jj = it >> 9, bgx = (it >> 6) & 7, st = it & 63;
            const bf16* src = KV + (size_t)(3 + 2 * jj) * kvs + ((size_t)bgx * 4096 + st * 64) * 64;
            bf16* dst = VT + ((size_t)(jj * 8 + bgx) * 64) * 4096 + st * 64;
#pragma unroll
            for (int i = 0; i < 8; ++i) { const int row = (lane >> 3) + 8 * i, ch = lane & 7; const u32x4 v = *(const u32x4*)(src + row * 64 + ch * 8);
                *(LAS u32x2*)(sc + row * 68 + ch * 8) = (u32x2){v.x, v.y}; *(LAS u32x2*)(sc + row * 68 + ch * 8 + 4) = (u32x2){v.z, v.w}; }
            WAVE_FENCE();
#pragma unroll
            for (int i = 0; i < 8; ++i) { const int d = (lane >> 3) + 8 * i, c8 = (lane & 7) * 8; const LAS bf16* s = sc + c8 * 68 + d;
                u32x4 o; o.x = (unsigned)s[0] | ((unsigned)s[68] << 16); o.y = (unsigned)s[2 * 68] | ((unsigned)s[3 * 68] << 16);
                o.z = (unsigned)s[4 * 68] | ((unsigned)s[5 * 68] << 16); o.w = (unsigned)s[6 * 68] | ((unsigned)s[7 * 68] << 16);
                *(u32x4*)(dst + (size_t)d * 4096 + c8) = o; }
            WAVE_FENCE();
        }
#endif
        __syncthreads();
        if (!cv) moe_convert_range(p, lds, MOE_N1 + MOE_N6, MOE_TILES_LATER, gw, NGW);
    }
}

__device__ __forceinline__ float dot64(const LAS float* q, const bf16* krow) {
    float a = 0.f;
#pragma unroll
    for (int c = 0; c < 8; ++c) { const u32x4 v = *(const u32x4*)(krow + 8 * c); const f32x4 q0 = *(const LAS f32x4*)(q + 8 * c), q1 = *(const LAS f32x4*)(q + 8 * c + 4);
        a += q0[0] * bflo(v.x) + q0[1] * bfhi(v.x) + q0[2] * bflo(v.y) + q0[3] * bfhi(v.y) + q1[0] * bflo(v.z) + q1[1] * bfhi(v.z) + q1[2] * bflo(v.w) + q1[3] * bfhi(v.w); }
    return a;
}
__device__ __forceinline__ void phase_nsa_simple(const Params& p, LAS unsigned char* lds) {
    const int tid = tid_fresh(), lane = tid & 63, wave = tid >> 6;
    unsigned char* ws = p.ws;
    LAS float* qs = (LAS float*)(lds + wave * 8192);
    LAS float* pb = qs + 256;
    LAS float* ocb = pb + 1024;
    const bf16* Q = (const bf16*)(ws + WS_Q); const bf16* KV = (const bf16*)(ws + WS_KV); const float* GT = (const float*)(ws + WS_GATES);
    const bf16* KC = (const bf16*)(ws + WS_KC); const bf16* VC = (const bf16*)(ws + WS_VC); bf16* CAT = (bf16*)(ws + WS_CAT);
    const int gw = blockIdx.x * 8 + wave, NGW = gridDim.x * 8;
    for (int it = gw; it < NT * 2; it += NGW) {
        const int g = it & 1, tok = it >> 1, b = tok >> 12, t = tok & 4095, bg = b * 2 + g;
        { const u32x2 w = *(const u32x2*)(Q + (size_t)tok * 512 + g * 256 + 4 * lane); *(LAS f32x4*)(qs + 4 * lane) = (f32x4){bflo(w.x), bfhi(w.x), bflo(w.y), bfhi(w.y)}; }
        WAVE_FENCE();
        const size_t kvs = (size_t)4 * 2 * 4096 * 64;
        const bf16* kslc = KV + 2 * kvs + (size_t)bg * 4096 * 64; const bf16* vslc = KV + 3 * kvs + (size_t)bg * 4096 * 64;
        const bf16* kwin = KV + 4 * kvs + (size_t)bg * 4096 * 64; const bf16* vwin = KV + 5 * kvs + (size_t)bg * 4096 * 64;
        const bf16* kc = KC + (size_t)bg * 256 * 64; const bf16* vc = VC + (size_t)bg * 256 * 64;
        const int nvis = t >= 31 ? (t - 31) / 16 + 1 : 0;
        float imp = 0.f;
        for (int hg = 0; hg < 4; ++hg) {
            float s[4]; float mx = -1e30f;
#pragma unroll
            for (int i = 0; i < 4; ++i) { const int n = lane + 64 * i; s[i] = (n < nvis) ? dot64(qs + hg * 64, kc + (size_t)n * 64) * (1.f / 1.4426950408889634f) : -1e30f; mx = fmaxf(mx, s[i]); }
            mx = wave_max(mx); float l = 0.f;
#pragma unroll
            for (int i = 0; i < 4; ++i) { const int n = lane + 64 * i; s[i] = (n < nvis) ? __expf(s[i] - mx) : 0.f; l += s[i]; }
            l = wave_sum(l); const float il = nvis > 0 ? 1.f / l : 0.f;
#pragma unroll
            for (int i = 0; i < 4; ++i) pb[lane + 64 * i] = s[i] * il;
            WAVE_FENCE();
            { float a = 0.f;
#pragma unroll
              for (int d = -1; d < 4; ++d) { const int n = 4 * lane + d; if (n >= 0) a += pb[n]; }
              imp += a; }
            float o = 0.f;
            for (int n = 0; n < nvis; ++n) o += pb[n] * bf2f(vc[(size_t)n * 64 + lane]);
            ocb[hg * 64 + lane] = o;
            WAVE_FENCE();
        }
        const int cur = t >> 6;
        const bool valid = lane <= cur, forced = (lane == 0) || (lane == cur) || (lane == cur - 1);
        const float score = valid ? imp + (forced ? 1e6f : 0.f) : -1e9f;
        int rank = 0;
        for (int i = 0; i < 64; ++i) { const float si = __shfl(score, i); rank += (si > score || (si == score && i < lane)) ? 1 : 0; }
        const unsigned long long selmask = __ballot(rank < 16);
#if NSA_MODE >= 2
        if (lane == 0) ((unsigned long long*)(ws + WS_PROBE + 4096))[(size_t)tok * 2 + g] = selmask;
#endif
        for (int hg = 0; hg < 4; ++hg) {
            const LAS float* qh = qs + hg * 64;
            float s[16]; float mx = -1e30f; unsigned long long mm = selmask;
#pragma unroll
            for (int i = 0; i < 16; ++i) { const int jb = __builtin_ctzll(mm); mm &= mm - 1; const int pos = jb * 64 + lane;
                s[i] = (pos <= t) ? dot64(qh, kslc + (size_t)pos * 64) * (1.f / 1.4426950408889634f) : -1e30f; mx = fmaxf(mx, s[i]); }
            mx = wave_max(mx); float l = 0.f; mm = selmask;
#pragma unroll
            for (int i = 0; i < 16; ++i) { const int jb = __builtin_ctzll(mm); mm &= mm - 1; const int pos = jb * 64 + lane; s[i] = (pos <= t) ? __expf(s[i] - mx) : 0.f; l += s[i]; }
            l = wave_sum(l); const float il = 1.f / l;
#pragma unroll
            for (int i = 0; i < 16; ++i) pb[i * 64 + lane] = s[i] * il;
            WAVE_FENCE();
            float os = 0.f; mm = selmask;
            for (int i = 0; i < 16; ++i) { const int jb = __builtin_ctzll(mm); mm &= mm - 1; if (jb * 64 > t) continue;
                const bf16* vb = vslc + (size_t)jb * 64 * 64 + lane;
                for (int k = 0; k < 64; ++k) os += pb[i * 64 + k] * bf2f(vb[k * 64]); }
            WAVE_FENCE();
            float sw[8]; mx = -1e30f;
#pragma unroll
            for (int i = 0; i < 8; ++i) { const int pos = t - 511 + lane + 64 * i; sw[i] = (pos >= 0) ? dot64(qh, kwin + (size_t)pos * 64) * (1.f / 1.4426950408889634f) : -1e30f; mx = fmaxf(mx, sw[i]); }
            mx = wave_max(mx); l = 0.f;
#pragma unroll
            for (int i = 0; i < 8; ++i) { const int pos = t - 511 + lane + 64 * i; sw[i] = (pos >= 0) ? __expf(sw[i] - mx) : 0.f; l += sw[i]; }
            l = wave_sum(l); const float ilw = 1.f / l;
#pragma unroll
            for (int i = 0; i < 8; ++i) pb[i * 64 + lane] = sw[i] * ilw;
            WAVE_FENCE();
            float ow = 0.f;
            { const int p0 = t - 511; for (int k = (p0 < 0 ? -p0 : 0); k < 512; ++k) ow += pb[k] * bf2f(vwin[(size_t)(p0 + k) * 64 + lane]); }
            WAVE_FENCE();
            const float* gt = GT + (size_t)tok * 24 + g * 12 + hg * 3;
            const float o = gt[0] * ocb[hg * 64 + lane] + gt[1] * os + gt[2] * ow;
            CAT[(size_t)tok * 1024 + g * 256 + hg * 64 + lane] = (bf16)f2bf(o);
        }
        WAVE_FENCE();
    }
}


#ifndef NSA_MODE
#define NSA_MODE 1
#endif
constexpr int NSA_KB = 0, NSA_VB = 16384, NSA_IMP = 32768, NSA_IST = 66, NSA_SEL = NSA_IMP + 4 * 64 * NSA_IST * 4;
constexpr float LOG2E = 1.0f;

__device__ __forceinline__ void nsa_load(const bf16* k, const bf16* vt, int vstride, int tid, u32x4& kr, u32x4& vr) {
    kr = *(const u32x4*)(k + tid * 8);
    vr = *(const u32x4*)(vt + (size_t)(tid >> 3) * vstride + (tid & 7) * 8);
}
__device__ __forceinline__ void nsa_store(LAS unsigned char* lds, int buf, int tid, const u32x4& kr, const u32x4& vr) {
    const int row = tid >> 3, ch = tid & 7, off = buf * 8192 + row * 128 + ((ch ^ (row & 7)) << 4);
    *(LAS u32x4*)(lds + NSA_KB + off) = kr; *(LAS u32x4*)(lds + NSA_VB + off) = vr;
}
__device__ __forceinline__ void nsa_qk(const LAS unsigned char* kb, const bf16x8 (&Qf)[4], const int (&koff)[4], f32x16& S0, f32x16& S1) {
#pragma unroll
    for (int r = 0; r < 16; ++r) { S0[r] = 0.f; S1[r] = 0.f; }
#pragma unroll
    for (int ks = 0; ks < 4; ++ks) { const bf16x8 k0 = *(const LAS bf16x8*)(kb + koff[ks]), k1 = *(const LAS bf16x8*)(kb + 4096 + koff[ks]);
        S0 = MFMA32(k0, Qf[ks], S0); S1 = MFMA32(k1, Qf[ks], S1); }
}
__device__ __forceinline__ void nsa_mask(f32x16& S0, f32x16& S1, int lo, int hi) {
#pragma unroll
    for (int r = 0; r < 16; ++r) { const int c = 16 * (r >> 3) + (r & 7);
        S0[r] = (c >= lo && c <= hi) ? S0[r] : -1e30f; S1[r] = (c + 32 >= lo && c + 32 <= hi) ? S1[r] : -1e30f; }
}
__device__ __forceinline__ float nsa_rowmax(const f32x16& S0, const f32x16& S1) {
    float mx = fmaxf(S0[0], S1[0]);
#pragma unroll
    for (int r = 1; r < 16; ++r) mx = fmaxf(mx, fmaxf(S0[r], S1[r]));
    return fmaxf(mx, __shfl_xor(mx, 32));
}
__device__ __forceinline__ void nsa_pv(const LAS unsigned char* vb, const f32x16& S0, const f32x16& S1, const int (&voff)[4], f32x16 (&O)[2]) {
#pragma unroll
    for (int s = 0; s < 4; ++s) { u32x4 w;
        if (s < 2) { w.x = pk2(S0[8 * (s & 1) + 0], S0[8 * (s & 1) + 1]); w.y = pk2(S0[8 * (s & 1) + 2], S0[8 * (s & 1) + 3]); w.z = pk2(S0[8 * (s & 1) + 4], S0[8 * (s & 1) + 5]); w.w = pk2(S0[8 * (s & 1) + 6], S0[8 * (s & 1) + 7]); }
        else       { w.x = pk2(S1[8 * (s & 1) + 0], S1[8 * (s & 1) + 1]); w.y = pk2(S1[8 * (s & 1) + 2], S1[8 * (s & 1) + 3]); w.z = pk2(S1[8 * (s & 1) + 4], S1[8 * (s & 1) + 5]); w.w = pk2(S1[8 * (s & 1) + 6], S1[8 * (s & 1) + 7]); }
        const bf16x8 Pf = __builtin_bit_cast(bf16x8, w);
#pragma unroll
        for (int mt = 0; mt < 2; ++mt) { const bf16x8 Vf = *(const LAS bf16x8*)(vb + mt * 4096 + voff[s]); O[mt] = MFMA32(Vf, Pf, O[mt]); } }
}
template <bool WITH_O>
__device__ __forceinline__ void nsa_online(f32x16& S0, f32x16& S1, float& m, float& l, f32x16 (&O)[2]) {
    const float mx = nsa_rowmax(S0, S1), mn = fmaxf(m, mx), alpha = __builtin_amdgcn_exp2f((m - mn) * LOG2E), mb = mn <= -1e29f ? 0.f : mn * LOG2E;
    float rs = 0.f;
#pragma unroll
    for (int r = 0; r < 16; ++r) { S0[r] = __builtin_amdgcn_exp2f(fmaf(S0[r], LOG2E, -mb)); S1[r] = __builtin_amdgcn_exp2f(fmaf(S1[r], LOG2E, -mb)); rs += S0[r] + S1[r]; }
    l = l * alpha + rs; m = mn;
    if (WITH_O) {
#pragma unroll
        for (int r = 0; r < 16; ++r) { O[0][r] *= alpha; O[1][r] *= alpha; } }
}

__device__ __forceinline__ void phase_nsa_fast(const Params& p, LAS unsigned char* lds, bf16* CATo, const unsigned long long* sel_in, unsigned long long* sel_out) {
    const int tid = tid_fresh(), lane = tid & 63, wave = __builtin_amdgcn_readfirstlane(tid >> 6);
    const int hg = wave & 3, th = wave >> 2, q = lane & 31, h = lane >> 5;
    unsigned char* ws = p.ws;
    const bf16* Q = (const bf16*)(ws + WS_Q); const bf16* KV = (const bf16*)(ws + WS_KV); const float* GT = (const float*)(ws + WS_GATES);
    const bf16* KC = (const bf16*)(ws + WS_KC); const bf16* VCT = (const bf16*)(ws + WS_VCT); const bf16* VT = (const bf16*)(ws + WS_VT);
    const size_t kvs = (size_t)4 * 2 * 4096 * 64;
    LAS float* imp = (LAS float*)(lds + NSA_IMP);
    LAS unsigned long long* sel = (LAS unsigned long long*)(lds + NSA_SEL);
    int koff[4], voff[4];
    { const int pr = (q & ~12) | ((q & 4) << 1) | ((q & 8) >> 1);
      const int hxk = h ^ (pr & 7), hxv = h ^ (q & 7);
#pragma unroll
      for (int s = 0; s < 4; ++s) { koff[s] = pr * 128 + (((2 * s) ^ hxk) << 4); voff[s] = q * 128 + (((2 * s) ^ hxv) << 4); } }
    for (int u = blockIdx.x; u < 256; u += gridDim.x) {
        const int bg = u & 7, pair = u >> 3, b = bg >> 1, g = bg & 1;
#ifndef NSA_HALVES
#define NSA_HALVES 2
#endif
        for (int half = 0; half < NSA_HALVES; ++half) {
            const int qt = (half & 1) ? pair : 63 - pair, t0 = qt * 64, tl = 32 * th + q, t = t0 + tl, tok = b * 4096 + t;
            bf16x8 Qf[4];
#pragma unroll
            for (int ks = 0; ks < 4; ++ks) { const u32x4 w = *(const u32x4*)(Q + (size_t)tok * 512 + g * 256 + hg * 64 + 16 * ks + 8 * h); u32x4 o;
                Qf[ks] = __builtin_bit_cast(bf16x8, w); }
            const float g0 = GT[(size_t)tok * 24 + g * 12 + hg * 3 + 0], g1 = GT[(size_t)tok * 24 + g * 12 + hg * 3 + 1], g2 = GT[(size_t)tok * 24 + g * 12 + hg * 3 + 2];
            if (tid == 0) sel[64] = 0ull;
            f32x16 OA[2], O[2], S0, S1; u32x4 kr, vr;
            const int nvis = t >= 31 ? (t - 31) / 16 + 1 : 0, ntc = (4 * qt + 3 + 63) >> 6;
            const bf16* kcb = KC + (size_t)bg * 256 * 64; const bf16* vcb = VCT + (size_t)bg * 64 * 256;
            float mc = -1e30f, lc = 0.f;
            nsa_load(kcb, vcb, 256, tid, kr, vr); nsa_store(lds, 0, tid, kr, vr); __syncthreads();
            for (int ct = 0; ct < ntc; ++ct) { const int buf = ct & 1;
                if (ct + 1 < ntc) nsa_load(kcb + (size_t)(ct + 1) * 64 * 64, vcb + (ct + 1) * 64, 256, tid, kr, vr);
                nsa_qk(lds + NSA_KB + buf * 8192, Qf, koff, S0, S1); nsa_mask(S0, S1, -1000, nvis - 64 * ct - 1 - 8 * h);
                nsa_online<false>(S0, S1, mc, lc, O);
                if (ct + 1 < ntc) nsa_store(lds, buf ^ 1, tid, kr, vr);
                __syncthreads(); }
            { const float lt = lc + __shfl_xor(lc, 32), il = lt > 0.f ? 1.f / lt : 0.f, mb = mc <= -1e29f ? 0.f : mc * LOG2E;
#pragma unroll
              for (int r = 0; r < 16; ++r) { O[0][r] = 0.f; O[1][r] = 0.f; }
              float carry_prev = 0.f;
              nsa_load(kcb, vcb, 256, tid, kr, vr); nsa_store(lds, 0, tid, kr, vr); __syncthreads();
              for (int ct = 0; ct < ntc; ++ct) { const int buf = ct & 1;
                if (ct + 1 < ntc) nsa_load(kcb + (size_t)(ct + 1) * 64 * 64, vcb + (ct + 1) * 64, 256, tid, kr, vr);
                nsa_qk(lds + NSA_KB + buf * 8192, Qf, koff, S0, S1); nsa_mask(S0, S1, -1000, nvis - 64 * ct - 1 - 8 * h);
#pragma unroll
                for (int r = 0; r < 16; ++r) { S0[r] = __builtin_amdgcn_exp2f(fmaf(S0[r], LOG2E, -mb)) * il; S1[r] = __builtin_amdgcn_exp2f(fmaf(S1[r], LOG2E, -mb)) * il; }
                LAS float* row = imp + (hg * 64 + tl) * NSA_IST + 16 * ct + 2 * h;
#pragma unroll
                for (int sx = 0; sx < 4; ++sx) { const int x8 = 8 * (sx & 1);
                    float p0, p1, p2, p3, p4, p5, p6, p7;
                    if (sx < 2) { p0 = S0[x8]; p1 = S0[x8 + 1]; p2 = S0[x8 + 2]; p3 = S0[x8 + 3]; p4 = S0[x8 + 4]; p5 = S0[x8 + 5]; p6 = S0[x8 + 6]; p7 = S0[x8 + 7]; }
                    else        { p0 = S1[x8]; p1 = S1[x8 + 1]; p2 = S1[x8 + 2]; p3 = S1[x8 + 3]; p4 = S1[x8 + 4]; p5 = S1[x8 + 5]; p6 = S1[x8 + 6]; p7 = S1[x8 + 7]; }
                    const float recv = __shfl_xor(p7, 32), cin = h ? recv : carry_prev; carry_prev = recv;
                    const float a0 = (((cin + p0) + p1) + p2) + p3, a1 = (((p3 + p4) + p5) + p6) + p7;
                    *(LAS f32x2*)(row + 4 * sx) = (f32x2){a0, a1}; }
                nsa_pv(lds + NSA_VB + buf * 8192, S0, S1, voff, O);
                if (ct + 1 < ntc) nsa_store(lds, buf ^ 1, tid, kr, vr);
                __syncthreads(); }
#pragma unroll
              for (int r = 0; r < 16; ++r) { OA[0][r] = g0 * O[0][r]; OA[1][r] = g0 * O[1][r]; } }
            { unsigned long long orm = 0ull;
              for (int i = 0; i < 8; ++i) { const int tk = wave * 8 + i; unsigned long long msk;
                if (sel_in) msk = sel_in[(size_t)(b * 4096 + t0 + tk) * 2 + g];
                else { const LAS float* sl = imp + tk * NSA_IST + lane;
                    const float im = ((sl[0] + sl[64 * NSA_IST]) + sl[2 * 64 * NSA_IST]) + sl[3 * 64 * NSA_IST];
                    const bool valid = lane <= qt, forced = (lane == 0) || (lane == qt) || (lane == qt - 1);
                    const float score = valid ? im + (forced ? 1e6f : 0.f) : -1e9f; int rank = 0;
#pragma unroll
                    for (int j = 0; j < 64; ++j) { const float sj = __builtin_bit_cast(float, __builtin_amdgcn_readlane(__builtin_bit_cast(int, score), j)); rank += (sj > score || (sj == score && j < lane)) ? 1 : 0; }
                    msk = __ballot(rank < 16); }
                if (lane == 0) { sel[tk] = msk; if (sel_out) sel_out[(size_t)(b * 4096 + t0 + tk) * 2 + g] = msk; }
                orm |= msk; }
              if (lane == 0) __hip_atomic_fetch_or(sel + 64, orm, __ATOMIC_RELAXED, __HIP_MEMORY_SCOPE_WORKGROUP); }
            __syncthreads();
            const unsigned long long mysel = sel[tl];
            const unsigned long long orall = sel[64];
            const unsigned olo = __builtin_amdgcn_readfirstlane((unsigned)orall), ohi = __builtin_amdgcn_readfirstlane((unsigned)(orall >> 32));
            { unsigned long long rem = (((unsigned long long)ohi << 32) | olo) & (qt == 63 ? ~0ull : ((2ull << qt) - 1ull));
              const bf16* kb = KV + 2 * kvs + (size_t)bg * 4096 * 64; const bf16* vb = VT + (size_t)bg * 64 * 4096;
              float m = -1e30f, l = 0.f;
#pragma unroll
              for (int r = 0; r < 16; ++r) { O[0][r] = 0.f; O[1][r] = 0.f; }
              int j = __builtin_ctzll(rem); rem &= rem - 1; int buf = 0;
              nsa_load(kb + (size_t)j * 64 * 64, vb + j * 64, 4096, tid, kr, vr); nsa_store(lds, 0, tid, kr, vr); __syncthreads();
              for (;;) { const bool more = rem != 0ull; int jn = 0;
                if (more) { jn = __builtin_ctzll(rem); rem &= rem - 1; nsa_load(kb + (size_t)jn * 64 * 64, vb + jn * 64, 4096, tid, kr, vr); }
                nsa_qk(lds + NSA_KB + buf * 8192, Qf, koff, S0, S1);
                const bool rv = (mysel >> j) & 1ull;
                if (j == qt || __ballot(rv) != ~0ull) nsa_mask(S0, S1, -1000, rv ? (j == qt ? tl - 8 * h : 1000) : -2000);
                nsa_online<true>(S0, S1, m, l, O);
                nsa_pv(lds + NSA_VB + buf * 8192, S0, S1, voff, O);
                if (more) nsa_store(lds, buf ^ 1, tid, kr, vr);
                __syncthreads();
                if (!more) break; j = jn; buf ^= 1; }
              const float lt = l + __shfl_xor(l, 32), sc = g1 / lt;
#pragma unroll
              for (int r = 0; r < 16; ++r) { OA[0][r] += sc * O[0][r]; OA[1][r] += sc * O[1][r]; } }
            { const bf16* kb = KV + 4 * kvs + (size_t)bg * 4096 * 64; const bf16* vb = VT + (size_t)(8 + bg) * 64 * 4096;
              float m = -1e30f, l = 0.f;
#pragma unroll
              for (int r = 0; r < 16; ++r) { O[0][r] = 0.f; O[1][r] = 0.f; }
              const int j0 = qt > 8 ? qt - 8 : 0;
              nsa_load(kb + (size_t)j0 * 64 * 64, vb + j0 * 64, 4096, tid, kr, vr); nsa_store(lds, 0, tid, kr, vr); __syncthreads();
              for (int j = j0; j <= qt; ++j) { const int buf = (j - j0) & 1;
                if (j < qt) nsa_load(kb + (size_t)(j + 1) * 64 * 64, vb + (j + 1) * 64, 4096, tid, kr, vr);
                nsa_qk(lds + NSA_KB + buf * 8192, Qf, koff, S0, S1);
                if (j == qt || j == qt - 8) nsa_mask(S0, S1, j == qt - 8 ? tl + 1 - 8 * h : -1000, j == qt ? tl - 8 * h : 1000);
                nsa_online<true>(S0, S1, m, l, O);
                nsa_pv(lds + NSA_VB + buf * 8192, S0, S1, voff, O);
                if (j < qt) nsa_store(lds, buf ^ 1, tid, kr, vr);
                __syncthreads(); }
              const float lt = l + __shfl_xor(l, 32), sc = g2 / lt;
#pragma unroll
              for (int r = 0; r < 16; ++r) { OA[0][r] += sc * O[0][r]; OA[1][r] += sc * O[1][r]; } }
            { bf16* orow = CATo + (size_t)tok * 1024 + g * 256 + hg * 64 + 4 * h;
#pragma unroll
              for (int mt = 0; mt < 2; ++mt)
#pragma unroll
                for (int r4 = 0; r4 < 4; ++r4) { u32x2 w; w.x = pk2(OA[mt][4 * r4], OA[mt][4 * r4 + 1]); w.y = pk2(OA[mt][4 * r4 + 2], OA[mt][4 * r4 + 3]); *(u32x2*)(orow + 32 * mt + 8 * r4) = w; } }
        }
    }
}

namespace n3 {
constexpr int SLOTB = 8192, NSLOT = 3;
constexpr int L_K = 0, L_V = NSLOT * SLOTB, L_WS = 2 * NSLOT * SLOTB  , L_ACC = L_WS + 2048  ;
constexpr int ACCP = 65, L_SEL = L_ACC + 67584  , L_TL = L_SEL + 528  , L_END = L_TL + 160;
static_assert(L_END <= LDS_MISC, "NSA LDS map");
typedef short s16x4 __attribute__((ext_vector_type(4)));
typedef short v4i16_t __attribute__((ext_vector_type(4)));
typedef LAS const char* lds_cptr;
__device__ __forceinline__ int crow(int r, int hi) { return (r & 3) + 8 * (r >> 2) + 4 * hi; }
__device__ __forceinline__ void glds16(const void* gsrc, unsigned lds_dst) { unsigned keep;
    asm volatile("s_mov_b32 %0, m0\n\ts_mov_b32 m0, %2\n\ts_nop 0\n\tglobal_load_lds_dwordx4 %1, off\n\ts_mov_b32 m0, %0" : "=&s"(keep) : "v"(gsrc), "s"(lds_dst) : "memory"); }
__device__ __forceinline__ float fadd_s(float a, float b) { float r; asm("v_add_f32_e32 %0, %1, %2" : "=v"(r) : "v"(a), "v"(b)); return r; }
__device__ __forceinline__ float fsub_s(float a, float b) { float r; asm("v_sub_f32_e32 %0, %1, %2" : "=v"(r) : "v"(a), "v"(b)); return r; }
__device__ __forceinline__ void kload8(bf16x8* kf, lds_cptr kp) {
    kf[0] = *(const LAS bf16x8*)(kp);        kf[1] = *(const LAS bf16x8*)(kp + 512);  kf[2] = *(const LAS bf16x8*)(kp + 2048); kf[3] = *(const LAS bf16x8*)(kp + 2560);
    kf[4] = *(const LAS bf16x8*)(kp + 4096); kf[5] = *(const LAS bf16x8*)(kp + 4608); kf[6] = *(const LAS bf16x8*)(kp + 6144); kf[7] = *(const LAS bf16x8*)(kp + 6656); }
__device__ __forceinline__ void kload2(bf16x8* kf, lds_cptr kp, int j) { kf[2 * j] = *(const LAS bf16x8*)(kp + j * 2048); kf[2 * j + 1] = *(const LAS bf16x8*)(kp + j * 2048 + 512); }
__device__ __forceinline__ s16x4 vtr(lds_cptr p) { return __builtin_bit_cast(s16x4, __builtin_amdgcn_ds_read_tr16_b64_v4i16((LAS v4i16_t*)p)); }
#define N3_SBAR() __builtin_amdgcn_sched_barrier(0)
#define N3_WAIT_BAR(N) asm volatile("s_waitcnt vmcnt(" #N ") lgkmcnt(0)\n\ts_barrier" ::: "memory")
__device__ __forceinline__ void kmask(f32x16& p0, f32x16& p1, int lo, int hi_) {
#pragma unroll
    for (int r = 0; r < 16; ++r) { const int kv = (r & 3) + 8 * (r >> 2); if (kv < lo || kv > hi_) p0[r] = -INFINITY; if (kv + 32 < lo || kv + 32 > hi_) p1[r] = -INFINITY; }
}
__device__ __forceinline__ void prefetch0(LAS unsigned char* lds, const bf16* Kh, const bf16* Vh) {
    const int tid = tid_fresh(), lane = tid & 63; const int wid = __builtin_amdgcn_readfirstlane(tid >> 6); const unsigned lds0 = (unsigned)(size_t)lds;
    glds16(Kh + (size_t)lane * 64 + wid * 8, (unsigned)__builtin_amdgcn_readfirstlane(lds0 + L_K + wid * 1024));
    glds16(Vh + (size_t)(16 * (wid & 3) + (lane >> 2)) * 64 + (wid >> 2) * 32 + (lane & 3) * 8, (unsigned)__builtin_amdgcn_readfirstlane(lds0 + L_V + wid * 1024));
}
template <int MODE, bool PRE = false>
__device__ __forceinline__ void stream(LAS unsigned char* lds, const bf16x8 (&qr)[4], const bf16* Kh, const bf16* Vh, unsigned long long tmask, int NT, int qt, int tl, unsigned long long mysel, float gate) {
    constexpr int THRL = 8;
    const int tid = tid_fresh(), lane = tid & 63, r32 = lane & 31, hi = lane >> 5; const int wid = __builtin_amdgcn_readfirstlane(tid >> 6);
    const unsigned lds0 = (unsigned)(size_t)lds;
    LAS float* wsf = (LAS float*)(lds + L_WS) + wid * 64;
    LAS float* acc = (LAS float*)(lds + L_ACC) + wid * 32 * ACCP;
    const bf16* ksrc = Kh + (size_t)lane * 64 + wid * 8;
    const bf16* vsrc = Vh + (size_t)(16 * (wid & 3) + (lane >> 2)) * 64 + (wid >> 2) * 32 + (lane & 3) * 8;
    const unsigned kdst = lds0 + L_K + wid * 1024, vdst = lds0 + L_V + wid * 1024;
    unsigned long long it = tmask; int q0, q1, q2, q3 = 0;
#define N3_NEXT(Q) do { if (it != 0ull) { Q = __builtin_ctzll(it); it &= it - 1ull; } else Q = 128 | qt; } while (0)
#define N3_DMA_K(Q, slot) do { glds16(ksrc + (size_t)((Q) & 63) * 4096, (unsigned)__builtin_amdgcn_readfirstlane(kdst + (slot))); } while (0)
#define N3_DMA_V(Q, slot) do { glds16(vsrc + (size_t)((Q) & 63) * 4096, (unsigned)__builtin_amdgcn_readfirstlane(vdst + (slot))); } while (0)
    bf16x8 kf[8];
    const lds_cptr shm3 = (lds_cptr)lds; const lds_cptr kp0 = shm3 + L_K + hi * 1024 + r32 * 16; const lds_cptr vp0 = shm3 + L_V + ((lane >> 4) & 1) * 32 + (lane & 3) * 8 + (4 * hi + ((lane & 15) >> 2)) * 64;
    N3_NEXT(q0); N3_NEXT(q1); N3_NEXT(q2);
    if (!PRE) { N3_DMA_K(q0, 0); N3_DMA_V(q0, 0); }
    N3_DMA_K(q1, SLOTB);
    float mhat = 0.f, l_reg = 0.f; f32x16 o[2];
#pragma unroll
    for (int r = 0; r < 16; ++r) { o[0][r] = 0.f; o[1][r] = 0.f; }
    f32x16 negm;
    { float z_; asm volatile("v_mov_b32 %0, 0" : "=v"(z_));
#pragma unroll
      for (int r = 0; r < 16; ++r) negm[r] = z_; }
    asm volatile("" : "+v"(negm));
    unsigned fprev = 0xffffffffu, fnew = 0xffffffffu;
#define N3_MASK(P0, P1, Q) do { const int jt_ = (Q); const int j_ = jt_ & 63; \
        if (MODE == 1) { fnew = ((((mysel >> j_) & 1ull) != 0ull) && !(jt_ & 128)) ? 0xffffffffu : 0u; if (jt_ == qt) kmask(P0, P1, -4 * hi, tl - 4 * hi); } \
        else { if ((qt >= 8 && j_ == qt - 8) || j_ == qt || (jt_ & 128)) { int lo_ = 0, hi__ = 63; if (qt >= 8 && j_ == qt - 8) lo_ = tl + 1; if (j_ == qt) hi__ = tl; if (jt_ & 128) hi__ = -1; \
                 kmask(P0, P1, lo_ - 4 * hi, hi__ - 4 * hi); } } } while (0)
    bool resc = false;
#define N3_RESC() do { if (resc) { asm volatile("s_waitcnt lgkmcnt(0)" ::: "memory"); \
        _Pragma("unroll") for (int d_ = 0; d_ < 2; ++d_) _Pragma("unroll") for (int r = 0; r < 16; ++r) o[d_][r] *= wsf[crow(r, hi)]; } } while (0)
    f32x16 pA0, pA1, pB0, pB1;
    int sl_prev = 0, sl_cur = 0, sl_next = SLOTB;
#define N3_ROT() do { sl_prev = sl_cur; sl_cur = sl_next; sl_next = (sl_next == (NSLOT - 1) * SLOTB) ? 0 : sl_next + SLOTB; } while (0)
    N3_DMA_K(q2, 2 * SLOTB);
    N3_WAIT_BAR(3);
    { const lds_cptr kb = kp0;
#pragma unroll
      for (int d0 = 0; d0 < 4; ++d0) { const bf16x8 b0 = *(const LAS bf16x8*)(kb + d0 * 2048), b1 = *(const LAS bf16x8*)(kb + d0 * 2048 + 512);
          if (d0 == 0) { pA0 = MFMA32(b0, qr[0], negm); pA1 = MFMA32(b1, qr[0], negm); } else { pA0 = MFMA32(b0, qr[d0], pA0); pA1 = MFMA32(b1, qr[d0], pA1); } } }
    asm volatile("s_nop 15\n\ts_nop 7" : "+v"(pA0), "+v"(pA1));
    N3_MASK(pA0, pA1, q0);
    { float rm = fmaxf(pA0[0], pA1[0]);
#pragma unroll
      for (int r = 1; r < 16; ++r) rm = fmaxf(rm, fmaxf(pA0[r], pA1[r]));
      { auto rr = __builtin_amdgcn_permlane32_swap(__float_as_uint(rm), __float_as_uint(rm), false, false); rm = fmaxf(__uint_as_float(rr[0]), __uint_as_float(rr[1])); }
      if (MODE == 1) { rm = fnew ? rm : -INFINITY; fprev = fnew; }
      const float dl = rm > -3e38f ? rm : 0.f; mhat = fadd_s(mhat, dl);
#pragma unroll
      for (int r = 0; r < 16; ++r) { pA0[r] = fsub_s(pA0[r], dl); pA1[r] = fsub_s(pA1[r], dl); }
#pragma unroll
      for (int r = 0; r < 16; ++r) negm[r] = -mhat;
      asm volatile("" : "+v"(negm));
#pragma unroll
      for (int r = 0; r < 16; ++r) { pA0[r] = __builtin_amdgcn_exp2f(pA0[r]); pA1[r] = __builtin_amdgcn_exp2f(pA1[r]); } }
    N3_WAIT_BAR(0);
    N3_NEXT(q3);
    if (3 < NT) N3_DMA_K(q3, 0);
    N3_DMA_V(q1, SLOTB);
    q0 = q1; q1 = q2; q2 = q3;
    N3_ROT();
    kload8(kf, kp0 + sl_cur);
    if (3 < NT) N3_WAIT_BAR(2); else N3_WAIT_BAR(1);
    s16x4 vlo[8], vhi[8]; u32x4 pw0, pw1, pw2, pw3;
#define N3_PKW(P, B) (MODE == 1 ? (pk2(P[B], P[B + 1]) & fprev) : pk2(P[B], P[B + 1]))
#define N3_PAF(k) __builtin_bit_cast(bf16x8, pw##k)
#define N3_VFR(i) (bf16x8){vlo[i][0], vlo[i][1], vlo[i][2], vlo[i][3], vhi[i][0], vhi[i][1], vhi[i][2], vhi[i][3]}
#define N3_PIN(x) asm volatile("" : "+v"(x))
#define N3_MX3(a, b, c) __builtin_fmaxf(__builtin_fmaxf((a), (b)), (c))
#define N3_GAPA(MF, A0, A1, A2, A3, W0, W1, PW) do { MF; sacc += A0; sacc += A1; sacc += A2; sacc += A3; N3_PIN(sacc); W0; W1; N3_PIN(PW); N3_SBAR(); } while (0)
#define N3_EX(v) __builtin_amdgcn_exp2f(v)
#define N3_GAPB(MF, X, B) do { MF; X[B] = N3_EX(X[B]); X[B + 1] = N3_EX(X[B + 1]); X[B + 2] = N3_EX(X[B + 2]); X[B + 3] = N3_EX(X[B + 3]); N3_PIN(X); N3_SBAR(); } while (0)
#define N3_VRD(i) do { vlo[i] = vtr(vp_ + (((i) >> 2) * 4096 + ((i) & 3) * 1024)); vhi[i] = vtr(vp_ + (((i) >> 2) * 4096 + ((i) & 3) * 1024 + 512)); } while (0)
#define N3_KRD(G, j) do { if (G) { kload2(kf, kp0 + sl_next, j); N3_SBAR(); } } while (0)
#define N3_STEP(C0, C1, P0, P1, t, GK, GV, GL) do { N3_SBAR(); \
    const lds_cptr vp_ = vp0 + sl_prev; \
    N3_VRD(0); N3_SBAR(); float sacc = (P0[0] + P0[1]); \
    N3_GAPA(C0 = MFMA32(kf[0], qr[0], negm), P0[2], P0[3], P0[4], P0[5],     pw0[0] = N3_PKW(P0, 0), pw0[1] = N3_PKW(P0, 2), pw0); \
    N3_VRD(4); N3_SBAR(); N3_GAPA(C1 = MFMA32(kf[1], qr[0], negm), P0[6], P0[7], P0[8], P0[9],     pw0[2] = N3_PKW(P0, 4), pw0[3] = N3_PKW(P0, 6), pw0); \
    N3_VRD(1); N3_SBAR(); N3_GAPA(C0 = MFMA32(kf[2], qr[1], C0),   P0[10], P0[11], P0[12], P0[13], pw1[0] = N3_PKW(P0, 8), pw1[1] = N3_PKW(P0, 10), pw1); \
    N3_VRD(5); N3_SBAR(); N3_GAPA(C1 = MFMA32(kf[3], qr[1], C1),   P0[14], P0[15], P1[0], P1[1],   pw1[2] = N3_PKW(P0, 12), pw1[3] = N3_PKW(P0, 14), pw1); \
    N3_VRD(2); N3_SBAR(); N3_GAPA(C0 = MFMA32(kf[4], qr[2], C0),   P1[2], P1[3], P1[4], P1[5],     pw2[0] = N3_PKW(P1, 0), pw2[1] = N3_PKW(P1, 2), pw2); \
    N3_VRD(6); N3_SBAR(); N3_GAPA(C1 = MFMA32(kf[5], qr[2], C1),   P1[6], P1[7], P1[8], P1[9],     pw2[2] = N3_PKW(P1, 4), pw2[3] = N3_PKW(P1, 6), pw2); \
    N3_VRD(3); N3_SBAR(); N3_GAPA(C0 = MFMA32(kf[6], qr[3], C0),   P1[10], P1[11], P1[12], P1[13], pw3[0] = N3_PKW(P1, 8), pw3[1] = N3_PKW(P1, 10), pw3); \
    N3_VRD(7); N3_SBAR(); N3_GAPA(C1 = MFMA32(kf[7], qr[3], C1),   P1[14], P1[15], 0.f, 0.f,       pw3[2] = N3_PKW(P1, 12), pw3[3] = N3_PKW(P1, 14), pw3); \
    l_reg += (MODE == 1 ? (fprev ? sacc : 0.f) : sacc); \
    N3_NEXT(q3); if (GK) { N3_DMA_K(q3, sl_cur); } if (GV) { N3_DMA_V(q1, sl_next); } \
    N3_MASK(C0, C1, q0); q0 = q1; q1 = q2; q2 = q3; \
    { float a = N3_MX3(C0[0], C0[1], C1[0]), b = N3_MX3(C0[2], C0[3], C1[1]); a = N3_MX3(a, C1[2], C1[3]); \
      _Pragma("unroll") for (int r = 4; r < 16; r += 4) { a = N3_MX3(a, C0[r], C0[r + 1]); b = N3_MX3(b, C0[r + 2], C0[r + 3]); a = N3_MX3(a, C1[r], C1[r + 1]); b = N3_MX3(b, C1[r + 2], C1[r + 3]); } \
      float rm = __builtin_fmaxf(a, b); { auto rr = __builtin_amdgcn_permlane32_swap(__float_as_uint(rm), __float_as_uint(rm), false, false); rm = __builtin_fmaxf(__uint_as_float(rr[0]), __uint_as_float(rr[1])); } \
      if (MODE == 1) { rm = fnew ? rm : -INFINITY; fprev = fnew; } \
      resc = false; \
      if (__builtin_expect(__any(rm > (float)THRL), 0)) { const float dl = __builtin_fmaxf(rm, 0.f); mhat += dl; \
        _Pragma("unroll") for (int r = 0; r < 16; ++r) { C0[r] -= dl; C1[r] -= dl; } \
        _Pragma("unroll") for (int r = 0; r < 16; ++r) negm[r] = -mhat; asm volatile("" : "+v"(negm)); \
        const float f = __builtin_amdgcn_exp2f(-dl); l_reg *= f; if (hi == 0) wsf[r32] = f; resc = true; } } \
    N3_SBAR(); \
    N3_GAPB(o[0] = MFMA32(N3_PAF(0), N3_VFR(0), o[0]), C0, 0); \
    N3_GAPB(o[1] = MFMA32(N3_PAF(0), N3_VFR(4), o[1]), C0, 4); \
    N3_KRD(GL, 0); N3_GAPB(o[0] = MFMA32(N3_PAF(1), N3_VFR(1), o[0]), C0, 8); \
    N3_KRD(GL, 1); N3_GAPB(o[1] = MFMA32(N3_PAF(1), N3_VFR(5), o[1]), C0, 12); \
    N3_KRD(GL, 2); N3_GAPB(o[0] = MFMA32(N3_PAF(2), N3_VFR(2), o[0]), C1, 0); \
    N3_KRD(GL, 3); N3_GAPB(o[1] = MFMA32(N3_PAF(2), N3_VFR(6), o[1]), C1, 4); \
    N3_GAPB(o[0] = MFMA32(N3_PAF(3), N3_VFR(3), o[0]), C1, 8); \
    N3_GAPB(o[1] = MFMA32(N3_PAF(3), N3_VFR(7), o[1]), C1, 12); \
    } while (0)
#define N3_ENDW(tt) do { if ((tt) + 3 < NT) { N3_WAIT_BAR(2); } else if ((tt) + 2 < NT) { N3_WAIT_BAR(1); } else { N3_WAIT_BAR(0); } } while (0)
    int t = 1;
    for (; t + 5 < NT; t += 2) {
        N3_STEP(pB0, pB1, pA0, pA1, t, true, true, true);     N3_WAIT_BAR(2); N3_RESC(); N3_ROT();
        N3_STEP(pA0, pA1, pB0, pB1, t + 1, true, true, true); N3_WAIT_BAR(2); N3_RESC(); N3_ROT();
    }
    for (; t + 1 < NT; t += 2) {
        N3_STEP(pB0, pB1, pA0, pA1, t, (t + 3 < NT), (t + 1 < NT), (t + 1 < NT));     N3_ENDW(t);     N3_RESC(); N3_ROT();
        N3_STEP(pA0, pA1, pB0, pB1, t + 1, (t + 4 < NT), (t + 2 < NT), (t + 2 < NT)); N3_ENDW(t + 1); N3_RESC(); N3_ROT();
    }
    N3_STEP(pB0, pB1, pA0, pA1, NT - 1, false, false, false); N3_RESC();
    { float sacc = pB0[0] + pB0[1];
#pragma unroll
      for (int r = 2; r < 16; ++r) sacc += pB0[r];
#pragma unroll
      for (int r = 0; r < 16; ++r) sacc += pB1[r];
      l_reg += (MODE == 1 ? (fprev ? sacc : 0.f) : sacc);
      pw0 = (u32x4){N3_PKW(pB0, 0), N3_PKW(pB0, 2), N3_PKW(pB0, 4), N3_PKW(pB0, 6)}; pw1 = (u32x4){N3_PKW(pB0, 8), N3_PKW(pB0, 10), N3_PKW(pB0, 12), N3_PKW(pB0, 14)};
      pw2 = (u32x4){N3_PKW(pB1, 0), N3_PKW(pB1, 2), N3_PKW(pB1, 4), N3_PKW(pB1, 6)}; pw3 = (u32x4){N3_PKW(pB1, 8), N3_PKW(pB1, 10), N3_PKW(pB1, 12), N3_PKW(pB1, 14)};
      N3_SBAR();
      const lds_cptr vp_ = vp0 + sl_cur;
#pragma unroll
      for (int i = 0; i < 8; ++i) N3_VRD(i);
      asm volatile("s_waitcnt lgkmcnt(0)" ::: "memory"); N3_SBAR();
      o[0] = MFMA32(N3_PAF(0), N3_VFR(0), o[0]); o[0] = MFMA32(N3_PAF(1), N3_VFR(1), o[0]); o[0] = MFMA32(N3_PAF(2), N3_VFR(2), o[0]); o[0] = MFMA32(N3_PAF(3), N3_VFR(3), o[0]);
      o[1] = MFMA32(N3_PAF(0), N3_VFR(4), o[1]); o[1] = MFMA32(N3_PAF(1), N3_VFR(5), o[1]); o[1] = MFMA32(N3_PAF(2), N3_VFR(6), o[1]); o[1] = MFMA32(N3_PAF(3), N3_VFR(7), o[1]); }
    { auto rr = __builtin_amdgcn_permlane32_swap(__float_as_uint(l_reg), __float_as_uint(l_reg), false, false); l_reg = __uint_as_float(rr[0]) + __uint_as_float(rr[1]); }
    if (hi == 0) wsf[32 + r32] = gate / l_reg;
    asm volatile("s_waitcnt lgkmcnt(0)" ::: "memory");
#pragma unroll
    for (int r = 0; r < 16; ++r) { const int row = crow(r, hi); const float f = wsf[32 + row];
#pragma unroll
        for (int d0 = 0; d0 < 2; ++d0) { LAS float* a = acc + row * ACCP + d0 * 32 + r32; *a = *a + o[d0][r] * f; } }
    asm volatile("s_waitcnt lgkmcnt(0)\n\ts_barrier" ::: "memory");
#undef N3_NEXT
#undef N3_DMA_K
#undef N3_DMA_V
#undef N3_MASK
#undef N3_RESC
#undef N3_ROT
#undef N3_PKW
#undef N3_PAF
#undef N3_VFR
#undef N3_PIN
#undef N3_MX3
#undef N3_GAPA
#undef N3_EX
#undef N3_GAPB
#undef N3_VRD
#undef N3_KRD
#undef N3_STEP
#undef N3_ENDW
}
}

__device__ __forceinline__ void phase_nsa3(const Params& p, LAS unsigned char* lds, bf16* CATo, const unsigned long long* sel_in, unsigned long long* sel_out) {
    unsigned char* ws = p.ws;
    const bf16* Q = (const bf16*)(ws + WS_Q); const bf16* KV = (const bf16*)(ws + WS_KV); const float* GT = (const float*)(ws + WS_GATES);
    const bf16* KC = (const bf16*)(ws + WS_KC); const bf16* VCT = (const bf16*)(ws + WS_VCT);
    const size_t kvs = (size_t)4 * 2 * 4096 * 64;
    LAS float* imp = (LAS float*)(lds + n3::L_ACC);
    LAS unsigned long long* sel = (LAS unsigned long long*)(lds + n3::L_SEL);
    for (int u = blockIdx.x; u < 256; u += gridDim.x) {
        const int bg = u & 7, pair = u >> 3, b = bg >> 1, g = bg & 1;
        for (int half = 0; half < NSA_HALVES; ++half) {
            const int tid = tid_fresh(), lane = tid & 63, wave = __builtin_amdgcn_readfirstlane(tid >> 6);
            const int hg = wave & 3, th = wave >> 2, q = lane & 31, h = lane >> 5;
            int koff[4], voff[4];
            { const int pr = (q & ~12) | ((q & 4) << 1) | ((q & 8) >> 1); const int hxk = h ^ (pr & 7), hxv = h ^ (q & 7);
#pragma unroll
              for (int s = 0; s < 4; ++s) { koff[s] = pr * 128 + (((2 * s) ^ hxk) << 4); voff[s] = q * 128 + (((2 * s) ^ hxv) << 4); } }
            const int qt = (half & 1) ? pair : 63 - pair, t0 = qt * 64, tl = 32 * th + q, t = t0 + tl, tok = b * 4096 + t;
            bf16x8 Qf[4];
#pragma unroll
            for (int ks = 0; ks < 4; ++ks) Qf[ks] = *(const bf16x8*)(Q + (size_t)tok * 512 + g * 256 + hg * 64 + 16 * ks + 8 * h);
            const float g0 = GT[(size_t)tok * 24 + g * 12 + hg * 3 + 0], g1 = GT[(size_t)tok * 24 + g * 12 + hg * 3 + 1], g2 = GT[(size_t)tok * 24 + g * 12 + hg * 3 + 2];
            if (tid == 0) sel[64] = 0ull;
            f32x16 O[2], S0, S1; u32x4 kr, vr;
            const int nvis = t >= 31 ? (t - 31) / 16 + 1 : 0, ntc = (4 * qt + 3 + 63) >> 6;
            const bf16* kcb = KC + (size_t)bg * 256 * 64; const bf16* vcb = VCT + (size_t)bg * 64 * 256;
            float mc = -1e30f, lc = 0.f;
            nsa_load(kcb, vcb, 256, tid, kr, vr); nsa_store(lds, 0, tid, kr, vr); __syncthreads();
            for (int ct = 0; ct < ntc; ++ct) { const int buf = ct & 1;
                if (ct + 1 < ntc) nsa_load(kcb + (size_t)(ct + 1) * 64 * 64, vcb + (ct + 1) * 64, 256, tid, kr, vr);
                else nsa_load(kcb, vcb, 256, tid, kr, vr);
                nsa_qk(lds + NSA_KB + buf * 8192, Qf, koff, S0, S1); nsa_mask(S0, S1, -1000, nvis - 64 * ct - 1 - 8 * h);
                nsa_online<false>(S0, S1, mc, lc, O);
                nsa_store(lds, buf ^ 1, tid, kr, vr);
                __syncthreads(); }
            { const float lt = lc + __shfl_xor(lc, 32), il = lt > 0.f ? 1.f / lt : 0.f, mb = mc <= -1e29f ? 0.f : mc;
#pragma unroll
              for (int r = 0; r < 16; ++r) { O[0][r] = 0.f; O[1][r] = 0.f; }
              float carry_prev = 0.f;
              for (int ct = 0; ct < ntc; ++ct) { const int buf = (ntc + ct) & 1;
                if (ct + 1 < ntc) nsa_load(kcb + (size_t)(ct + 1) * 64 * 64, vcb + (ct + 1) * 64, 256, tid, kr, vr);
                nsa_qk(lds + NSA_KB + buf * 8192, Qf, koff, S0, S1); nsa_mask(S0, S1, -1000, nvis - 64 * ct - 1 - 8 * h);
#pragma unroll
                for (int r = 0; r < 16; ++r) { S0[r] = __builtin_amdgcn_exp2f(S0[r] - mb) * il; S1[r] = __builtin_amdgcn_exp2f(S1[r] - mb) * il; }
                LAS float* row = imp + (hg * 64 + tl) * NSA_IST + 16 * ct + 2 * h;
#pragma unroll
                for (int sx = 0; sx < 4; ++sx) { const int x8 = 8 * (sx & 1);
                    float p0, p1, p2, p3, p4, p5, p6, p7;
                    if (sx < 2) { p0 = S0[x8]; p1 = S0[x8 + 1]; p2 = S0[x8 + 2]; p3 = S0[x8 + 3]; p4 = S0[x8 + 4]; p5 = S0[x8 + 5]; p6 = S0[x8 + 6]; p7 = S0[x8 + 7]; }
                    else        { p0 = S1[x8]; p1 = S1[x8 + 1]; p2 = S1[x8 + 2]; p3 = S1[x8 + 3]; p4 = S1[x8 + 4]; p5 = S1[x8 + 5]; p6 = S1[x8 + 6]; p7 = S1[x8 + 7]; }
                    const float recv = __shfl_xor(p7, 32), cin = h ? recv : carry_prev; carry_prev = recv;
                    const float a0 = (((cin + p0) + p1) + p2) + p3, a1 = (((p3 + p4) + p5) + p6) + p7;
                    *(LAS f32x2*)(row + 4 * sx) = (f32x2){a0, a1}; }
                nsa_pv(lds + NSA_VB + buf * 8192, S0, S1, voff, O);
                if (ct + 1 < ntc) nsa_store(lds, buf ^ 1, tid, kr, vr);
                __syncthreads(); } }
            n3::prefetch0(lds, KV + 2 * kvs + (size_t)bg * 4096 * 64, KV + 3 * kvs + (size_t)bg * 4096 * 64);
            { unsigned long long orm = 0ull;
              for (int i = 0; i < 8; ++i) { const int tk = wave * 8 + i; unsigned long long msk;
                if (sel_in) msk = sel_in[(size_t)(b * 4096 + t0 + tk) * 2 + g];
                else { const LAS float* sl = imp + tk * NSA_IST + lane;
                    const float im = ((sl[0] + sl[64 * NSA_IST]) + sl[2 * 64 * NSA_IST]) + sl[3 * 64 * NSA_IST];
                    const bool valid = lane <= qt, forced = (lane == 0) || (lane == qt) || (lane == qt - 1);
                    const float score = valid ? im + (forced ? 1e6f : 0.f) : -1e9f;
                    const unsigned key = valid ? __float_as_uint(score) + 1u : 0u; unsigned pre = 0u;
#pragma unroll
                    for (int bit = 30; bit >= 0; --bit) { const unsigned cand = pre | (1u << bit); if (__builtin_popcountll(__ballot(key >= cand)) >= 16) pre = cand; }
                    const unsigned long long gt = __ballot(key > pre), eq = __ballot(key == pre); const int need = 16 - __builtin_popcountll(gt);
                    const int below = __builtin_amdgcn_mbcnt_hi((unsigned)(eq >> 32), __builtin_amdgcn_mbcnt_lo((unsigned)eq, 0u));
                    msk = __ballot(key > pre || (key == pre && below < need)); }
                if (lane == 0) { sel[tk] = msk; if (sel_out) sel_out[(size_t)(b * 4096 + t0 + tk) * 2 + g] = msk; }
                orm |= msk; }
              if (lane == 0) __hip_atomic_fetch_or(sel + 64, orm, __ATOMIC_RELAXED, __HIP_MEMORY_SCOPE_WORKGROUP); }
            __syncthreads();
            const unsigned long long mysel = sel[tl];
            unsigned long long oms, omw;
            { const unsigned long long o_ = sel[64] & (qt == 63 ? ~0ull : ((2ull << qt) - 1ull));
              oms = ((unsigned long long)(unsigned)__builtin_amdgcn_readfirstlane((int)(o_ >> 32)) << 32) | (unsigned)__builtin_amdgcn_readfirstlane((int)o_);
              const int jlo = qt > 8 ? qt - 8 : 0; omw = (qt == 63 ? ~0ull : ((2ull << qt) - 1ull)) & ~((1ull << jlo) - 1ull); }
            __syncthreads();
            { LAS float* acc = (LAS float*)(lds + n3::L_ACC) + wave * 32 * n3::ACCP + q * n3::ACCP + 4 * h;
#pragma unroll
              for (int mt = 0; mt < 2; ++mt)
#pragma unroll
                for (int r = 0; r < 16; ++r) acc[32 * mt + (r & 3) + 8 * (r >> 2)] = g0 * O[mt][r]; }
            const int NTs = (__builtin_popcountll(oms) + 1) & ~1, NTw = qt == 0 ? 2 : ((__builtin_popcountll(omw) + 1) & ~1);
            const bf16* Qw = Q + (size_t)(b * 4096 + t0 + 32 * th) * 512 + g * 256 + hg * 64;
#if N3_PROBE & 1
            n3::stream<1>(lds, Qf, KV + 2 * kvs + (size_t)bg * 4096 * 64, KV + 3 * kvs + (size_t)bg * 4096 * 64, oms, NTs, qt, tl, mysel, 0.f);
#endif
            n3::stream<1, (N3_PROBE & 1) == 0>(lds, Qf, KV + 2 * kvs + (size_t)bg * 4096 * 64, KV + 3 * kvs + (size_t)bg * 4096 * 64, oms, NTs, qt, tl, mysel, g1);
#if N3_PROBE & 2
            n3::stream<2>(lds, Qf, KV + 4 * kvs + (size_t)bg * 4096 * 64, KV + 5 * kvs + (size_t)bg * 4096 * 64, omw, NTw, qt, tl, mysel, 0.f);
#endif
            n3::stream<2>(lds, Qf, KV + 4 * kvs + (size_t)bg * 4096 * 64, KV + 5 * kvs + (size_t)bg * 4096 * 64, omw, NTw, qt, tl, mysel, g2);
            { const LAS float* accw = (const LAS float*)(lds + n3::L_ACC) + wave * 32 * n3::ACCP;
#pragma unroll
              for (int i = 0; i < 4; ++i) { const int row = i * 8 + (lane >> 3), ch = lane & 7; const LAS float* a = accw + row * n3::ACCP + ch * 8;
                  u32x4 w; w.x = pk2(a[0], a[1]); w.y = pk2(a[2], a[3]); w.z = pk2(a[4], a[5]); w.w = pk2(a[6], a[7]);
                  *(u32x4*)(CATo + (size_t)(b * 4096 + t0 + 32 * th + row) * 1024 + g * 256 + hg * 64 + ch * 8) = w; } }
            __syncthreads();
        }
    }
}
#if NSA_MODE >= 2
__device__ __forceinline__ void phase_probe_cmp(const Params& p) {
    const int gt = blockIdx.x * 512 + threadIdx.x, NGT = gridDim.x * 512; float num = 0.f, den = 0.f;
#if NSA_MODE == 2
    const bf16* A = (const bf16*)(p.ws + WS_CAT); const bf16* B = (const bf16*)(p.ws + WS_M);
    for (int i = gt; i < NT * 512; i += NGT) { const size_t o = (size_t)(i >> 9) * 1024 + (i & 511); const float a = bf2f(A[o]), b = bf2f(B[o]); num += (a - b) * (a - b); den += a * a; }
#else
    const unsigned long long* A = (const unsigned long long*)(p.ws + WS_PROBE + 4096); const unsigned long long* B = A + NT * 2;
    for (int i = gt; i < NT * 2; i += NGT) { num += (A[i] != B[i]) ? 1.f : 0.f; den += 1.f; }
#endif
    num = wave_sum(num); den = wave_sum(den);
    __shared__ float red[16];
    if ((threadIdx.x & 63) == 0) { red[(threadIdx.x >> 6) * 2] = num; red[(threadIdx.x >> 6) * 2 + 1] = den; }
    __syncthreads();
    if (threadIdx.x == 0) { float a = 0.f, b = 0.f; for (int i = 0; i < 8; ++i) { a += red[2 * i]; b += red[2 * i + 1]; } float* slot = (float*)(p.ws + WS_PACC) + 2 * blockIdx.x; slot[0] = a; slot[1] = b; }
}
#endif


struct EpiRmsRes {
    static constexpr bool AFTER_DRAIN = true;
    const float* base; float* hout; bf16* U; const float* gpost; const float* gpre; float* slots; unsigned* cnts; int ex;
    __device__ __forceinline__ void operator()(const f32x4 (&)[2][2][4][2], const g8::Unit&, int, int, int, int) const {}
    __device__ __forceinline__ float row_scale(const f32x4 (&v)[2][2][4][2], const g8::Unit& u, int wr, int wc, int fr, int fq, LAS unsigned char* lds, int bank, int ai, int m) const { return 0.f; }
    __device__ __forceinline__ void exchange(const f32x4 (&v)[2][2][4][2], const g8::Unit& u, int wr, int wc, int fr, int fq, LAS unsigned char* lds, int bank) const {
        LAS float* P = (LAS float*)lds; LAS float* S = (LAS float*)(lds + 4096);
        const int tid = tid_fresh();
#pragma unroll
        for (int ai = 0; ai < 2; ++ai)
#pragma unroll
            for (int m = 0; m < 4; ++m) { float s = 0.f;
#pragma unroll
                for (int bj = 0; bj < 2; ++bj)
#pragma unroll
                    for (int n = 0; n < 2; ++n) { const f32x4 x = v[ai][bj][m][n]; s += (x[0] * x[0] + x[1] * x[1]) + (x[2] * x[2] + x[3] * x[3]); }
                s += __shfl_xor(s, 16); s += __shfl_xor(s, 32);
                if (fq == 0) P[(ai * 128 + wr * 64 + m * 16 + fr) * 4 + wc] = s; }
        __syncthreads();
        float* slot = slots + ((size_t)(bank * 64 + u.pm) * 256) * 4; unsigned* cnt = cnts + (size_t)(bank * 64 + u.pm) * 64;
        if (tid < 256) { const float t = (P[tid * 4 + 0] + P[tid * 4 + 1]) + (P[tid * 4 + 2] + P[tid * 4 + 3]);
            __hip_atomic_store(slot + tid * 4 + u.pn, t, __ATOMIC_RELAXED, __HIP_MEMORY_SCOPE_AGENT);
            asm volatile("s_waitcnt vmcnt(0)" ::: "memory");
            if ((tid & 63) == 0) __hip_atomic_fetch_add(cnt, 1u, __ATOMIC_RELAXED, __HIP_MEMORY_SCOPE_AGENT); }
        if (tid < 64) { unsigned sp = 0;
            while ((unsigned)__builtin_amdgcn_readfirstlane(__hip_atomic_load(cnt, __ATOMIC_RELAXED, __HIP_MEMORY_SCOPE_AGENT)) < 16u) { __builtin_amdgcn_s_sleep(1); if (++sp > (1u << 22)) break; }
            __builtin_amdgcn_fence(__ATOMIC_ACQUIRE, "agent");
            asm volatile("s_waitcnt vmcnt(0)" ::: "memory"); }
        __syncthreads();
        if (tid < 256) { const float a = __hip_atomic_load(slot + tid * 4 + 0, __ATOMIC_RELAXED, __HIP_MEMORY_SCOPE_AGENT), b = __hip_atomic_load(slot + tid * 4 + 1, __ATOMIC_RELAXED, __HIP_MEMORY_SCOPE_AGENT),
                        c = __hip_atomic_load(slot + tid * 4 + 2, __ATOMIC_RELAXED, __HIP_MEMORY_SCOPE_AGENT), d = __hip_atomic_load(slot + tid * 4 + 3, __ATOMIC_RELAXED, __HIP_MEMORY_SCOPE_AGENT);
            S[tid] = rsqrtf(((a + b) + (c + d)) * (1.f / 1024.f) + EPS); }
        __syncthreads();
    }
    __device__ __forceinline__ void fused(f32x4 (&acc)[2][2][4][2], const g8::Unit& u, int wr, int wc, int fr, int fq, LAS unsigned char* lds) const {
        const LAS float* S = (const LAS float*)(lds + 4096);
        const int col0 = u.pn * 256 + wc * 32 + 4 * fq;
        exchange(acc, u, wr, wc, fr, fq, lds, ex);
#pragma unroll
        for (int ai = 0; ai < 2; ++ai)
#pragma unroll
            for (int m = 0; m < 4; ++m) { const int rl = ai * 128 + wr * 64 + m * 16 + fr; const float r = S[rl]; const size_t off = (size_t)(u.pm * 256 + rl) * 1024 + col0;
#pragma unroll
                for (int bj = 0; bj < 2; ++bj)
#pragma unroll
                    for (int n = 0; n < 2; ++n) { const f32x4 g = *(const f32x4*)(gpost + col0 + bj * 128 + n * 16), bs = *(const f32x4*)(base + off + bj * 128 + n * 16);
                        const f32x4 h = bs + acc[ai][bj][m][n] * r * g; acc[ai][bj][m][n] = h; *(f32x4*)(hout + off + bj * 128 + n * 16) = h; }
                asm volatile("" ::: "memory"); }
        exchange(acc, u, wr, wc, fr, fq, lds, ex + 1);
#pragma unroll
        for (int ai = 0; ai < 2; ++ai)
#pragma unroll
            for (int m = 0; m < 4; ++m) { const int rl = ai * 128 + wr * 64 + m * 16 + fr; const float r = S[rl]; const size_t off = (size_t)(u.pm * 256 + rl) * 1024 + col0;
#pragma unroll
                for (int bj = 0; bj < 2; ++bj)
#pragma unroll
                    for (int n = 0; n < 2; ++n) { const f32x4 g = *(const f32x4*)(gpre + col0 + bj * 128 + n * 16); const f32x4 o = acc[ai][bj][m][n] * r * g;
                        u32x2 w; w.x = pk2(o[0], o[1]); w.y = pk2(o[2], o[3]); *(u32x2*)(U + off + bj * 128 + n * 16) = w; }
                asm volatile("" ::: "memory"); }
    }
};

template <bool BF>
struct EpiRmsRes2 {
    static constexpr bool AFTER_DRAIN = true;
    const void* base; bf16* H; float* rs; const float* gpost; float* slots; unsigned* cnts; int ex;
    __device__ __forceinline__ void operator()(const f32x4 (&)[2][2][4][2], const g8::Unit&, int, int, int, int) const {}
    __device__ __forceinline__ void fused(f32x4 (&acc)[2][2][4][2], const g8::Unit& u, int wr, int wc, int fr, int fq, LAS unsigned char* lds) const {
        const LAS float* S = (const LAS float*)(lds + 4096);
        const EpiRmsRes X{nullptr, nullptr, nullptr, nullptr, nullptr, slots, cnts, ex};
        const int col0 = u.pn * 256 + wc * 64 + 8 * fq;
        X.exchange(acc, u, wr, wc, fr, fq, lds, ex);
#pragma unroll
        for (int ai = 0; ai < 2; ++ai)
#pragma unroll
            for (int m = 0; m < 4; ++m) { const int rl = ai * 128 + wr * 64 + m * 16 + fr; const float r = S[rl]; const size_t off = (size_t)(u.pm * 256 + rl) * 1024 + col0;
#pragma unroll
                for (int bj = 0; bj < 2; ++bj) { const f32x4 g0 = *(const f32x4*)(gpost + col0 + bj * 32), g1 = *(const f32x4*)(gpost + col0 + bj * 32 + 4); f32x4 b0, b1;
                    if (BF) { const u32x4 w = *(const u32x4*)((const bf16*)base + off + bj * 32); b0 = (f32x4){bflo(w.x), bfhi(w.x), bflo(w.y), bfhi(w.y)}; b1 = (f32x4){bflo(w.z), bfhi(w.z), bflo(w.w), bfhi(w.w)}; }
                    else { b0 = *(const f32x4*)((const float*)base + off + bj * 32); b1 = *(const f32x4*)((const float*)base + off + bj * 32 + 4); }
                    const f32x4 h0 = b0 + acc[ai][bj][m][0] * r * g0, h1 = b1 + acc[ai][bj][m][1] * r * g1; acc[ai][bj][m][0] = h0; acc[ai][bj][m][1] = h1;
                    u32x4 o; o.x = pk2(h0[0], h0[1]); o.y = pk2(h0[2], h0[3]); o.z = pk2(h1[0], h1[1]); o.w = pk2(h1[2], h1[3]); *(u32x4*)(H + off + bj * 32) = o; }
                asm volatile("" ::: "memory"); }
        X.exchange(acc, u, wr, wc, fr, fq, lds, ex + 1);
        if (u.pn == 0) { const int tid = tid_fresh(); if (tid < 256) rs[u.pm * 256 + tid] = S[tid]; }
    }
};

template <bool BF>
__device__ __forceinline__ void phase_norm(const Params& p, const void* base, const float* gpost, const float* gpre, unsigned char* u8, float* rs = nullptr) {
    const int tid_ = tid_fresh(), lane = tid_ & 63, wave = tid_ >> 6; const int gw = blockIdx.x * 8 + wave, NGW = gridDim.x * 8;
    const bf16* M = (const bf16*)(p.ws + WS_M); bf16* U = (bf16*)(p.ws + WS_U); bf16* H = (bf16*)(p.ws + WS_H);
    constexpr int ES = BF ? 2 : 4;
    for (int m = gw; m < NT; m += 2 * NGW) { f32x4 h[4], h2[4]; const int m2 = m + NGW;
        row_norm2<BF>((const char*)base + (size_t)m * D * ES, M + (size_t)m * D, H + (size_t)m * D, U + (size_t)m * D, (const char*)base + (size_t)m2 * D * ES, M + (size_t)m2 * D, H + (size_t)m2 * D, U + (size_t)m2 * D, gpost, gpre, lane, h, h2, rs ? rs + m : nullptr, rs ? rs + m2 : nullptr);
        if (u8) {
#pragma unroll
            for (int j = 0; j < 4; ++j) { *(unsigned*)(u8 + (size_t)m * D + 4 * lane + 256 * j) = pk4f8(h[j][0], h[j][1], h[j][2], h[j][3]); *(unsigned*)(u8 + (size_t)m2 * D + 4 * lane + 256 * j) = pk4f8(h2[j][0], h2[j][1], h2[j][2], h2[j][3]); } } }
}

struct EpiGmlpIn {
    static constexpr bool AFTER_DRAIN = false;
    bf16* Z; f32x2* ST; const float* rs;
    __device__ __forceinline__ void operator()(const f32x4 (&acc)[2][2][4][2], const g8::Unit& u, int wr, int wc, int fr, int fq, const LAS float* rsl) const {
        const int row0 = u.pm * 256 + wr * 64 + fr, col0 = u.pn * 256 + wc * 64 + 8 * fq;
#pragma unroll
        for (int ai = 0; ai < 2; ++ai)
#pragma unroll
            for (int m = 0; m < 4; ++m) { const int row = row0 + ai * 128 + m * 16; bf16* rowp = Z + (size_t)row * 2048 + col0; float s = 0.f, q = 0.f; const float rr = rsl[row - u.pm * 256];
#pragma unroll
                for (int bj = 0; bj < 2; ++bj) { u32x4 w;
#pragma unroll
                    for (int n = 0; n < 2; ++n) { const f32x4 v = acc[ai][bj][m][n]; const f32x2 y0 = gelu_tanh2((f32x2){v[0], v[1]} * rr), y1 = gelu_tanh2((f32x2){v[2], v[3]} * rr), q2 = y0 * y0 + y1 * y1, s2 = y0 + y1;
                        const float a = y0[0], b = y0[1], c = y1[0], d = y1[1];
                        s += s2[0] + s2[1]; q += q2[0] + q2[1];
                        if (n == 0) { w.x = pk2(a, b); w.y = pk2(c, d); } else { w.z = pk2(a, b); w.w = pk2(c, d); } }
                    *(u32x4*)(rowp + bj * 32) = w; }
                if (u.pn >= 4) { s += __shfl_xor(s, 16); s += __shfl_xor(s, 32); q += __shfl_xor(q, 16); q += __shfl_xor(q, 32);
                    if (fq == 0) ST[(size_t)row * 16 + (u.pn - 4) * 4 + wc] = (f32x2){s, q}; } }
    }
};
__device__ __forceinline__ void phase_gmlp_sgu(const Params& p, LAS unsigned char* lds) {
    const int tid = tid_fresh(); unsigned char* ws = p.ws;
    LAS float* zt = (LAS float*)lds;
    LAS float* mu = zt + 128 * 128; LAS float* rs = mu + 128;
    const bf16* Z = (const bf16*)(ws + WS_Z); const f32x2* ST = (const f32x2*)(ws + WS_STATS); const bf16* WSB = (const bf16*)(ws + WS_WSB); bf16* O = (bf16*)(ws + WS_CAT);
    const float* lng = p.in[I_GLNG]; const float* lnb = p.in[I_GLNB]; const float* bs = p.in[I_GBS];
    for (int unit = blockIdx.x; unit < 4 * 32 * 8; unit += gridDim.x) {
        const int g = unit & 7, bc = unit >> 3, row0 = bc * 128;
        __syncthreads();
        if (tid < 128) { float s = 0.f, q = 0.f; const f32x2* st = ST + (size_t)(row0 + tid) * 16;
            for (int i = 0; i < 16; ++i) { s += st[i].x; q += st[i].y; }
            const float m = s * (1.f / 1024.f); mu[tid] = m; rs[tid] = rsqrtf(fmaxf(q * (1.f / 1024.f) - m * m, 0.f) + EPS); }
        __syncthreads();
        for (int i = tid; i < 128 * 16; i += 512) { const int s = i >> 4, c8 = (i & 15) * 8; const u32x4 v = *(const u32x4*)(Z + (size_t)(row0 + s) * 2048 + 1024 + g * 128 + c8);
            const float m = mu[s], r = rs[s]; const float* gg = lng + g * 128 + c8; const float* bb = lnb + g * 128 + c8; LAS float* d = zt + s * 128 + c8;
            d[0] = (bflo(v.x) - m) * r * gg[0] + bb[0]; d[1] = (bfhi(v.x) - m) * r * gg[1] + bb[1]; d[2] = (bflo(v.y) - m) * r * gg[2] + bb[2]; d[3] = (bfhi(v.y) - m) * r * gg[3] + bb[3];
            d[4] = (bflo(v.z) - m) * r * gg[4] + bb[4]; d[5] = (bfhi(v.z) - m) * r * gg[5] + bb[5]; d[6] = (bflo(v.w) - m) * r * gg[6] + bb[6]; d[7] = (bfhi(v.w) - m) * r * gg[7] + bb[7]; }
        __syncthreads();
        const int d = tid & 127;
        for (int i = 0; i < 32; ++i) { const int t = (tid >> 7) + 4 * i; const bf16* wr = WSB + ((size_t)g * 128 + t) * 128; float a = bs[g * 128 + t];
            for (int s = 0; s <= t; ++s) a += bf2f(wr[s]) * zt[s * 128 + d];
            const size_t row = (size_t)(row0 + t); const float z1 = bf2f(Z[row * 2048 + g * 128 + d]);
            O[row * 1024 + g * 128 + d] = (bf16)f2bf(z1 * a); }
    }
}


__device__ __forceinline__ void phase_gmlp_sgu_fast(const Params& p, LAS unsigned char* lds) {
    const int tid = tid_fresh(), lane = tid & 63, wave = __builtin_amdgcn_readfirstlane(tid >> 6); unsigned char* ws = p.ws;
    LAS unsigned char* zt = lds;
    LAS float* mu = (LAS float*)(lds + 32768); LAS float* rs = mu + 128;
    LAS float* mx = (LAS float*)(lds + 40960);
    const bf16* Z = (const bf16*)(ws + WS_Z); const f32x2* ST = (const f32x2*)(ws + WS_STATS); const bf16* WSB = (const bf16*)(ws + WS_WSB); bf16* O = (bf16*)(ws + WS_CAT);
    const float* bs = p.in[I_GBS];
    const int q = lane & 31, h = lane >> 5, tt = wave & 3, dp = wave >> 2;
    const int c8 = (tid & 15) * 8;
    const int NU = 4 * 32 * 8;
#define SGU_MAP(unit_, g_, row0_) do { const int ui_ = gridDim.x == 256 ? (int)(blockIdx.x >> 3) + 32 * ((unit_) >> 8) : (unit_); g_ = ui_ & 7; \
        row0_ = (gridDim.x == 256 ? 16 * (int)(blockIdx.x & 7) + (ui_ >> 3) : (unit_) >> 3) * 128; } while (0)
    u32x4 z2n[4], z1n[4]; f32x4 stn[2];
#define SGU_LOAD(unit_) do { int g_, r0_; SGU_MAP(unit_, g_, r0_); \
        { const f32x4* sp_ = (const f32x4*)(ST + (size_t)(r0_ + (tid >> 2)) * 16 + (tid & 3) * 4); stn[0] = sp_[0]; stn[1] = sp_[1]; } \
        _Pragma("unroll") for (int it = 0; it < 4; ++it) { const size_t row_ = (size_t)(r0_ + (tid >> 4) + 32 * it); \
            z2n[it] = *(const u32x4*)(Z + row_ * 2048 + 1024 + g_ * 128 + c8); z1n[it] = *(const u32x4*)(Z + row_ * 2048 + g_ * 128 + c8); } } while (0)
    int unit = blockIdx.x; if (unit >= NU) return;
    SGU_LOAD(unit);
    int gprev = -1; bf16x8 Wf[8]; f32x4 ga, gb, ba, bb;
    for (; unit < NU; unit += gridDim.x) {
        int g, row0; SGU_MAP(unit, g, row0);
        u32x4 z2c[4], z1c[4]; const f32x4 st0 = stn[0], st1 = stn[1];
#pragma unroll
        for (int it = 0; it < 4; ++it) { z2c[it] = z2n[it]; z1c[it] = z1n[it]; }
        if (unit + (int)gridDim.x < NU) SGU_LOAD(unit + (int)gridDim.x);
        if (g != gprev) { gprev = g;
            ga = *(const f32x4*)(p.in[I_GLNG] + g * 128 + c8); gb = *(const f32x4*)(p.in[I_GLNG] + g * 128 + c8 + 4);
            ba = *(const f32x4*)(p.in[I_GLNB] + g * 128 + c8); bb = *(const f32x4*)(p.in[I_GLNB] + g * 128 + c8 + 4);
#pragma unroll
            for (int ks = 0; ks < 8; ++ks) Wf[ks] = *(const bf16x8*)(WSB + ((size_t)g * 128 + 32 * tt + q) * 128 + 16 * ks + 8 * h); }
        __syncthreads();
        { float s = (st0[0] + st0[2]) + (st1[0] + st1[2]), qq = (st0[1] + st0[3]) + (st1[1] + st1[3]);
          s += __shfl_xor(s, 1); qq += __shfl_xor(qq, 1); s += __shfl_xor(s, 2); qq += __shfl_xor(qq, 2);
          if ((tid & 3) == 0) { const float m = s * (1.f / 1024.f); mu[tid >> 2] = m; rs[tid >> 2] = rsqrtf(fmaxf(qq * (1.f / 1024.f) - m * m, 0.f) + EPS); } }
        __syncthreads();
#pragma unroll
        for (int it = 0; it < 4; ++it) { const int s = (tid >> 4) + 32 * it; const u32x4 v = z2c[it];
            const float m = mu[s], r = rs[s];
            float y[8]; y[0] = (bflo(v.x) - m) * r * ga[0] + ba[0]; y[1] = (bfhi(v.x) - m) * r * ga[1] + ba[1]; y[2] = (bflo(v.y) - m) * r * ga[2] + ba[2]; y[3] = (bfhi(v.y) - m) * r * ga[3] + ba[3];
            y[4] = (bflo(v.z) - m) * r * gb[0] + bb[0]; y[5] = (bfhi(v.z) - m) * r * gb[1] + bb[1]; y[6] = (bflo(v.w) - m) * r * gb[2] + bb[2]; y[7] = (bfhi(v.w) - m) * r * gb[3] + bb[3];
#pragma unroll
            for (int e = 0; e < 8; ++e) { const int d = c8 + e; *(LAS bf16*)(zt + d * 256 + ((((s >> 3) ^ (d ^ (d >> 3))) & 15) << 4) + (s & 7) * 2) = (bf16)f2bf(y[e]); } }
        __syncthreads();
#pragma unroll
        for (int di = 0; di < 2; ++di) { const int d = 64 * dp + 32 * di + q; f32x16 acc;
#pragma unroll
            for (int r = 0; r < 16; ++r) acc[r] = 0.f;
            const LAS unsigned char* zr = zt + d * 256; const int sw = (d ^ (d >> 3)) & 15;
#pragma unroll
            for (int ks = 0; ks < 8; ++ks) if (ks <= 2 * tt + 1) { const bf16x8 Zf = *(const LAS bf16x8*)(zr + (((2 * ks + h) ^ sw) << 4)); acc = MFMA32(Wf[ks], Zf, acc); }
#pragma unroll
            for (int r = 0; r < 16; ++r) { const int t = 32 * tt + (r & 3) + 8 * (r >> 2) + 4 * h; mx[t * 128 + d] = acc[r] + bs[g * 128 + t]; } }
        __syncthreads();
#pragma unroll
        for (int it = 0; it < 4; ++it) { const int t = (tid >> 4) + 32 * it; const size_t row = (size_t)(row0 + t);
            const u32x4 zv = z1c[it]; const f32x4 m0 = *(const LAS f32x4*)(mx + t * 128 + c8), m1 = *(const LAS f32x4*)(mx + t * 128 + c8 + 4);
            u32x4 o; o.x = pk2(bflo(zv.x) * m0[0], bfhi(zv.x) * m0[1]); o.y = pk2(bflo(zv.y) * m0[2], bfhi(zv.y) * m0[3]); o.z = pk2(bflo(zv.z) * m1[0], bfhi(zv.z) * m1[1]); o.w = pk2(bflo(zv.w) * m1[2], bfhi(zv.w) * m1[3]);
            *(u32x4*)(O + row * 1024 + g * 128 + c8) = o; }
    }
#undef SGU_LOAD
#undef SGU_MAP
}

__device__ __forceinline__ void moe_tables(const Params& p, LAS unsigned char* lds) {
    LAS int* tb = (LAS int*)(lds + LDS_MISC);
    __syncthreads();
    if (threadIdx.x < 8) tb[threadIdx.x] = (int)__hip_atomic_load((const unsigned*)(p.ws + WS_CNT) + threadIdx.x, __ATOMIC_RELAXED, __HIP_MEMORY_SCOPE_AGENT);
    __syncthreads();
    if (threadIdx.x == 0) { int acc = 0;
        for (int e = 0; e < 8; ++e) { tb[8 + e] = acc; acc += (tb[e] + 255) >> 8; }
        tb[16] = acc; }
    __syncthreads();
}
template <bool GATHER_>
struct MoeSched {
    static constexpr bool GATHER = GATHER_;
    const char* A; const char* Wt; const int* list; LAS int* tb; int apitch_, bpitch, nN, G, c; size_t wstride;
    int nM; unsigned long long tp8;
    int lim = 0x7fffffff;
    __device__ __forceinline__ void init() { nM = __builtin_amdgcn_readfirstlane(tb[16]); unsigned lo = 0u, hi = 0u;
#pragma unroll
        for (int x = 1; x < 4; ++x) lo |= ((unsigned)__builtin_amdgcn_readfirstlane(tb[8 + x]) & 0xffu) << (8 * x);
#pragma unroll
        for (int x = 4; x < 8; ++x) hi |= ((unsigned)__builtin_amdgcn_readfirstlane(tb[8 + x]) & 0xffu) << (8 * (x - 4));
        tp8 = ((unsigned long long)hi << 32) | lo; }
    __device__ __forceinline__ int apitch() const { return apitch_; }
    __device__ __forceinline__ const void* abase() const { return A; }
    __device__ __forceinline__ const void* bbase() const { return Wt; }
    __device__ __forceinline__ bool next(int i, g8::Unit& u) const {
        if (i * G + c >= lim || !g8::tile_order(i * G + c, nM, nN, u.pm, u.pn)) return false;
        int e = 0;
#pragma unroll
        for (int x = 1; x < 8; ++x) e += (u.pm >= (int)((tp8 >> (8 * x)) & 0xffull)) ? 1 : 0;
        u.e = e; u.bo = (unsigned)e * (unsigned)wstride + (unsigned)u.pn * 256u * (unsigned)bpitch;
        u.ao = GATHER ? 0u : (unsigned)u.pm * 256u * (unsigned)apitch_; return true;
    }
    __device__ __forceinline__ void aoff(const g8::Unit& u, unsigned (&v)[4]) const {
        int R0, C0; g8::stage_rc(tid_fresh() * 16, R0, C0);
        const int cnt = __builtin_amdgcn_readfirstlane(tb[u.e]), l0 = (u.pm - (int)((tp8 >> (8 * u.e)) & 0xffull)) * 256;
#pragma unroll
        for (int x = 0; x < 4; ++x) { const int lr = l0 + 64 * x + R0; const int tok = lr < cnt ? list[u.e * 16384 + lr] : 0; v[x] = (unsigned)(tok * apitch_ + C0 * 2); }
    }
};
struct EpiSwiGLU8 {
    static constexpr bool AFTER_DRAIN = false;
    unsigned char* O; int ldc; float sc;
    __device__ __forceinline__ void operator()(const f32x4 (&acc)[2][2][4][2], const g8::Unit& u, int wr, int wc, int fr, int fq, LAS unsigned char* lds) const {
        const int row0 = u.pm * 256 + wr * 64 + fr, col0 = u.pn * 128 + wc * 32 + 8 * fq; const float k1 = -sc * 1.4426950408889634f, k2 = sc * sc;
#pragma unroll
        for (int ai = 0; ai < 2; ++ai)
#pragma unroll
            for (int m = 0; m < 4; ++m) { u32x2 w;
#pragma unroll
                for (int bj = 0; bj < 2; ++bj) { const f32x4 g = acc[ai][bj][m][0], up = acc[ai][bj][m][1]; unsigned x = 0u;
                    { const f32x2 a = swiglu2((f32x2){g[0], g[1]}, (f32x2){up[0], up[1]}, k1, k2); x = __builtin_amdgcn_cvt_pk_fp8_f32(clamp8(a[0]), clamp8(a[1]), x, false); }
                    { const f32x2 b = swiglu2((f32x2){g[2], g[3]}, (f32x2){up[2], up[3]}, k1, k2); x = __builtin_amdgcn_cvt_pk_fp8_f32(clamp8(b[0]), clamp8(b[1]), x, true); }
                    if (bj == 0) w.x = x; else w.y = x; }
                *(u32x2*)(O + (size_t)(row0 + ai * 128 + m * 16) * ldc + col0) = w;
                asm volatile("" ::: "memory"); }
    }
};
struct EpiBf16S {
    static constexpr bool AFTER_DRAIN = false;
    bf16* O; int ldc; float sc;
    __device__ __forceinline__ void operator()(const f32x4 (&acc)[2][2][4][2], const g8::Unit& u, int wr, int wc, int fr, int fq) const {
        const int row0 = u.pm * 256 + wr * 64 + fr, col0 = u.pn * 256 + wc * 64 + 8 * fq;
#pragma unroll
        for (int ai = 0; ai < 2; ++ai)
#pragma unroll
            for (int m = 0; m < 4; ++m) { bf16* rowp = O + (size_t)(row0 + ai * 128 + m * 16) * ldc + col0;
#pragma unroll
                for (int bj = 0; bj < 2; ++bj) { const f32x4 v0 = acc[ai][bj][m][0] * sc, v1 = acc[ai][bj][m][1] * sc;
                    u32x4 w; w.x = pk2(v0[0], v0[1]); w.y = pk2(v0[2], v0[3]); w.z = pk2(v1[0], v1[1]); w.w = pk2(v1[2], v1[3]); *(u32x4*)(rowp + bj * 32) = w; } }
    }
};

constexpr int MOE_TK = 512, MOE_TP = EFF / MOE_TK;
__device__ __forceinline__ int moe_tail_units(int nM, int G) { const int T = nM * (D / 256) - 2 * G; return (T > 0 && MOE_TP * T <= G && (G & 1) == 0) ? T : 0; }
struct MoeTailSched {
    static constexpr bool GATHER = false;
    const char* A; const char* Wt; int apitch_, bpitch, nN, c, first, npieces, khalf; size_t wstride; int nM; unsigned long long tp8; int G;
    __device__ __forceinline__ int apitch() const { return apitch_; }
    __device__ __forceinline__ const void* abase() const { return A; }
    __device__ __forceinline__ const void* bbase() const { return Wt; }
    __device__ __forceinline__ int nt(const g8::Unit& u) const { return (u.e & 0x1000) ? khalf / 128 : EFF / 128; }
    __device__ __forceinline__ bool next(int i, g8::Unit& u) const {
        const bool tail = i >= 2; const int un = c / MOE_TP, h = tail ? c - un * MOE_TP : 0;
        if (i > 2 || (tail && c >= npieces)) return false;
        if (tail) { u.pm = first + (un >> 2); u.pn = un & 3; }
        else g8::tile_order(i * G + c, first, nN, u.pm, u.pn);
        int e = 0;
#pragma unroll
        for (int x = 1; x < 8; ++x) e += (u.pm >= (int)((tp8 >> (8 * x)) & 0xffull)) ? 1 : 0;
        const unsigned kb = (unsigned)h * (unsigned)khalf;
        u.e = tail ? (e | (h << 8) | 0x1000 | (un << 16)) : e; u.bo = (unsigned)e * (unsigned)wstride + (unsigned)u.pn * 256u * (unsigned)bpitch + kb;
        u.ao = (unsigned)u.pm * 256u * (unsigned)apitch_ + kb; return true;
    }
    __device__ __forceinline__ void aoff(const g8::Unit&, unsigned (&)[4]) const {}
};
struct EpiBf16S2 {
    static constexpr bool AFTER_DRAIN = false;
    bf16* O; bf16* O2; int ldc; float sc;
    __device__ __forceinline__ void operator()(const f32x4 (&acc)[2][2][4][2], const g8::Unit& u, int wr, int wc, int fr, int fq) const {
        const int h = (u.e >> 8) & 7; const bool h1 = h != 0; const int ld = h1 ? 256 : ldc;
        bf16* base = h1 ? O2 + (size_t)((u.e >> 16) * (MOE_TP - 1) + h - 1) * 65536 : O + (size_t)u.pm * 256 * ldc + u.pn * 256;
        const int row0 = wr * 64 + fr, col0 = wc * 64 + 8 * fq;
#pragma unroll
        for (int ai = 0; ai < 2; ++ai)
#pragma unroll
            for (int m = 0; m < 4; ++m) { bf16* rowp = base + (size_t)(row0 + ai * 128 + m * 16) * ld + col0;
#pragma unroll
                for (int bj = 0; bj < 2; ++bj) { const f32x4 v0 = acc[ai][bj][m][0] * sc, v1 = acc[ai][bj][m][1] * sc;
                    u32x4 w; w.x = pk2(v0[0], v0[1]); w.y = pk2(v0[2], v0[3]); w.z = pk2(v1[0], v1[1]); w.w = pk2(v1[2], v1[3]); *(u32x4*)(rowp + bj * 32) = w; } }
    }
};

__device__ __forceinline__ void phase_norm_router(const Params& p, LAS unsigned char* lds) {
    const int tid = tid_fresh(), lane = tid & 63, wave = tid >> 6; unsigned char* ws = p.ws;
    LAS int* lc = (LAS int*)(lds + LDS_MISC + 256);
    LAS int* rec = lc + 16;
    const bf16* M = (const bf16*)(ws + WS_M); bf16* U = (bf16*)(ws + WS_U);
    const float* wrt = p.in[I_MWR];
    int* list = (int*)(ws + WS_LIST); int* toke = (int*)(ws + WS_TOKE); float* tokw = (float*)(ws + WS_TOKW); unsigned* gcnt = (unsigned*)(ws + WS_CNT);
    for (int r0 = (gridDim.x == 256 ? (int)((blockIdx.x & 7) * 2048 + (blockIdx.x >> 3) * 64) : (int)blockIdx.x * 64); r0 < NT; r0 += gridDim.x * 64) {
        __syncthreads();
        if (tid < 16) lc[tid] = 0;
        LAS unsigned char* wl = lds + 65536;
#pragma unroll
        for (int kk = 0; kk < 2; ++kk) { const int k = tid + 512 * kk, l_ = (k & 255) >> 2, jx = (k >> 8) * 4 + (k & 3); const f32x4 a = *(const f32x4*)(wrt + (size_t)k * 8), b = *(const f32x4*)(wrt + (size_t)k * 8 + 4);
            *(LAS f32x4*)(wl + (jx * 64 + l_) * 48) = a; *(LAS f32x4*)(wl + (jx * 64 + l_) * 48 + 16) = b; }
        __syncthreads();
#if FUSE_NORM
        u32x2 nA[4], nB[4]; float nra, nrb;
#define RT_LOAD(i_) do { const int a_ = r0 + wave * 8 + (i_), b_ = a_ + 4; const bf16* H_ = (const bf16*)(ws + WS_H); \
            _Pragma("unroll") for (int j = 0; j < 4; ++j) { nA[j] = *(const u32x2*)(H_ + (size_t)a_ * D + 4 * lane + 256 * j); nB[j] = *(const u32x2*)(H_ + (size_t)b_ * D + 4 * lane + 256 * j); } \
            nra = ((const float*)(ws + WS_RS))[a_]; nrb = ((const float*)(ws + WS_RS))[b_]; } while (0)
        RT_LOAD(0);
#endif
        for (int i = 0; i < 4; ++i) { const int lrA = wave * 8 + i, lrB = lrA + 4, mA = r0 + lrA, mB = r0 + lrB; f32x4 h[4], h2[4];
            bf16* H = (bf16*)(ws + WS_H);
#if FUSE_NORM
            { const float ra = nra, rb = nrb; const float* gp = p.in[I_NFPRE] + D;
#pragma unroll
              for (int j = 0; j < 4; ++j) { h[j] = (f32x4){bflo(nA[j].x), bfhi(nA[j].x), bflo(nA[j].y), bfhi(nA[j].y)}; h2[j] = (f32x4){bflo(nB[j].x), bfhi(nB[j].x), bflo(nB[j].y), bfhi(nB[j].y)}; }
              if (i + 1 < 4) RT_LOAD(i + 1);
#pragma unroll
              for (int j = 0; j < 4; ++j) { const f32x4 g = *(const f32x4*)(gp + 4 * lane + 256 * j); h[j] = h[j] * ra * g; h2[j] = h2[j] * rb * g; } }
#else
            row_norm2<true>(H + (size_t)mA * D, M + (size_t)mA * D, H + (size_t)mA * D, MOE_F8 ? nullptr : U + (size_t)mA * D, H + (size_t)mB * D, M + (size_t)mB * D, H + (size_t)mB * D, MOE_F8 ? nullptr : U + (size_t)mB * D, p.in[I_NMPOST] + D, p.in[I_NFPRE] + D, lane, h, h2);
#endif
#if MOE_F8
            if (gridDim.x == 256) {
#pragma unroll
                for (int j = 0; j < 4; ++j) { *(LAS unsigned*)(lds + lrA * 1024 + 4 * lane + 256 * j) = pk4f8(h[j][0], h[j][1], h[j][2], h[j][3]); *(LAS unsigned*)(lds + lrB * 1024 + 4 * lane + 256 * j) = pk4f8(h2[j][0], h2[j][1], h2[j][2], h2[j][3]); }
            } else {
#pragma unroll
            for (int j = 0; j < 4; ++j) { *(unsigned*)(ws + WS_U8 + (size_t)mA * D + 4 * lane + 256 * j) = pk4f8(h[j][0], h[j][1], h[j][2], h[j][3]); *(unsigned*)(ws + WS_U8 + (size_t)mB * D + 4 * lane + 256 * j) = pk4f8(h2[j][0], h2[j][1], h2[j][2], h2[j][3]); } }
#endif
            float lg[8], lh[8];
#pragma unroll
            for (int e = 0; e < 8; ++e) { lg[e] = 0.f; lh[e] = 0.f; }
#pragma unroll
            for (int j = 0; j < 4; ++j)
#pragma unroll
                for (int x = 0; x < 4; ++x) { const f32x4 wa = *(const LAS f32x4*)(wl + ((j * 4 + x) * 64 + lane) * 48), wb = *(const LAS f32x4*)(wl + ((j * 4 + x) * 64 + lane) * 48 + 16); const float hv = h[j][x], hw = h2[j][x];
                    lg[0] += hv * wa[0]; lg[1] += hv * wa[1]; lg[2] += hv * wa[2]; lg[3] += hv * wa[3]; lg[4] += hv * wb[0]; lg[5] += hv * wb[1]; lg[6] += hv * wb[2]; lg[7] += hv * wb[3];
                    lh[0] += hw * wa[0]; lh[1] += hw * wa[1]; lh[2] += hw * wa[2]; lh[3] += hw * wa[3]; lh[4] += hw * wb[0]; lh[5] += hw * wb[1]; lh[6] += hw * wb[2]; lh[7] += hw * wb[3]; }
            float w1;
            { const bool b5 = (lane & 32) != 0, b4 = (lane & 16) != 0, b3 = (lane & 8) != 0, b2 = (lane & 4) != 0; float w8[8], w4[4], w2[2];
#pragma unroll
              for (int e = 0; e < 8; ++e) { const float snd = b5 ? lg[e] : lh[e], kp = b5 ? lh[e] : lg[e]; w8[e] = kp + __shfl_xor(snd, 32); }
#pragma unroll
              for (int e = 0; e < 4; ++e) { const float snd = b4 ? w8[e] : w8[e + 4], kp = b4 ? w8[e + 4] : w8[e]; w4[e] = kp + __shfl_xor(snd, 16); }
#pragma unroll
              for (int e = 0; e < 2; ++e) { const float snd = b3 ? w4[e] : w4[e + 2], kp = b3 ? w4[e + 2] : w4[e]; w2[e] = kp + __shfl_xor(snd, 8); }
              { const float snd = b2 ? w2[0] : w2[1], kp = b2 ? w2[1] : w2[0]; w1 = kp + __shfl_xor(snd, 4); }
              w1 += __shfl_xor(w1, 2); w1 += __shfl_xor(w1, 1); }
#pragma unroll
            for (int rr = 0; rr < 2; ++rr) { const int lr = rr ? lrB : lrA, m = rr ? mB : mA;
                float l8[8];
#pragma unroll
                for (int e = 0; e < 8; ++e) l8[e] = __builtin_bit_cast(float, __builtin_amdgcn_readlane(__builtin_bit_cast(int, w1), 32 * rr + 16 * (e >> 2) + 8 * ((e >> 1) & 1) + 4 * (e & 1)));
                int e0 = 0; float v0 = l8[0];
#pragma unroll
                for (int e = 1; e < 8; ++e) if (l8[e] > v0) { v0 = l8[e]; e0 = e; }
                int e1 = e0 == 0 ? 1 : 0; float v1 = -3.4e38f;
#pragma unroll
                for (int e = 0; e < 8; ++e) if (e != e0 && l8[e] > v1) { v1 = l8[e]; e1 = e; }
                if (lane == 0) { const float x = __expf(v1 - v0), w0 = 1.f / (1.f + x), w1 = x / (1.f + x);
                    const int p0 = __hip_atomic_fetch_add(lc + e0, 1, __ATOMIC_RELAXED, __HIP_MEMORY_SCOPE_WORKGROUP), p1 = __hip_atomic_fetch_add(lc + e1, 1, __ATOMIC_RELAXED, __HIP_MEMORY_SCOPE_WORKGROUP);
                    rec[lr * 4 + 0] = e0; rec[lr * 4 + 1] = e1; rec[lr * 4 + 2] = p0; rec[lr * 4 + 3] = p1; tokw[m * 2] = w0; tokw[m * 2 + 1] = w1; } }
        }
        __syncthreads();
        if (tid < 8) lc[8 + tid] = (int)atomicAdd(gcnt + tid, (unsigned)lc[tid]);
        __syncthreads();
        if (tid < 128) { const int lr = tid >> 1, k = tid & 1, e = rec[lr * 4 + k], pos = lc[8 + e] + rec[lr * 4 + 2 + k], m = r0 + lr;
            list[e * 16384 + pos] = m; toke[m * 2 + k] = (e << 16) | pos; }
    }
}

__device__ __forceinline__ void phase_moe_gather(const Params& p, LAS unsigned char* lds) {
    const int tid_ = tid_fresh(), lane = tid_ & 63, wave = tid_ >> 6; const int gw = blockIdx.x * 8 + wave, NGW = gridDim.x * 8; unsigned char* ws = p.ws;
    LAS int* tb = (LAS int*)(lds + LDS_MISC); const int* list = (const int*)(ws + WS_LIST);
    if (gridDim.x == 256) {
        const LAS int* lc = (const LAS int*)(lds + LDS_MISC + 256); const LAS int* rec = lc + 16;
        for (int idx = wave; idx < 128; idx += 8) { const int lr = idx >> 1, k = idx & 1, e = rec[lr * 4 + k], pos = lc[8 + e] + rec[lr * 4 + 2 + k];
            const u32x4 v = *(const LAS u32x4*)(lds + lr * 1024 + 16 * lane);
            *(u32x4*)(ws + WS_XG8 + ((size_t)tb[8 + e] * 256 + pos) * D + 16 * lane) = v; }
        return; }
    for (int e = 0; e < NE; ++e) { const int cnt = tb[e]; const size_t base = (size_t)tb[8 + e] * 256;
        for (int r = gw; r < cnt; r += 2 * NGW) { const int r2 = r + NGW; const int t0 = list[e * 16384 + r], t1 = r2 < cnt ? list[e * 16384 + r2] : t0;
            const u32x4 a = *(const u32x4*)(ws + WS_U8 + (size_t)t0 * D + 16 * lane), b = *(const u32x4*)(ws + WS_U8 + (size_t)t1 * D + 16 * lane);
            *(u32x4*)(ws + WS_XG8 + (base + r) * D + 16 * lane) = a; if (r2 < cnt) *(u32x4*)(ws + WS_XG8 + (base + r2) * D + 16 * lane) = b; } }
}
__device__ __forceinline__ void phase_final(const Params& p, LAS unsigned char* lds) {
    const int tid_ = tid_fresh(), lane = tid_ & 63, wave = tid_ >> 6; const int gw = blockIdx.x * 8 + wave, NGW = gridDim.x * 8; unsigned char* ws = p.ws;
    LAS int* tb = (LAS int*)(lds + LDS_MISC);
    const bf16* Y = (const bf16*)(ws + WS_Y); const int* toke = (const int*)(ws + WS_TOKE); const float* tokw = (const float*)(ws + WS_TOKW); const float* g = p.in[I_NFPOST] + D;
    const f32x4 gg0 = *(const f32x4*)(g + 4 * lane), gg1 = *(const f32x4*)(g + 4 * lane + 256), gg2 = *(const f32x4*)(g + 4 * lane + 512), gg3 = *(const f32x4*)(g + 4 * lane + 768);
    const bf16* Y2 = (const bf16*)(ws + WS_XG8);
    const int PM0 = __builtin_amdgcn_readfirstlane(moe_tail_units(tb[16], (int)gridDim.x) > 0 ? 2 * (int)gridDim.x / (D / 256) : 0x7fffffff);
    for (int mm = gw; mm < NT; mm += 2 * NGW) {
        int c0[2], c1[2]; float w0[2], w1[2]; size_t s0[2], s1[2];
#pragma unroll
        for (int z = 0; z < 2; ++z) { const int m = mm + z * NGW; c0[z] = toke[m * 2]; c1[z] = toke[m * 2 + 1]; w0[z] = tokw[m * 2]; w1[z] = tokw[m * 2 + 1]; }
#pragma unroll
        for (int z = 0; z < 2; ++z) { s0[z] = (size_t)tb[8 + (c0[z] >> 16)] * 256 + (c0[z] & 0xffff); s1[z] = (size_t)tb[8 + (c1[z] >> 16)] * 256 + (c1[z] & 0xffff); }
        f32x4 f[2][4]; u32x2 hw[2][4], ya[2][4], yb[2][4]; float ss[2] = {0.f, 0.f};
#pragma unroll
        for (int z = 0; z < 2; ++z)
#pragma unroll
            for (int j = 0; j < 4; ++j) { ya[z][j] = *(const u32x2*)(Y + s0[z] * D + 4 * lane + 256 * j); yb[z][j] = *(const u32x2*)(Y + s1[z] * D + 4 * lane + 256 * j);
                hw[z][j] = *(const u32x2*)((const bf16*)(ws + WS_H) + (size_t)(mm + z * NGW) * D + 4 * lane + 256 * j); }
#pragma unroll
        for (int z = 0; z < 2; ++z) {
#pragma unroll
            for (int j = 0; j < 4; ++j) f[z][j] = (f32x4){0.f, 0.f, 0.f, 0.f};
            const int pa = __builtin_amdgcn_readfirstlane((int)(s0[z] >> 8)), pb = __builtin_amdgcn_readfirstlane((int)(s1[z] >> 8));
            if (pa >= PM0) { const bf16* yp = Y2 + ((size_t)(pa - PM0) * 4 * (MOE_TP - 1) * 256 + (s0[z] & 255)) * 256 + 4 * lane; u32x2 t[4][MOE_TP - 1];
#pragma unroll
                for (int j = 0; j < 4; ++j)
#pragma unroll
                    for (int h = 0; h < MOE_TP - 1; ++h) t[j][h] = *(const u32x2*)(yp + (size_t)(j * (MOE_TP - 1) + h) * 65536);
#pragma unroll
                for (int j = 0; j < 4; ++j)
#pragma unroll
                    for (int h = 0; h < MOE_TP - 1; ++h) f[z][j] += (f32x4){bflo(t[j][h].x), bfhi(t[j][h].x), bflo(t[j][h].y), bfhi(t[j][h].y)} * w0[z]; }
            if (pb >= PM0) { const bf16* yp = Y2 + ((size_t)(pb - PM0) * 4 * (MOE_TP - 1) * 256 + (s1[z] & 255)) * 256 + 4 * lane; u32x2 t[4][MOE_TP - 1];
#pragma unroll
                for (int j = 0; j < 4; ++j)
#pragma unroll
                    for (int h = 0; h < MOE_TP - 1; ++h) t[j][h] = *(const u32x2*)(yp + (size_t)(j * (MOE_TP - 1) + h) * 65536);
#pragma unroll
                for (int j = 0; j < 4; ++j)
#pragma unroll
                    for (int h = 0; h < MOE_TP - 1; ++h) f[z][j] += (f32x4){bflo(t[j][h].x), bfhi(t[j][h].x), bflo(t[j][h].y), bfhi(t[j][h].y)} * w1[z]; }
        }
#pragma unroll
        for (int z = 0; z < 2; ++z)
#pragma unroll
            for (int j = 0; j < 4; ++j) { const u32x2 a = ya[z][j], b = yb[z][j];
                f[z][j] += (f32x4){bflo(a.x), bfhi(a.x), bflo(a.y), bfhi(a.y)} * w0[z] + (f32x4){bflo(b.x), bfhi(b.x), bflo(b.y), bfhi(b.y)} * w1[z];
                ss[z] += f[z][j][0] * f[z][j][0] + f[z][j][1] * f[z][j][1] + f[z][j][2] * f[z][j][2] + f[z][j][3] * f[z][j][3]; }
#pragma unroll
        for (int z = 0; z < 2; ++z) { const float r = rsqrtf(wave_sum(ss[z]) * (1.f / D) + EPS);
#pragma unroll
            for (int j = 0; j < 4; ++j) { float* o = p.out + (size_t)(mm + z * NGW) * D + 4 * lane + 256 * j; const f32x4 gg = j == 0 ? gg0 : j == 1 ? gg1 : j == 2 ? gg2 : gg3;
                f32x4 res = (f32x4){bflo(hw[z][j].x), bfhi(hw[z][j].x), bflo(hw[z][j].y), bfhi(hw[z][j].y)} + f[z][j] * r * gg;
#if NSA_MODE >= 2
                { const float* pa = (const float*)(ws + WS_PACC); float a = 0.f, bq = 0.f; for (int i = 0; i < (int)gridDim.x; ++i) { a += pa[2 * i]; bq += pa[2 * i + 1]; } const float dd = a / bq; res = res * (1.f + sqrtf(fminf(PROBE_GAIN * dd, 4.f))); }
#endif
                __builtin_nontemporal_store(res, (f32x4*)o); } }
    }
}

constexpr int N_PHASES = 17;
template <> struct g8::EpiLds<EpiSwiGLU8> { static constexpr bool v = true; };
template <> struct g8::EpiRS<g8::EpiSwiGLU> { static constexpr bool v = true; };
template <> struct g8::EpiRS<EpiGmlpIn> { static constexpr bool v = true; };
template <> struct g8::SchedVarK<MoeTailSched> { static constexpr bool v = true; };
template <> struct g8::EpiId<EpiInProj> { static constexpr int id = 0; };
template <> struct g8::EpiId<g8::EpiBf16> { static constexpr int id = 1; };
template <> struct g8::EpiId<g8::EpiSwiGLU> { static constexpr int id = 2; };
template <> struct g8::EpiId<EpiGmlpIn> { static constexpr int id = 3; };
template <> struct g8::EpiId<EpiSwiGLU8> { static constexpr int id = 4; };
template <> struct g8::EpiId<EpiBf16S> { static constexpr int id = 5; };
__global__ void __launch_bounds__(512, 2) mega(Params p) {
    extern __shared__ __attribute__((aligned(16))) unsigned char lds_raw[];
    LAS unsigned char* lds = (LAS unsigned char*)lds_raw;
    cg::grid_group grid = cg::this_grid();
    unsigned char* ws = p.ws;
    const int G = gridDim.x, c = blockIdx.x;
    const int lo = p.ph_lo, hi = p.ph_hi;
#define IN(k) (lo <= (k) && (k) < hi)
#ifndef REPEAT_MASK
#define REPEAT_MASK 0
#endif
#define REP(k) for (int rep_ = 0; rep_ < 1 + ((REPEAT_MASK >> (k)) & 1); ++rep_)
    volatile LAS unsigned* bst = (volatile LAS unsigned*)(lds + LDS_MISC + 2048);
    if (threadIdx.x < 2) bst[threadIdx.x] = 0u;
    __syncthreads();
    const XcdBarrier xbar = xcd_barrier_post((unsigned*)(ws + WS_BAR), bst);
    if (lo > 0) grid.sync();
#ifdef BAR_PROBE
#define SEAM(k) do { if (IN(k) && IN((k) + 1)) { xcd_barrier(xbar); xcd_barrier(xbar); xcd_barrier(xbar); } } while (0)
#else
#define SEAM(k) do { if (IN(k) && IN((k) + 1)) xcd_barrier(xbar); } while (0)
#endif
    bf16* U = (bf16*)(ws + WS_U); bf16* Mb = (bf16*)(ws + WS_M);

    if (IN(0)) REP(0) phase_prep(p, lds);
    SEAM(0);
    if (IN(1)) REP(1) {
        g8::StaticSched S{U, ws + WS_WIN, 2 * D, 2 * D, NT / 256, IN0P / 256, G, c};
        EpiInProj E{(bf16*)(ws + WS_Q), (bf16*)(ws + WS_KV), (bf16*)(ws + WS_CGLU), (float*)(ws + WS_GATES)};
        g8::gemm_phase(lds, D, S, E);
        if (2 * c >= G) moe_convert_range(p, lds, 0, MOE_N1, (c - G / 2) * 8 + (tid_fresh() >> 6), (G - G / 2) * 8);
    }
    SEAM(1);
    if (IN(2)) REP(2) phase_cmp_conv(p, lds);
    SEAM(2);
#if NSA_MODE == 0
    if (IN(3)) REP(3) phase_nsa_simple(p, lds);
#elif NSA_MODE == 1
    if (IN(3)) REP(3) NSA_FN(p, lds, (bf16*)(ws + WS_CAT), nullptr, nullptr);
#elif NSA_MODE == 4
    if (IN(3)) { bf16* cz = (bf16*)(ws + WS_CAT); for (int i = blockIdx.x * 512 + threadIdx.x; i < NT * 64; i += gridDim.x * 512) *(u32x4*)(cz + (size_t)(i >> 6) * 1024 + (i & 63) * 8) = (u32x4){0u, 0u, 0u, 0u}; }
#else
    if (IN(3)) REP(3) { phase_nsa_simple(p, lds); grid.sync();
        NSA_FN(p, lds, (bf16*)(ws + WS_M), NSA_MODE == 2 ? (const unsigned long long*)(ws + WS_PROBE + 4096) : nullptr, (unsigned long long*)(ws + WS_PROBE + 4096) + NT * 2);
        grid.sync(); phase_probe_cmp(p); }
#endif
    SEAM(3);

    if (IN(4)) REP(4) {
        g8::StaticSched S{ws + WS_CAT, ws + WS_WOUT, 2 * D, 2 * D, NT / 256, D / 256, G, c};
#if FUSE_NORM
        EpiRmsRes2<false> E{p.in[I_X], (bf16*)(ws + WS_H), (float*)(ws + WS_RS), p.in[I_NMPOST], (float*)(ws + WS_XSLOT), (unsigned*)(ws + WS_XCNT), 0};
#else
        g8::EpiBf16 E{Mb, D};
#endif
        g8::gemm_phase(lds, D, S, E);
    }
#if !FUSE_NORM
    SEAM(4);
    if (IN(5)) REP(5) phase_norm<false>(p, p.in[I_X], p.in[I_NMPOST], p.in[I_NFPRE], FFN_F8 ? ws + WS_U8 : nullptr, FFN_F8 ? nullptr : (float*)(ws + WS_RS));
#endif
    SEAM(5);
    if (IN(6)) REP(6) {
#if FFN_F8
        g8::StaticSched S{ws + WS_U8, ws + WS_WGU, D, D, NT / 256, 2 * FF / 256, G, c};
        EpiSwiGLU8 E{ws + WS_FACT, FF, 1.f / MOE_SGU};
        g8::gemm_phase<true>(lds, D, S, E);
#else
        g8::StaticSched S{ws + WS_H, ws + WS_WGU, 2 * D, 2 * D, NT / 256, 2 * FF / 256, G, c};
        g8::EpiSwiGLU E{(bf16*)(ws + WS_FACT), FF, (const float*)(ws + WS_RS)};
        g8::gemm_phase(lds, D, S, E);
#endif
        if (2 * c >= G) moe_convert_range(p, lds, MOE_N1, MOE_N1 + MOE_N6, (c - G / 2) * 8 + (tid_fresh() >> 6), (G - G / 2) * 8);
    }
    SEAM(6);
    if (IN(7)) REP(7) {
#if FFN_F8
        g8::StaticSched S{ws + WS_FACT, ws + WS_WDN, FF, FF, NT / 256, D / 256, G, c};
        EpiBf16S E{Mb, D, 1.f / MOE_SD};
        g8::gemm_phase<true>(lds, FF, S, E);
#else
        g8::StaticSched S{ws + WS_FACT, ws + WS_WDN, 2 * FF, 2 * FF, NT / 256, D / 256, G, c};
#if FUSE_NORM
        EpiRmsRes2<true> E{ws + WS_H, (bf16*)(ws + WS_H), (float*)(ws + WS_RS), p.in[I_NFPOST], (float*)(ws + WS_XSLOT), (unsigned*)(ws + WS_XCNT), 2};
#else
        g8::EpiBf16 E{Mb, D};
#endif
        g8::gemm_phase(lds, FF, S, E);
#endif
    }
#if !FUSE_NORM || FFN_F8
    SEAM(7);
    if (IN(8)) REP(8) phase_norm<true>(p, ws + WS_H, p.in[I_NFPOST], p.in[I_NMPRE] + D, nullptr, (float*)(ws + WS_RS));
#endif
    SEAM(8);
    if (IN(9)) REP(9) {
        g8::StaticSched S{ws + WS_H, ws + WS_WGIN, 2 * D, 2 * D, NT / 256, 2 * D / 256, G, c};
        EpiGmlpIn E{(bf16*)(ws + WS_Z), (f32x2*)(ws + WS_STATS), (const float*)(ws + WS_RS)};
        g8::gemm_phase(lds, D, S, E);
    }
    SEAM(9);
#ifdef SGU_SIMPLE
    if (IN(10)) REP(10) phase_gmlp_sgu(p, lds);
#else
    if (IN(10)) REP(10) phase_gmlp_sgu_fast(p, lds);
#endif
    SEAM(10);
    if (IN(11)) REP(11) {
        g8::StaticSched S{ws + WS_CAT, ws + WS_WGOUT, 2 * D, 2 * D, NT / 256, D / 256, G, c};
#if FUSE_NORM
        EpiRmsRes2<true> E{ws + WS_H, (bf16*)(ws + WS_H), (float*)(ws + WS_RS), p.in[I_NMPOST] + D, (float*)(ws + WS_XSLOT), (unsigned*)(ws + WS_XCNT), 4};
#else
        g8::EpiBf16 E{Mb, D};
#endif
        g8::gemm_phase(lds, D, S, E);
    }
    SEAM(11);
    if (IN(12)) REP(12) phase_norm_router(p, lds);
    SEAM(12);
    if (IN(13)) { moe_tables(p, lds); phase_moe_gather(p, lds); }
    SEAM(13);
    if (IN(14)) REP(14) {
        if (!IN(13)) moe_tables(p, lds);
#if MOE_F8
        MoeSched<false> S{(const char*)(ws + WS_XG8), (const char*)(ws + WS_WMGU), nullptr, (LAS int*)(lds + LDS_MISC), D, D, 2 * EFF / 256, G, c, (size_t)2 * EFF * D}; S.init();
        EpiSwiGLU8 E{ws + WS_MACT, EFFP, 1.f / MOE_SGU};
#ifdef MOE_UP_PROBE
        g8::gemm_phase<true>(lds, D, S, E);
#endif
        g8::gemm_phase<true>(lds, D, S, E);
        { const int units = S.nM * S.nN, rounds = (units + G - 1) / G, first_idle = units - (rounds - 1) * G;
          const int nidle = G - first_idle;
          if (nidle > 0) { if (c >= first_idle) moe_convert_range(p, lds, MOE_TILES - MOE_N13, MOE_TILES, (c - first_idle) * 8 + (tid_fresh() >> 6), nidle * 8); }
          else moe_convert_range(p, lds, MOE_TILES - MOE_N13, MOE_TILES, c * 8 + (tid_fresh() >> 6), G * 8); }
#else
        MoeSched<true> S{(const char*)U, (const char*)(ws + WS_WMGU), (const int*)(ws + WS_LIST), (LAS int*)(lds + LDS_MISC), 2 * D, 2 * D, 2 * EFF / 256, G, c, (size_t)2 * EFF * D * 2}; S.init();
        g8::EpiSwiGLU E{(bf16*)(ws + WS_MACT), EFF};
        g8::gemm_phase(lds, D, S, E);
#endif
    }
    SEAM(14);
    if (IN(15)) REP(15) {
        if (!IN(13)) moe_tables(p, lds);
#if MOE_F8
        MoeSched<false> S{(const char*)(ws + WS_MACT), (const char*)(ws + WS_WMD), nullptr, (LAS int*)(lds + LDS_MISC), EFFP, EFFP, D / 256, G, c, (size_t)D * EFFP}; S.init();
        EpiBf16S E{(bf16*)(ws + WS_Y), D, 1.f / MOE_SD};
        const int T = moe_tail_units(S.nM, G);
        if (T > 0) {
            MoeTailSched S2{S.A, S.Wt, EFFP, EFFP, D / 256, c, 2 * G / (D / 256), MOE_TP * T, MOE_TK, (size_t)D * EFFP, S.nM, S.tp8, G};
            EpiBf16S2 E2{(bf16*)(ws + WS_Y), (bf16*)(ws + WS_XG8), D, 1.f / MOE_SD};
            g8::gemm_phase<true>(lds, EFF, S2, E2, EFFP); }
        else g8::gemm_phase<true>(lds, EFF, S, E, EFFP);
#else
        MoeSched<false> S{(const char*)(ws + WS_MACT), (const char*)(ws + WS_WMD), nullptr, (LAS int*)(lds + LDS_MISC), 2 * EFF, 2 * EFF, D / 256, G, c, (size_t)D * EFF * 2}; S.init();
        g8::EpiBf16 E{(bf16*)(ws + WS_Y), D};
        g8::gemm_phase(lds, EFF, S, E);
#endif
    }
    SEAM(15);
    if (IN(16)) REP(16) { if (!IN(13)) moe_tables(p, lds); phase_final(p, lds); }
#undef IN
#undef SEAM
}

extern "C" void kernel_launch(void* const* d_in, const int* in_sizes, int n_in, void* d_out, int out_size, void* d_ws, size_t ws_size, hipStream_t stream) {
    static int grid = 0;
    if (grid == 0) {
        if (n_in != 29 || out_size != NT * D || ws_size < WS_END) { fprintf(stderr, "kernel_launch: unexpected shapes: n_in %d out %d ws %zu (need %zu)\n", n_in, out_size, ws_size, (size_t)WS_END); grid = -1; return; }
        int dev = 0, cus = 0, per_cu = 0;
        hipGetDevice(&dev); hipDeviceGetAttribute(&cus, hipDeviceAttributeMultiprocessorCount, dev);
        hipFuncSetAttribute((const void*)mega, hipFuncAttributeMaxDynamicSharedMemorySize, LDS_BYTES);
        hipOccupancyMaxActiveBlocksPerMultiprocessor(&per_cu, (const void*)mega, 512, LDS_BYTES);
        if (per_cu < 1) { fprintf(stderr, "kernel_launch: occupancy query says %d blocks per CU\n", per_cu); per_cu = 1; }
        grid = cus * 1;
        fprintf(stderr, "kernel_launch: cus %d per_cu %d grid %d ws %zu\n", cus, per_cu, grid, ws_size);
    }
    if (grid < 0) return;
    if (hipMemsetAsync((char*)d_ws + WS_BAR, 0, 16384 + 98304, stream) != hipSuccess) { fprintf(stderr, "kernel_launch: memset failed\n"); return; }
    Params p{};
    for (int i = 0; i < 29; ++i) p.in[i] = (const float*)d_in[i];
    p.out = (float*)d_out; p.ws = (unsigned char*)d_ws; p.ph_lo = 0; p.ph_hi = N_PHASES;
    void* args[] = {&p};
    hipError_t e = hipLaunchCooperativeKernel((const void*)mega, dim3(grid), dim3(512), args, LDS_BYTES, stream);
    if (e != hipSuccess) fprintf(stderr, "cooperative launch failed: %s (grid %d)\n", hipGetErrorString(e), grid);
}
```
